# Optimizing an MI355X kernel written in HIP

```python
import math
import jax, jax.numpy as jnp
from jax import lax
import numpy as np

D_MODEL = 1024
BATCH = 2
SEQ = 8192
DEPTH = 2

D_FF = 2816
NORM_EPS = 1e-6
NSA_HEADS = 8
NSA_KV_HEADS = 2
NSA_GROUP = NSA_HEADS // NSA_KV_HEADS
NSA_HEAD_DIM = 64
CMP_BLOCK = 32
CMP_STRIDE = 16
SEL_BLOCK = 64
SEL_TOPK = 16
WINDOW = 512
Q_BLOCK = 128
ROPE_THETA = 10000.0
FORCE_SCORE = 1e4
SSD_HEADS = 16
SSD_HEAD_DIM = 64
SSD_D_INNER = SSD_HEADS * SSD_HEAD_DIM
SSD_GROUPS = 2
SSD_STATE = 128
SSD_CONV = 4
SSD_CHUNK = 128
SSD_NORM_EPS = 1e-5
RWKV_HEAD_DIM = 64
RWKV_HEADS = D_MODEL // RWKV_HEAD_DIM
DECAY_LORA = 64
AAA_LORA = 64
GATE_LORA = 160
RWKV_GN_EPS = 64e-5

N_EVEN = (DEPTH + 1) // 2
N_ODD = DEPTH // 2

NSA_Q_W = NSA_HEADS * NSA_HEAD_DIM
NSA_KV_W = NSA_KV_HEADS * NSA_HEAD_DIM
SSD_XBC = SSD_D_INNER + 2 * SSD_GROUPS * SSD_STATE
IN_SPLITS = (NSA_Q_W, NSA_KV_W, NSA_KV_W, NSA_KV_W, NSA_KV_W, NSA_KV_W, NSA_KV_W,
             NSA_HEADS * 3, SSD_D_INNER, SSD_XBC, SSD_HEADS)
IN_WIDTH = sum(IN_SPLITS)
MIX_OUT_WIDTH = NSA_Q_W + SSD_D_INNER

kernel_name = 'hybrid_nsa_ssd_rwkv7_macaron'


def rmsnorm(x, g, eps=NORM_EPS):
    xf = x.astype(jnp.float32)
    y = xf * lax.rsqrt(jnp.mean(xf * xf, -1, keepdims=True) + eps)
    return (y * g.astype(jnp.float32)).astype(x.dtype)


def swiglu(x, w_gate, w_up, w_down):
    return (jax.nn.silu(x @ w_gate) * (x @ w_up)) @ w_down


def rope_tables(seq, dim):
    inv = ROPE_THETA ** (-jnp.arange(0, dim, 2, dtype=jnp.float32) / dim)
    ang = jnp.arange(seq, dtype=jnp.float32)[:, None] * inv[None, :]
    return jnp.cos(ang), jnp.sin(ang)


def apply_rope(x, cos, sin):
    shape = (1, x.shape[1]) + (1,) * (x.ndim - 3) + (cos.shape[-1],)
    c = cos.reshape(shape).astype(x.dtype)
    s = sin.reshape(shape).astype(x.dtype)
    x1, x2 = jnp.split(x, 2, axis=-1)
    return jnp.concatenate([x1 * c - x2 * s, x2 * c + x1 * s], -1)


def masked_softmax(s, mask):
    s = jnp.where(mask, s.astype(jnp.float32), -1e30)
    p = jnp.where(mask, jnp.exp(s - jnp.max(s, -1, keepdims=True)), 0.0)
    return p / jnp.maximum(jnp.sum(p, -1, keepdims=True), 1e-30)


def compress_blocks(k, pe, w1, w2):
    b, s, h, d = k.shape
    n_cmp = (s - CMP_BLOCK) // CMP_STRIDE + 1
    idx = jnp.arange(n_cmp)[:, None] * CMP_STRIDE + jnp.arange(CMP_BLOCK)[None, :]
    blk = k[:, idx] + pe[None, None, :, None, :]
    blk = jnp.moveaxis(blk, 3, 2).reshape(b, n_cmp, h, CMP_BLOCK * d)
    return jax.nn.silu(blk @ w1) @ w2


def nsa_attention(q, k_cmp, v_cmp, k_sel, v_sel, k_win, v_win, gates,
                  pe_k, w1_k, w2_k, pe_v, w1_v, w2_v):
    b, s, hkv, g, d = q.shape
    kc = compress_blocks(k_cmp, pe_k, w1_k, w2_k)
    vc = compress_blocks(v_cmp, pe_v, w1_v, w2_v)
    n_cmp = kc.shape[1]
    n_sel = s // SEL_BLOCK
    topk = min(SEL_TOPK, n_sel)
    cmp_start = jnp.arange(n_cmp) * CMP_STRIDE
    cmp_end = cmp_start + CMP_BLOCK - 1
    sel_start = jnp.arange(n_sel) * SEL_BLOCK
    overlap = ((cmp_start[:, None] < sel_start[None, :] + SEL_BLOCK)
               & (cmp_end[:, None] >= sel_start[None, :])).astype(jnp.float32)
    ks_blk = jnp.moveaxis(k_sel, 2, 1).reshape(b, hkv, n_sel, SEL_BLOCK, d)
    vs_blk = jnp.moveaxis(v_sel, 2, 1).reshape(b, hkv, n_sel, SEL_BLOCK, d)
    pad = ((0, 0), (WINDOW, 0), (0, 0), (0, 0))
    kw_pad = jnp.pad(k_win, pad)
    vw_pad = jnp.pad(v_win, pad)
    bi = jnp.arange(b)[:, None, None, None]
    hi = jnp.arange(hkv)[None, :, None, None]
    blk_ids = jnp.arange(n_sel)

    def block(qi):
        s0 = qi * Q_BLOCK
        qb = lax.dynamic_slice_in_dim(q, s0, Q_BLOCK, 1)
        gb = lax.dynamic_slice_in_dim(gates, s0, Q_BLOCK, 1)
        t = s0 + jnp.arange(Q_BLOCK)
        p_c = masked_softmax(jnp.einsum('bqhgd,bchd->bhgqc', qb, kc),
                             cmp_end[None, :] <= t[:, None])
        o_c = jnp.einsum('bhgqc,bchd->bqhgd', p_c.astype(vc.dtype), vc)
        imp = jnp.einsum('bhgqc,cj->bhqj', p_c, overlap)
        cur = t // SEL_BLOCK
        forced = ((blk_ids[None, :] == 0) | (blk_ids[None, :] == cur[:, None])
                  | (blk_ids[None, :] == cur[:, None] - 1))
        valid = sel_start[None, :] <= t[:, None]
        imp = jnp.where(valid, jnp.where(forced, FORCE_SCORE, imp), -jnp.inf)
        _, sel = lax.top_k(imp, topk)
        kg = ks_blk[bi, hi, sel].reshape(b, hkv, Q_BLOCK, topk * SEL_BLOCK, d)
        vg = vs_blk[bi, hi, sel].reshape(b, hkv, Q_BLOCK, topk * SEL_BLOCK, d)
        tok = (sel[..., None] * SEL_BLOCK + jnp.arange(SEL_BLOCK)).reshape(
            b, hkv, Q_BLOCK, topk * SEL_BLOCK)
        p_s = masked_softmax(jnp.einsum('bqhgd,bhqnd->bhgqn', qb, kg),
                             (tok <= t[:, None])[:, :, None])
        o_s = jnp.einsum('bhgqn,bhqnd->bqhgd', p_s.astype(vg.dtype), vg)
        kw = lax.dynamic_slice_in_dim(kw_pad, s0, Q_BLOCK + WINDOW, 1)
        vw = lax.dynamic_slice_in_dim(vw_pad, s0, Q_BLOCK + WINDOW, 1)
        kp = s0 - WINDOW + jnp.arange(Q_BLOCK + WINDOW)
        mask_w = ((kp[None, :] <= t[:, None]) & (kp[None, :] > t[:, None] - WINDOW)
                  & (kp[None, :] >= 0))
        p_w = masked_softmax(jnp.einsum('bqhgd,bkhd->bhgqk', qb, kw), mask_w)
        o_w = jnp.einsum('bhgqk,bkhd->bqhgd', p_w.astype(vw.dtype), vw)
        return gb[..., 0:1] * o_c + gb[..., 1:2] * o_s + gb[..., 2:3] * o_w

    out = lax.map(block, jnp.arange(s // Q_BLOCK))
    return jnp.moveaxis(out, 0, 1).reshape(b, s, hkv * g * d)


def causal_depthwise_conv(x, w, bias):
    y = lax.conv_general_dilated(x, w, window_strides=(1,), padding=[(SSD_CONV - 1, 0)],
                                 dimension_numbers=('NWC', 'WIO', 'NWC'),
                                 feature_group_count=x.shape[-1])
    return y + bias


def ssd_chunked(x, dt, a, bmat, cmat):
    b, s, h, p = x.shape
    g, n = bmat.shape[2], bmat.shape[3]
    r = h // g
    l = SSD_CHUNK
    c = s // l
    xd = (x * dt[..., None]).reshape(b, c, l, g, r, p)
    a_cs = jnp.cumsum(jnp.moveaxis((dt * a).reshape(b, c, l, g, r), 2, -1), axis=-1)
    bm = bmat.reshape(b, c, l, g, n)
    cm = cmat.reshape(b, c, l, g, n)
    causal = jnp.tril(jnp.ones((l, l), bool))
    seg = jnp.exp(jnp.where(causal, a_cs[..., :, None] - a_cs[..., None, :], -jnp.inf))
    cb = jnp.einsum('bclgn,bcsgn->bcgls', cm, bm)
    y_diag = jnp.einsum('bcgrls,bcsgrp->bclgrp', cb[:, :, :, None] * seg, xd)
    decay_states = jnp.exp(a_cs[..., -1:] - a_cs)
    states = jnp.einsum('bclgn,bcgrl,bclgrp->bcgrpn', bm, decay_states, xd)
    chunk_decay = jnp.exp(a_cs[..., -1])

    def step(carry, inp):
        st, dec = inp
        return carry * dec[..., None, None] + st, carry

    _, states_in = lax.scan(step, jnp.zeros_like(states[:, 0]),
                            (jnp.moveaxis(states, 1, 0), jnp.moveaxis(chunk_decay, 1, 0)))
    states_in = jnp.moveaxis(states_in, 0, 1)
    y_off = jnp.einsum('bclgn,bcgrpn,bcgrl->bclgrp', cm, states_in, jnp.exp(a_cs))
    return (y_diag + y_off).reshape(b, s, h, p)


def mamba2_branch(z, xbc, dt_raw, conv_w, conv_b, dt_bias, a_log, d_skip, norm_w):
    b, s, _ = z.shape
    f32 = jnp.float32
    xbc = jax.nn.silu(causal_depthwise_conv(xbc, conv_w, conv_b))
    xs, bm, cm = jnp.split(xbc, [SSD_D_INNER, SSD_D_INNER + SSD_GROUPS * SSD_STATE], -1)
    xs = xs.reshape(b, s, SSD_HEADS, SSD_HEAD_DIM).astype(f32)
    dt = jax.nn.softplus(dt_raw.astype(f32) + dt_bias.astype(f32))
    a = -jnp.exp(a_log.astype(f32))
    y = ssd_chunked(xs, dt, a, bm.reshape(b, s, SSD_GROUPS, SSD_STATE).astype(f32),
                    cm.reshape(b, s, SSD_GROUPS, SSD_STATE).astype(f32))
    y = y + xs * d_skip.astype(f32)[:, None]
    y = y.reshape(b, s, SSD_D_INNER) * jax.nn.silu(z.astype(f32))
    yg = y.reshape(b, s, SSD_GROUPS, SSD_D_INNER // SSD_GROUPS)
    yg = yg * lax.rsqrt(jnp.mean(yg * yg, -1, keepdims=True) + SSD_NORM_EPS)
    return (yg.reshape(b, s, SSD_D_INNER) * norm_w.astype(f32)).astype(z.dtype)


def nsa_ssd_mixer(h, cos, sin, w_in, pe_k, w1_k, w2_k, pe_v, w1_v, w2_v,
                  conv_w, conv_b, dt_bias, a_log, d_skip, ssd_norm_w, w_out):
    b, s, _ = h.shape
    proj = h @ w_in
    offs = np.cumsum(IN_SPLITS)[:-1].tolist()
    q, kc, vc, ks, vs, kw, vw, gl, z, xbc, dt = jnp.split(proj, offs, -1)
    kvshape = (b, s, NSA_KV_HEADS, NSA_HEAD_DIM)
    q = apply_rope(q.reshape(b, s, NSA_KV_HEADS, NSA_GROUP, NSA_HEAD_DIM), cos, sin) * (NSA_HEAD_DIM ** -0.5)
    kc = apply_rope(kc.reshape(kvshape), cos, sin)
    ks = apply_rope(ks.reshape(kvshape), cos, sin)
    kw = apply_rope(kw.reshape(kvshape), cos, sin)
    gates = jax.nn.sigmoid(gl).reshape(b, s, NSA_KV_HEADS, NSA_GROUP, 3)
    o_a = nsa_attention(q, kc, vc.reshape(kvshape), ks, vs.reshape(kvshape), kw, vw.reshape(kvshape),
                        gates, pe_k, w1_k, w2_k, pe_v, w1_v, w2_v)
    o_b = mamba2_branch(z, xbc, dt, conv_w, conv_b, dt_bias, a_log, d_skip, ssd_norm_w)
    return jnp.concatenate([o_a, o_b], -1) @ w_out


def rwkv7_time_mix(h, mu, w_r, w_k, w_v, w_o, w0, w1, w2, a0, a1, a2, g1, g2,
                   k_k, k_a, r_k, ln_g, ln_b):
    b, s, d = h.shape
    f32 = jnp.float32
    xx = jnp.pad(h, ((0, 0), (1, 0), (0, 0)))[:, :-1] - h
    xr, xw, xk, xv, xa, xg = [h + xx * mu[i] for i in range(6)]
    r = xr @ w_r
    w = -jax.nn.softplus(-(w0 + jnp.tanh(xw @ w1) @ w2)) - 0.5
    k = xk @ w_k
    v = xv @ w_v
    a = jax.nn.sigmoid(a0 + (xa @ a1) @ a2)
    g = jax.nn.sigmoid(xg @ g1) @ g2
    heads = lambda t: t.reshape(b, s, RWKV_HEADS, RWKV_HEAD_DIM).astype(f32)
    kk = heads(k * k_k)
    kk = kk / jnp.maximum(jnp.sqrt(jnp.sum(kk * kk, -1, keepdims=True)), 1e-12)
    k = k * (1 + (a - 1) * k_a)
    r_, k_, v_, a_ = heads(r), heads(k), heads(v), heads(a)
    decay = jnp.exp(-jnp.exp(heads(w)))

    def step(state, inp):
        r_t, d_t, k_t, v_t, kk_t, a_t = inp
        sa = jnp.einsum('bhij,bhj->bhi', state, -kk_t)
        state = (state * d_t[:, :, None, :] + sa[..., None] * (kk_t * a_t)[:, :, None, :]
                 + v_t[..., None] * k_t[:, :, None, :])
        return state, jnp.einsum('bhij,bhj->bhi', state, r_t)

    xs = tuple(jnp.moveaxis(t, 1, 0) for t in (r_, decay, k_, v_, kk, a_))
    _, y = lax.scan(step, jnp.zeros((b, RWKV_HEADS, RWKV_HEAD_DIM, RWKV_HEAD_DIM), f32), xs)
    y = jnp.moveaxis(y, 0, 1)
    mean = jnp.mean(y, -1, keepdims=True)
    var = jnp.mean(jnp.square(y - mean), -1, keepdims=True)
    y = ((y - mean) * lax.rsqrt(var + RWKV_GN_EPS)).reshape(b, s, d)
    y = y * ln_g.astype(f32) + ln_b.astype(f32)
    bonus = jnp.sum(r_ * k_ * r_k.astype(f32), -1, keepdims=True) * v_
    y = y + bonus.reshape(b, s, d)
    return (y * g.astype(f32)).astype(h.dtype) @ w_o


def setup_inputs(seed: int = 0) -> dict:
    key = jax.random.key(seed)
    ks = iter(jax.random.split(key, 48))
    nrm = lambda shape, scale: scale * jax.random.normal(next(ks), shape, jnp.float32)
    uni = lambda shape, lo, hi: jax.random.uniform(next(ks), shape, jnp.float32, lo, hi)
    D, F, E, O = D_MODEL, D_FF, N_EVEN, N_ODD
    L, KD = CMP_BLOCK, NSA_HEAD_DIM
    x = nrm((BATCH, SEQ, D), 1.0)
    norm_gains = 1.0 + nrm((DEPTH, 6, D), 0.05)
    ffn1_w_gate = nrm((DEPTH, D, F), D ** -0.5)
    ffn1_w_up = nrm((DEPTH, D, F), D ** -0.5)
    ffn1_w_down = nrm((DEPTH, F, D), F ** -0.5)
    ffn2_w_gate = nrm((DEPTH, D, F), D ** -0.5)
    ffn2_w_up = nrm((DEPTH, D, F), D ** -0.5)
    ffn2_w_down = nrm((DEPTH, F, D), F ** -0.5)
    ab_w_in = nrm((E, D, IN_WIDTH), D ** -0.5)
    a_cmp_pe_k = nrm((E, L, KD), 0.02)
    a_cmp_w1_k = nrm((E, L * KD, KD), (L * KD) ** -0.5)
    a_cmp_w2_k = nrm((E, KD, KD), KD ** -0.5)
    a_cmp_pe_v = nrm((E, L, KD), 0.02)
    a_cmp_w1_v = nrm((E, L * KD, KD), (L * KD) ** -0.5)
    a_cmp_w2_v = nrm((E, KD, KD), KD ** -0.5)
    b_conv_w = nrm((E, SSD_CONV, 1, SSD_XBC), SSD_CONV ** -0.5)
    b_conv_b = nrm((E, SSD_XBC), 0.02)
    dt0 = jnp.exp(uni((E, SSD_HEADS), math.log(1e-3), math.log(1e-1)))
    b_dt_bias = dt0 + jnp.log(-jnp.expm1(-dt0))
    b_a_log = jnp.log(uni((E, SSD_HEADS), 1.0, 16.0))
    b_d_skip = 1.0 + nrm((E, SSD_HEADS), 0.1)
    b_norm_w = 1.0 + nrm((E, SSD_D_INNER), 0.05)
    ab_w_out = nrm((E, MIX_OUT_WIDTH, D), MIX_OUT_WIDTH ** -0.5)
    c_mu = uni((O, 6, D), 0.0, 1.0)
    c_w_r = nrm((O, D, D), D ** -0.5)
    c_w_k = nrm((O, D, D), D ** -0.5)
    c_w_v = nrm((O, D, D), D ** -0.5)
    c_w_o = nrm((O, D, D), D ** -0.5)
    c_w0 = uni((O, D), -6.0, 1.0)
    c_w1 = nrm((O, D, DECAY_LORA), D ** -0.5)
    c_w2 = nrm((O, DECAY_LORA, D), 0.1 * DECAY_LORA ** -0.5)
    c_a0 = nrm((O, D), 0.1)
    c_a1 = nrm((O, D, AAA_LORA), D ** -0.5)
    c_a2 = nrm((O, AAA_LORA, D), 0.1 * AAA_LORA ** -0.5)
    c_g1 = nrm((O, D, GATE_LORA), D ** -0.5)
    c_g2 = nrm((O, GATE_LORA, D), GATE_LORA ** -0.5)
    c_k_k = 0.85 + nrm((O, D), 0.05)
    c_k_a = 1.0 + nrm((O, D), 0.05)
    c_r_k = nrm((O, RWKV_HEADS, RWKV_HEAD_DIM), 0.1)
    c_ln_g = 1.0 + nrm((O, D), 0.05)
    c_ln_b = nrm((O, D), 0.02)
    return {'x': x, 'norm_gains': norm_gains,
            'ffn1_w_gate': ffn1_w_gate, 'ffn1_w_up': ffn1_w_up, 'ffn1_w_down': ffn1_w_down,
            'ffn2_w_gate': ffn2_w_gate, 'ffn2_w_up': ffn2_w_up, 'ffn2_w_down': ffn2_w_down,
            'ab_w_in': ab_w_in, 'a_cmp_pe_k': a_cmp_pe_k, 'a_cmp_w1_k': a_cmp_w1_k,
            'a_cmp_w2_k': a_cmp_w2_k, 'a_cmp_pe_v': a_cmp_pe_v, 'a_cmp_w1_v': a_cmp_w1_v,
            'a_cmp_w2_v': a_cmp_w2_v, 'b_conv_w': b_conv_w, 'b_conv_b': b_conv_b,
            'b_dt_bias': b_dt_bias, 'b_a_log': b_a_log, 'b_d_skip': b_d_skip,
            'b_norm_w': b_norm_w, 'ab_w_out': ab_w_out,
            'c_mu': c_mu, 'c_w_r': c_w_r, 'c_w_k': c_w_k, 'c_w_v': c_w_v, 'c_w_o': c_w_o,
            'c_w0': c_w0, 'c_w1': c_w1, 'c_w2': c_w2, 'c_a0': c_a0, 'c_a1': c_a1, 'c_a2': c_a2,
            'c_g1': c_g1, 'c_g2': c_g2, 'c_k_k': c_k_k, 'c_k_a': c_k_a, 'c_r_k': c_r_k,
            'c_ln_g': c_ln_g, 'c_ln_b': c_ln_b}


def reference(x, norm_gains, ffn1_w_gate, ffn1_w_up, ffn1_w_down, ffn2_w_gate, ffn2_w_up,
              ffn2_w_down, ab_w_in, a_cmp_pe_k, a_cmp_w1_k, a_cmp_w2_k, a_cmp_pe_v, a_cmp_w1_v,
              a_cmp_w2_v, b_conv_w, b_conv_b, b_dt_bias, b_a_log, b_d_skip, b_norm_w, ab_w_out,
              c_mu, c_w_r, c_w_k, c_w_v, c_w_o, c_w0, c_w1, c_w2, c_a0, c_a1, c_a2, c_g1, c_g2,
              c_k_k, c_k_a, c_r_k, c_ln_g, c_ln_b):
    cos, sin = rope_tables(x.shape[1], NSA_HEAD_DIM)
    for layer in range(DEPTH):
        ng = norm_gains[layer]
        hdn = swiglu(rmsnorm(x, ng[0]), ffn1_w_gate[layer], ffn1_w_up[layer], ffn1_w_down[layer])
        x = x + 0.5 * rmsnorm(hdn, ng[1])
        hdn = rmsnorm(x, ng[2])
        i = layer // 2
        if layer % 2 == 0:
            hdn = nsa_ssd_mixer(hdn, cos, sin, ab_w_in[i], a_cmp_pe_k[i], a_cmp_w1_k[i],
                                a_cmp_w2_k[i], a_cmp_pe_v[i], a_cmp_w1_v[i], a_cmp_w2_v[i],
                                b_conv_w[i], b_conv_b[i], b_dt_bias[i], b_a_log[i], b_d_skip[i],
                                b_norm_w[i], ab_w_out[i])
        else:
            hdn = rwkv7_time_mix(hdn, c_mu[i], c_w_r[i], c_w_k[i], c_w_v[i], c_w_o[i], c_w0[i],
                                 c_w1[i], c_w2[i], c_a0[i], c_a1[i], c_a2[i], c_g1[i], c_g2[i],
                                 c_k_k[i], c_k_a[i], c_r_k[i], c_ln_g[i], c_ln_b[i])
        x = x + rmsnorm(hdn, ng[3])
        hdn = swiglu(rmsnorm(x, ng[4]), ffn2_w_gate[layer], ffn2_w_up[layer], ffn2_w_down[layer])
        x = x + 0.5 * rmsnorm(hdn, ng[5])
    return x
```

```cpp
#include <hip/hip_runtime.h>
#include <hip/hip_cooperative_groups.h>
#include <cstdio>
#include <cstdint>
#include <cstring>
namespace cg = cooperative_groups;

#define LAS __attribute__((address_space(3)))
typedef unsigned short bf16_t;
typedef short bf16x8 __attribute__((ext_vector_type(8)));
typedef short s16x4 __attribute__((ext_vector_type(4)));
typedef float f32x4 __attribute__((ext_vector_type(4)));
typedef float f32x2 __attribute__((ext_vector_type(2)));
typedef float f32x16 __attribute__((ext_vector_type(16)));
typedef unsigned u32x4 __attribute__((ext_vector_type(4)));
typedef unsigned u32x2 __attribute__((ext_vector_type(2)));
typedef __bf16 bf16x2_t __attribute__((ext_vector_type(2)));
typedef _Float16 h16x2 __attribute__((ext_vector_type(2)));
#define DI __device__ __forceinline__

constexpr int NB = 2, SEQ = 8192, MTOK = NB * SEQ, DM = 1024, DFF = 2816;
constexpr int NTHREADS = 512, NWAVES = 8;
constexpr int LDS_BYTES = 147456;
constexpr size_t MiB = 1u << 20;
constexpr size_t WS_WGU = 0, WS_WD = 11 * MiB;
constexpr size_t WS_MIX = 17 * MiB;
constexpr size_t WS_WIN = WS_MIX, WS_WOUT = WS_MIX + 8 * MiB, WS_W1K = WS_MIX + 11 * MiB, WS_W1V = WS_W1K + MiB / 2;
constexpr size_t WS_WG1 = WS_MIX, WS_WO = WS_MIX + 14 * MiB, WS_W2A = WS_MIX + 16 * MiB, WS_W2B = WS_W2A + MiB / 2;
constexpr size_t WS_ROPE = 35 * MiB;
constexpr size_t WS_GATES = 37 * MiB;
constexpr size_t WS_DT = WS_GATES + 3 * MiB / 2;
constexpr size_t WS_PK = 40 * MiB, WS_PV = 42 * MiB;
constexpr size_t WS_KCC = 44 * MiB, WS_VCCT = WS_KCC + MiB / 4;
constexpr size_t WS_CDEC = WS_KCC + MiB / 2;
constexpr size_t WS_PEB = WS_CDEC + 64 * 1024;
constexpr size_t WS_RK = 45 * MiB;
constexpr size_t WS_BAR = 46 * MiB;
constexpr size_t WS_A = 47 * MiB;
constexpr size_t WS_BIG = 80 * MiB;
constexpr size_t WS_H = WS_BIG, WS_Y = WS_BIG + 88 * MiB;
constexpr size_t WS_Q = WS_BIG, WS_KCN = WS_BIG + 16 * MiB, WS_VCN = WS_KCN + 4 * MiB, WS_KS = WS_VCN + 4 * MiB, WS_VST = WS_KS + 4 * MiB,
                 WS_KW = WS_VST + 4 * MiB, WS_VWT = WS_KW + 4 * MiB, WS_Z = WS_BIG + 40 * MiB, WS_XBC = WS_BIG + 72 * MiB, WS_OCAT = WS_XBC,
                 WS_BM = WS_BIG + 120 * MiB, WS_BMT = WS_BM + 8 * MiB, WS_CM = WS_BMT + 8 * MiB, WS_ST = WS_BIG + 144 * MiB;
constexpr size_t WS_XS = WS_A;
constexpr size_t WS_YMIX0 = WS_BIG;
constexpr size_t WS_R = WS_BIG, WS_K = WS_BIG + 32 * MiB, WS_V = WS_BIG + 64 * MiB, WS_LH = WS_BIG + 96 * MiB, WS_LD = WS_BIG + 112 * MiB,
                 WS_AA = WS_BIG + 144 * MiB, WS_YS = WS_A, WS_G = WS_LD, WS_A2 = WS_R, WS_YMIX1 = WS_K;
static_assert(WS_ST + 32 * MiB <= 256 * MiB && WS_AA + 32 * MiB <= 256 * MiB && WS_Y + 64 * MiB <= 256 * MiB, "ws map");

DI unsigned pk2(float lo, float hi) { f32x2 v = {lo, hi}; bf16x2_t b = __builtin_convertvector(v, bf16x2_t); return __builtin_bit_cast(unsigned, b); }
DI float bf2f(unsigned short u) { return __uint_as_float(((unsigned)u) << 16); }
DI float bflo(unsigned u) { return __uint_as_float(u << 16); }
DI float bfhi(unsigned u) { return __uint_as_float(u & 0xffff0000u); }
DI float sigmoidf_(float x) { return 1.f / (1.f + __expf(-x)); }
DI float siluf_(float x) { return x / (1.f + __expf(-x)); }
DI float softplusf_(float x) { return fmaxf(x, 0.f) + log1pf(expf(-fabsf(x))); }
DI float softplus_fast(float x) { return fmaxf(x, 0.f) + __logf(1.f + __expf(-fabsf(x))); }
DI float tanh_fast(float x) { const float e = __expf(2.f * x); return 1.f - 2.f / (e + 1.f); }
DI int tid_fresh(int wv) { int l; asm volatile("v_mbcnt_lo_u32_b32 %0, -1, 0\n\tv_mbcnt_hi_u32_b32 %0, -1, %0" : "=v"(l)); return wv * 64 + l; }
DI unsigned char* ws_fresh(unsigned char* w) { asm volatile("" : "+s"(w)); return w; }
DI int crow(int r, int hi) { return (r & 3) + 8 * (r >> 2) + 4 * hi; }
template <int CTRL> DI float dpp_f(float v) { return __builtin_bit_cast(float, __builtin_amdgcn_update_dpp(0, __builtin_bit_cast(int, v), CTRL, 0xf, 0xf, true)); }
DI float wave_sum(float v) {
    v += dpp_f<0xB1>(v); v += dpp_f<0x4E>(v); v += dpp_f<0x141>(v); v += dpp_f<0x140>(v);
    { auto r = __builtin_amdgcn_permlane16_swap(__float_as_uint(v), __float_as_uint(v), false, false); v = __uint_as_float(r[0]) + __uint_as_float(r[1]); }
    { auto r = __builtin_amdgcn_permlane32_swap(__float_as_uint(v), __float_as_uint(v), false, false); v = __uint_as_float(r[0]) + __uint_as_float(r[1]); }
    return v;
}
DI float quad_sum(float v) { v += dpp_f<0xB1>(v); v += dpp_f<0x4E>(v); return v; }
DI float xhalf(float v) { return __shfl_xor(v, 32); }
DI float xmax32(float v) { auto r = __builtin_amdgcn_permlane32_swap(__float_as_uint(v), __float_as_uint(v), false, false); return fmaxf(__uint_as_float(r[0]), __uint_as_float(r[1])); }
DI float xsum32(float v) { auto r = __builtin_amdgcn_permlane32_swap(__float_as_uint(v), __float_as_uint(v), false, false); return __uint_as_float(r[0]) + __uint_as_float(r[1]); }
DI float xother32(float v, int hh) { auto r = __builtin_amdgcn_permlane32_swap(__float_as_uint(v), __float_as_uint(v), false, false); return __uint_as_float(hh ? r[0] : r[1]); }
#define EXP2(x) __builtin_amdgcn_exp2f(x)
#define MFMA32(a, b, c) __builtin_amdgcn_mfma_f32_32x32x16_bf16((a), (b), (c), 0, 0, 0)

namespace pg8 {
constexpr int BM = 256, BK = 64, HALF = 128, HTB = HALF * BK * 2, STAGE_BYTES = 8 * HTB, NXCD = 8, WGM = 8;
DI int lds_byte(int r, int c) { const int st = (r >> 4) * 2 + (c >> 5), rr = r & 15, cc = c & 31, ob = rr * 64 + cc * 2; return st * 1024 + (ob ^ (((ob >> 9) & 1) << 5)); }
DI void stage_rc(int b, int& R, int& C) { const int st = b / 1024, sb = b % 1024, swz = sb ^ (((sb >> 9) & 1) << 5); R = (st >> 1) * 16 + swz / 64; C = (st & 1) * 32 + (swz % 64) / 2; }
DI int perm32(int rho) { const int n = rho >> 4, i = rho & 15; return 8 * (i >> 2) + 4 * n + (i & 3); }
struct Unit { int pm, pn; };
struct Gemm { const bf16_t* A; const bf16_t* Bt; int M, N, K; int lda; int padA; };
struct StaticOrder {
    int nM, nN, nwg, G, c;
    DI void init(int M, int N, int G_, int c_) { nM = M / BM; nN = N / BM; nwg = nM * nN; G = G_; c = c_; }
    DI bool next(int i, Unit& u) const {
        const long L = (long)i * G + c; if (L >= nwg) return false;
        int wgid = (int)L; { const int q = nwg / NXCD, r = nwg % NXCD, xcd = wgid % NXCD, off = wgid / NXCD; wgid = (xcd < r ? xcd * (q + 1) : r * (q + 1) + (xcd - r) * q) + off; }
        const int nig = WGM * nN, gid = wgid / nig, fm = gid * WGM, gsz = (nM - fm) < WGM ? (nM - fm) : WGM;
        u.pm = fm + ((wgid % nig) % gsz); u.pn = (wgid % nig) / gsz; return true;
    }
};
template <class Epi>
DI void gemm_phase(int wv, LAS unsigned char* lds, const Gemm g, const StaticOrder& S, const Epi& E) {
    const int tid = tid_fresh(wv), wid = __builtin_amdgcn_readfirstlane(tid >> 6), lane = tid & 63, wr = wid >> 2, wc = wid & 3, fr = lane & 15, fq = lane >> 4;
    const int K = g.K, nt = K / BK, lda = g.lda;
    unsigned voffA[2], voffB[2];
#pragma unroll
    for (int i = 0; i < 2; ++i) { int R, C; stage_rc(tid * 16 + i * 8192, R, C); const int Rb = (R & ~31) + perm32(R & 31);
        voffA[i] = (unsigned)(R * lda + C) * 2u; voffB[i] = (unsigned)(Rb * K + C) * 2u; }
    const size_t kstep = (size_t)(BK * 2);
    const size_t hA = (size_t)HALF * lda * 2, hB = (size_t)HALF * K * 2, tA = 2 * hA, tB = 2 * hB;
    const unsigned ldsw = (unsigned)wid * 1024u;
    const int aoff = lds_byte(wr * 64 + fr, fq * 8), boff = lds_byte(wc * 32 + fr, fq * 8);
#define PG8_SA(b, h) (((b) * 2 + (h)) * HTB)
#define PG8_SB(b, h) ((4 + (b) * 2 + (h)) * HTB)
#define PG8_STAGE(bufoff, gbase, voff) do { _Pragma("unroll") for (int _i = 0; _i < 2; ++_i) \
        __builtin_amdgcn_global_load_lds((const unsigned*)((const char*)(gbase) + (voff)[_i]), (LAS unsigned*)(lds + (bufoff) + ldsw + _i * 8192), 16, 0, 0); } while (0)
#define PG8_LDA(dst, b, h) do { _Pragma("unroll") for (int m = 0; m < 4; ++m) _Pragma("unroll") for (int k = 0; k < 2; ++k) dst[m][k] = *(const LAS bf16x8*)(lds + PG8_SA(b, h) + aoff + m * 2048 + k * 1024); } while (0)
#define PG8_LDB(dst, b, h) do { _Pragma("unroll") for (int n = 0; n < 2; ++n) _Pragma("unroll") for (int k = 0; k < 2; ++k) dst[n][k] = *(const LAS bf16x8*)(lds + PG8_SB(b, h) + boff + n * 2048 + k * 1024); } while (0)
#define PG8_MMA(ai, bj, At, Bt) do { __builtin_amdgcn_s_setprio(1); _Pragma("unroll") for (int m = 0; m < 4; ++m) _Pragma("unroll") for (int n = 0; n < 2; ++n) _Pragma("unroll") for (int k = 0; k < 2; ++k) \
        acc[ai][bj][m][n] = __builtin_amdgcn_mfma_f32_16x16x32_bf16(Bt[n][k], At[m][k], acc[ai][bj][m][n], 0, 0, 0); __builtin_amdgcn_s_setprio(0); } while (0)
#define PG8_WAIT_V(n) asm volatile("s_waitcnt vmcnt(" #n ")" ::: "memory")
#define PG8_WAIT_L(n) asm volatile("s_waitcnt lgkmcnt(" #n ")" ::: "memory")
#define PG8_BAR __builtin_amdgcn_s_barrier()
#define PG8_SCHED __builtin_amdgcn_sched_barrier(0)
#define PG8_ABASE(u) ((const char*)g.A + (size_t)(u).pm * tA + (size_t)((u).pm >> 5) * (size_t)g.padA)
    Unit cur, nxt; int ui = 0;
    if (!S.next(0, cur)) return;
    f32x4 acc[2][2][4][2];
#pragma unroll
    for (int a = 0; a < 2; ++a)
#pragma unroll
        for (int b = 0; b < 2; ++b)
#pragma unroll
            for (int m = 0; m < 4; ++m)
#pragma unroll
                for (int n = 0; n < 2; ++n) acc[a][b][m][n] = (f32x4){0.f, 0.f, 0.f, 0.f};
    bf16x8 At[4][2], B0[2][2], B1[2][2];
    const char* cA = PG8_ABASE(cur); const char* cB = (const char*)g.Bt + (size_t)cur.pn * tB;
    PG8_STAGE(PG8_SB(0, 0), cB, voffB); PG8_STAGE(PG8_SB(0, 1), cB + hB, voffB); PG8_STAGE(PG8_SA(0, 0), cA, voffA); PG8_STAGE(PG8_SA(0, 1), cA + hA, voffA);
    if (wr == 1) PG8_BAR;
    PG8_WAIT_V(2); PG8_BAR;
    PG8_STAGE(PG8_SB(1, 0), cB + kstep, voffB); PG8_STAGE(PG8_SA(1, 0), cA + kstep, voffA); PG8_STAGE(PG8_SB(1, 1), cB + hB + kstep, voffB);
    PG8_WAIT_V(6); PG8_BAR;
    for (;;) {
        const bool has_next = S.next(ui + 1, nxt);
        const char* nA = has_next ? PG8_ABASE(nxt) : cA; const char* nB = has_next ? (const char*)g.Bt + (size_t)nxt.pn * tB : cB;
#pragma unroll 1
        for (int t = 0; t < nt; t += 2) {
            const bool last = (t == nt - 2);
            const char* a1 = cA + (size_t)(t + 1) * kstep;
            const char* a2 = last ? nA : cA + (size_t)(t + 2) * kstep; const char* b2 = last ? nB : cB + (size_t)(t + 2) * kstep;
            const char* a3 = a2 + kstep; const char* b3 = b2 + kstep;
            PG8_LDB(B0, 0, 0); PG8_LDB(B1, 0, 1); PG8_SCHED; PG8_LDA(At, 0, 0); PG8_STAGE(PG8_SA(1, 1), a1 + hA, voffA);
            PG8_WAIT_V(8); PG8_WAIT_L(0); PG8_BAR; PG8_MMA(0, 0, At, B0); PG8_MMA(0, 1, At, B1); PG8_BAR; PG8_SCHED;
            PG8_LDA(At, 0, 1); PG8_STAGE(PG8_SB(0, 0), b2, voffB); PG8_STAGE(PG8_SB(0, 1), b2 + hB, voffB); PG8_STAGE(PG8_SA(0, 0), a2, voffA);
            PG8_WAIT_V(8); PG8_WAIT_L(0); PG8_BAR; PG8_MMA(1, 0, At, B0); PG8_MMA(1, 1, At, B1); PG8_BAR; PG8_SCHED;
            PG8_LDB(B0, 1, 0); PG8_LDB(B1, 1, 1); PG8_SCHED; PG8_LDA(At, 1, 0); PG8_STAGE(PG8_SA(0, 1), a2 + hA, voffA);
            PG8_WAIT_V(8); PG8_WAIT_L(0); PG8_BAR; PG8_MMA(0, 0, At, B0); PG8_MMA(0, 1, At, B1); PG8_BAR; PG8_SCHED;
            PG8_LDA(At, 1, 1); PG8_STAGE(PG8_SB(1, 0), b3, voffB); PG8_STAGE(PG8_SB(1, 1), b3 + hB, voffB); PG8_STAGE(PG8_SA(1, 0), a3, voffA);
            PG8_WAIT_V(8); PG8_WAIT_L(0); PG8_BAR; PG8_MMA(1, 0, At, B0); PG8_MMA(1, 1, At, B1); PG8_BAR; PG8_SCHED;
        }
        if (wr == 0) PG8_BAR;
        { int fr2 = fr, fq2 = fq; asm volatile("" : "+v"(fr2), "+v"(fq2)); E(acc, cur, wr, wc, fr2, fq2); }
        if (!has_next) break;
#pragma unroll
        for (int a = 0; a < 2; ++a)
#pragma unroll
            for (int b = 0; b < 2; ++b)
#pragma unroll
                for (int m = 0; m < 4; ++m)
#pragma unroll
                    for (int n = 0; n < 2; ++n) acc[a][b][m][n] = (f32x4){0.f, 0.f, 0.f, 0.f};
        cur = nxt; cA = nA; cB = nB; ++ui;
        if (wr == 1) PG8_BAR;
    }
    PG8_WAIT_V(0);
    PG8_BAR;
#undef PG8_SA
#undef PG8_SB
#undef PG8_STAGE
#undef PG8_LDA
#undef PG8_LDB
#undef PG8_MMA
#undef PG8_WAIT_V
#undef PG8_WAIT_L
#undef PG8_BAR
#undef PG8_SCHED
#undef PG8_ABASE
}
}
using pg8::Unit;
typedef f32x4 Acc[2][2][4][2];

#define EPI_ROWS(...) _Pragma("unroll") for (int ai = 0; ai < 2; ++ai) _Pragma("unroll") for (int m = 0; m < 4; ++m) { const int row = u.pm * 256 + ai * 128 + wr * 64 + m * 16 + fr; __VA_ARGS__ }
DI void st16_wt(void* p, u32x4 v) { asm volatile("global_store_dwordx4 %0, %1, off sc0 sc1\n\ts_nop 1" :: "v"(p), "v"(v) : "memory"); }
DI u32x4 pack8(f32x4 a, f32x4 b) { u32x4 w; w.x = pk2(a[0], a[1]); w.y = pk2(a[2], a[3]); w.z = pk2(b[0], b[1]); w.w = pk2(b[2], b[3]); return w; }

struct EpiF32 {
    float* O; int ldc;
    DI void operator()(const Acc& acc, const Unit& u, int wr, int wc, int fr, int fq) const {
        const int c0 = u.pn * 256 + wc * 32 + 8 * fq;
        EPI_ROWS( float* rp = O + (size_t)row * ldc + c0;
            _Pragma("unroll") for (int bj = 0; bj < 2; ++bj) { *(f32x4*)(rp + bj * 128) = acc[ai][bj][m][0]; *(f32x4*)(rp + bj * 128 + 4) = acc[ai][bj][m][1]; } )
    }
};
struct EpiBf16 {
    bf16_t* O; int ldc;
    DI void operator()(const Acc& acc, const Unit& u, int wr, int wc, int fr, int fq) const {
        const int c0 = u.pn * 256 + wc * 32 + 8 * fq;
        EPI_ROWS( bf16_t* rp = O + (size_t)row * ldc + c0;
            _Pragma("unroll") for (int bj = 0; bj < 2; ++bj) st16_wt(rp + bj * 128, pack8(acc[ai][bj][m][0], acc[ai][bj][m][1])); )
    }
};
struct EpiSwiglu {
    bf16_t* H;
    DI void operator()(const Acc& acc, const Unit& u, int wr, int wc, int fr, int fq) const {
        const int c0 = u.pn * 128 + wc * 32 + 8 * fq;
        EPI_ROWS( f32x4 a, b;
            _Pragma("unroll") for (int e = 0; e < 4; ++e) { a[e] = siluf_(acc[ai][0][m][0][e]) * acc[ai][1][m][0][e]; b[e] = siluf_(acc[ai][0][m][1][e]) * acc[ai][1][m][1][e]; }
            st16_wt(H + (size_t)row * DFF + c0, pack8(a, b)); )
    }
};
#define TS_(e) { const unsigned w0_ = pk2(ta0[e], ta1[e]); vt[(size_t)(e) * SEQ] = (bf16_t)(w0_ & 0xffff); vt[(size_t)((e) + 4) * SEQ] = (bf16_t)(w0_ >> 16); }
#define GV_(n, e) { const int c_ = cb + 4 * (n) + (e); const float v_ = (n) ? tb1[e] : tb0[e]; if (c_ < 24) GATES[(size_t)row * 24 + c_] = sigmoidf_(v_); else if (c_ < 40) DT[(size_t)row * 16 + c_ - 24] = softplus_fast(v_ + dt_bias[c_ - 24]); }
struct EpiWin {
    unsigned char* ws; const float* dt_bias;
    DI void operator()(const Acc& acc, const Unit& u, int wr, int wc, int fr, int fq) const {
        const int pn = u.pn;
        bf16_t* const Q = (bf16_t*)(ws + WS_Q); bf16_t* const VCN = (bf16_t*)(ws + WS_VCN); bf16_t* const VST = (bf16_t*)(ws + WS_VST); bf16_t* const VWT = (bf16_t*)(ws + WS_VWT);
        float* const GATES = (float*)(ws + WS_GATES); float* const DT = (float*)(ws + WS_DT); const float* const cosT = (const float*)(ws + WS_ROPE); const float* const sinT = cosT + SEQ * 32;
        if (pn <= 3) {
            if (pn == 3 && wc >= 2) return;
            const int d0 = 8 * fq;
            EPI_ROWS( const int t = row & (SEQ - 1), b = row >> 13;
                const f32x4 c0 = *(const f32x4*)(cosT + t * 32 + d0), c1 = *(const f32x4*)(cosT + t * 32 + d0 + 4);
                const f32x4 s0 = *(const f32x4*)(sinT + t * 32 + d0), s1 = *(const f32x4*)(sinT + t * 32 + d0 + 4);
                const f32x4 x10 = acc[ai][0][m][0], x11 = acc[ai][0][m][1], x20 = acc[ai][1][m][0], x21 = acc[ai][1][m][1];
                f32x4 o10 = x10 * c0 - x20 * s0, o11 = x11 * c1 - x21 * s1, o20 = x20 * c0 + x10 * s0, o21 = x21 * c1 + x11 * s1;
                bf16_t* dst;
                if (pn < 2) { const float qs = 0.125f * 1.4426950408889634f; o10 *= qs; o11 *= qs; o20 *= qs; o21 *= qs; dst = Q + (size_t)row * 512 + (pn * 4 + wc) * 64; }
                else { const size_t boff = (pn == 2) ? (wc < 2 ? WS_KCN : WS_KS) : WS_KW; dst = (bf16_t*)(ws + boff) + ((size_t)(b * 2 + (wc & 1)) * SEQ + t) * 64; }
                *(u32x4*)(dst + d0) = pack8(o10, o11); *(u32x4*)(dst + 32 + d0) = pack8(o20, o21); asm volatile("" ::: "memory"); )
        } else if (pn == 4 || pn == 5) {
            const int h = wc >> 1, d0 = (wc & 1) * 32 + 8 * fq;
            EPI_ROWS( const int t = row & (SEQ - 1), b = row >> 13;
                if (pn == 4) *(u32x4*)(VCN + ((size_t)(b * 2 + h) * SEQ + t) * 64 + d0) = pack8(acc[ai][0][m][0], acc[ai][0][m][1]);
                if (pn == 4) { bf16_t* vt = VST + ((size_t)(b * 2 + h) * 64 + d0) * SEQ + t; const f32x4 ta0 = acc[ai][1][m][0], ta1 = acc[ai][1][m][1]; TS_(0) TS_(1) TS_(2) TS_(3) }
                else { bf16_t* vt = VWT + ((size_t)(b * 2 + h) * 64 + d0) * SEQ + t; const f32x4 ta0 = acc[ai][0][m][0], ta1 = acc[ai][0][m][1]; TS_(0) TS_(1) TS_(2) TS_(3)
                  const int cb = wc * 32 + 8 * fq; const f32x4 tb0 = acc[ai][1][m][0], tb1 = acc[ai][1][m][1];
                  if (cb < 40) { GV_(0, 0) GV_(0, 1) GV_(0, 2) GV_(0, 3) GV_(1, 0) GV_(1, 1) GV_(1, 2) GV_(1, 3) } } )
        } else {
            bf16_t* O = (bf16_t*)(ws + ((pn < 10) ? WS_Z : WS_XBC)); const int ldc = (pn < 10) ? 1024 : 1536; const int c0 = (pn < 10 ? (pn - 6) : (pn - 10)) * 256 + wc * 32 + 8 * fq;
            EPI_ROWS( bf16_t* rp = O + (size_t)row * ldc + c0;
                _Pragma("unroll") for (int bj = 0; bj < 2; ++bj) st16_wt(rp + bj * 128, pack8(acc[ai][bj][m][0], acc[ai][bj][m][1])); )
        }
    }
};
struct EpiRwkv1 {
    unsigned char* ws;
    DI void operator()(const Acc& acc, const Unit& u, int wr, int wc, int fr, int fq) const {
        const int pn = u.pn; bf16_t* const LH = (bf16_t*)(ws + WS_LH);
        if (pn < 12) { bf16_t* O = (bf16_t*)(ws + (pn < 4 ? WS_R : (pn < 8 ? WS_K : WS_V))); const int c0 = (pn & 3) * 256 + wc * 32 + 8 * fq;
            EPI_ROWS( bf16_t* rp = O + (size_t)row * 1024 + c0;
                _Pragma("unroll") for (int bj = 0; bj < 2; ++bj) st16_wt(rp + bj * 128, pack8(acc[ai][bj][m][0], acc[ai][bj][m][1])); )
        } else {
            EPI_ROWS( _Pragma("unroll") for (int bj = 0; bj < 2; ++bj) { const int c0 = (pn - 12) * 256 + bj * 128 + wc * 32 + 8 * fq; f32x4 a = acc[ai][bj][m][0], b = acc[ai][bj][m][1];
                    if (c0 < 64) { _Pragma("unroll") for (int e = 0; e < 4; ++e) { a[e] = tanh_fast(a[e]); b[e] = tanh_fast(b[e]); } }
                    else if (c0 >= 128) { _Pragma("unroll") for (int e = 0; e < 4; ++e) { a[e] = sigmoidf_(a[e]); b[e] = sigmoidf_(b[e]); } }
                    *(u32x4*)(LH + (size_t)row * 512 + c0) = pack8(a, b); } )
        }
    }
};
struct EpiRwkv2 {
    _Float16* LD; bf16_t* AA; const float *w0, *a0;
    DI void operator()(const Acc& acc, const Unit& u, int wr, int wc, int fr, int fq) const {
        const int pn = u.pn;
        EPI_ROWS( _Pragma("unroll") for (int bj = 0; bj < 2; ++bj) { const int c0 = (pn & 3) * 256 + bj * 128 + wc * 32 + 8 * fq;
                if (pn < 4) { u32x4 o;
                    _Pragma("unroll") for (int n = 0; n < 2; ++n) _Pragma("unroll") for (int e2 = 0; e2 < 2; ++e2) {
                        const float wa = -softplus_fast(-(w0[c0 + 4 * n + 2 * e2] + acc[ai][bj][m][n][2 * e2])) - 0.5f, wb = -softplus_fast(-(w0[c0 + 4 * n + 2 * e2 + 1] + acc[ai][bj][m][n][2 * e2 + 1])) - 0.5f;
                        h16x2 hv = {(_Float16)(-__expf(wa)), (_Float16)(-__expf(wb))}; o[2 * n + e2] = __builtin_bit_cast(unsigned, hv); }
                    *(u32x4*)(LD + (size_t)row * 1024 + c0) = o;
                } else { f32x4 a, b;
                    _Pragma("unroll") for (int e = 0; e < 4; ++e) { a[e] = sigmoidf_(a0[c0 + e] + acc[ai][bj][m][0][e]); b[e] = sigmoidf_(a0[c0 + 4 + e] + acc[ai][bj][m][1][e]); }
                    *(u32x4*)(AA + (size_t)row * 1024 + c0) = pack8(a, b); } } )
    }
};

struct CvtJob { const float* src; const float* scale; bf16_t* dst; int ldw, K, N, ldk, koff, mode, rowoff, smode; };
struct ZeroJob { bf16_t* dst; int rows, ldk, c0, nc; int pad; };
constexpr int MAXJ = 20, MAXZ = 8;
struct JobSet { CvtJob cj[MAXJ]; ZeroJob zj[MAXZ]; int ncj, nzj; };
struct Params {
    const float* in[40]; float* out; unsigned char* ws;
    JobSet js[2];
    CvtJob ffn2[2][3];
};

DI int win_rowmap(int c) {
    if (c < 512) { const int hq = c >> 6, d = c & 63; return (hq >> 2) * 256 + (d < 32 ? 0 : 128) + (hq & 3) * 32 + (d & 31); }
    if (c < 1280) { const int seg = (c - 512) >> 7, cc = (c - 512) & 127, h = cc >> 6, d = cc & 63;
        if (seg == 0 || seg == 2 || seg == 4) { const int tile = (seg == 4) ? 3 : 2, hl = (seg == 2 ? 2 : 0) + h; return tile * 256 + (d < 32 ? 0 : 128) + hl * 32 + (d & 31); }
        if (seg == 1) return 1024 + cc; if (seg == 3) return 1024 + 128 + cc; return 1280 + cc; }
    if (c < 1304) return 1280 + 128 + (c - 1280);
    if (c < 2328) return 1536 + (c - 1304);
    if (c < 3864) return 2560 + (c - 2328);
    return 1280 + 128 + 24 + (c - 3864);
}
DI void cvt_item(const CvtJob& J, int item, LAS float* scr, int lane) {
    const int nblk = (J.N + 31) >> 5, kb = item / nblk, nb = item % nblk, k0 = 64 * kb, n0 = 32 * nb;
#pragma unroll 8
    for (int i = 0; i < 32; ++i) { const int kk = 2 * i + (lane >> 5), k = k0 + kk, n = n0 + (lane & 31);
        float v = 0.f; if (k < J.K && n < J.N) { v = J.src[(size_t)k * J.ldw + n]; if (J.smode == 1) v *= J.scale[k]; else if (J.smode == 2) v *= (1.f - J.scale[k]); }
        scr[kk * 33 + (lane & 31)] = v; }
    asm volatile("s_waitcnt lgkmcnt(0)" ::: "memory");
    const int c = lane & 7;
#pragma unroll
    for (int j = 0; j < 4; ++j) { const int nl = (lane >> 3) + 8 * j, n = n0 + nl; const LAS float* s = scr + (8 * c) * 33 + nl;
        if (n < J.N) { u32x4 o; o.x = pk2(s[0], s[33]); o.y = pk2(s[2 * 33], s[3 * 33]); o.z = pk2(s[4 * 33], s[5 * 33]); o.w = pk2(s[6 * 33], s[7 * 33]);
            int row; if (J.mode == 0) row = J.rowoff + n; else if (J.mode == 1) row = (n >> 7) * 256 + (n & 127) + J.rowoff; else row = win_rowmap(n);
            *(u32x4*)(J.dst + (size_t)row * J.ldk + J.koff + k0 + 8 * c) = o; } }
    asm volatile("s_waitcnt lgkmcnt(0)" ::: "memory");
}
DI void run_jobs(int wv, const CvtJob* cjs, int ncj, const ZeroJob* zjs, int nzj, LAS unsigned char* lds) {
    const int tid_ = tid_fresh(wv);
    const int lane = tid_ & 63, wave = tid_ >> 6, gw = blockIdx.x * NWAVES + wave, NGW = gridDim.x * NWAVES;
    LAS float* scr = (LAS float*)(lds + wave * 16384);
    int base = 0;
    for (int j = 0; j < ncj; ++j) { const CvtJob& J = cjs[j]; const int nit = ((J.K + 63) >> 6) * ((J.N + 31) >> 5);
        int first = (gw - base) % NGW; if (first < 0) first += NGW;
        for (int it = first; it < nit; it += NGW) cvt_item(J, it, scr, lane);
        base = (base + nit) % NGW; }
    const int gt = blockIdx.x * NTHREADS + tid_, NGT = gridDim.x * NTHREADS;
    for (int j = 0; j < nzj; ++j) { const ZeroJob& Z = zjs[j]; const int per = Z.nc >> 3, tot = Z.rows * per;
        for (int i = gt; i < tot; i += NGT) { const int r = i / per, c = (i % per) * 8; *(u32x4*)(Z.dst + (size_t)r * Z.ldk + Z.c0 + c) = (u32x4){0u, 0u, 0u, 0u}; } }
}

DI void row_phase(int wv, int mode, const float* X, const bf16_t* Y, const float* ga, float coef, const float* gb, float* Xout, bf16_t* A, int a_pad) {
    const int tid_ = tid_fresh(wv);
    const int lane = tid_ & 63, gw = blockIdx.x * NWAVES + (tid_ >> 6), NGW = gridDim.x * NWAVES;
    for (int r = gw; r < MTOK; r += NGW) {
        f32x4 v[4];
#pragma unroll
        for (int j = 0; j < 4; ++j) v[j] = *(const f32x4*)(X + (size_t)r * DM + 4 * lane + 256 * j);
        if (mode == 1) { f32x4 y[4]; float s = 0.f;
#pragma unroll
            for (int j = 0; j < 4; ++j) { const u32x2 yv = *(const u32x2*)(Y + (size_t)r * DM + 4 * lane + 256 * j); y[j] = (f32x4){bflo(yv.x), bfhi(yv.x), bflo(yv.y), bfhi(yv.y)}; s += y[j][0] * y[j][0] + y[j][1] * y[j][1] + y[j][2] * y[j][2] + y[j][3] * y[j][3]; }
            const float rs = coef * rsqrtf(wave_sum(s) * (1.f / DM) + 1e-6f);
#pragma unroll
            for (int j = 0; j < 4; ++j) { const f32x4 gg = *(const f32x4*)(ga + 4 * lane + 256 * j); v[j] += y[j] * gg * rs; } }
        if (Xout) {
#pragma unroll
            for (int j = 0; j < 4; ++j) st16_wt(Xout + (size_t)r * DM + 4 * lane + 256 * j, __builtin_bit_cast(u32x4, v[j])); }
        if (gb) { float s = 0.f;
#pragma unroll
            for (int j = 0; j < 4; ++j) s += v[j][0] * v[j][0] + v[j][1] * v[j][1] + v[j][2] * v[j][2] + v[j][3] * v[j][3];
            const float rs = rsqrtf(wave_sum(s) * (1.f / DM) + 1e-6f);
            const size_t ar = a_pad ? (size_t)(r + (r >> 13) + 1) : (size_t)r;
#pragma unroll
            for (int j = 0; j < 4; ++j) { const f32x4 gg = *(const f32x4*)(gb + 4 * lane + 256 * j); const f32x4 o = v[j] * gg * rs;
                u32x2 w; w.x = pk2(o[0], o[1]); w.y = pk2(o[2], o[3]); *(u32x2*)(A + ar * DM + 4 * lane + 256 * j) = w; } }
    }
    if (a_pad && gb) { const int gt = blockIdx.x * NTHREADS + tid_; if (gt < 256) { const int b = gt >> 7, c = (gt & 127) * 8; *(u32x4*)(A + (size_t)b * (SEQ + 1) * DM + c) = (u32x4){0u, 0u, 0u, 0u}; } }
}

DI void p0_misc(int wv, const Params& P, LAS unsigned char* lds) {
    unsigned char* const ws_ = ws_fresh(P.ws);
    const int tid_ = tid_fresh(wv);
    float* cosT = (float*)(ws_ + WS_ROPE); float* sinT = cosT + SEQ * 32;
    const int gt = blockIdx.x * NTHREADS + tid_, NGT = gridDim.x * NTHREADS;
    for (int i = gt; i < SEQ * 32; i += NGT) { const int t = i >> 5, k = i & 31; const float inv = powf(10000.f, -(float)(2 * k) / 64.f); const float ang = (float)t * inv; cosT[i] = cosf(ang); sinT[i] = sinf(ang); }
    if (blockIdx.x < 2) {
        const float* pe = P.in[blockIdx.x == 0 ? 9 : 12]; const float* w1 = P.in[blockIdx.x == 0 ? 10 : 13];
        LAS float* red = (LAS float*)lds; const int j = tid_ & 63, part = tid_ >> 6; float s = 0.f;
        for (int k = part; k < 2048; k += 8) s += pe[k] * w1[k * 64 + j];
        red[part * 64 + j] = s; __syncthreads();
        if (tid_ < 64) { float t = 0.f; for (int p = 0; p < 8; ++p) t += red[p * 64 + j]; ((float*)(ws_ + WS_PEB))[blockIdx.x * 64 + j] = t; }
        __syncthreads();
    }
}

DI void conv_phase(int wv, const Params& P) {
    unsigned char* const ws_ = ws_fresh(P.ws);
    const int tid_ = tid_fresh(wv);
    const bf16_t* XBC = (const bf16_t*)(ws_ + WS_XBC); bf16_t* XS = (bf16_t*)(ws_ + WS_XS); bf16_t* BM = (bf16_t*)(ws_ + WS_BM); bf16_t* BMT = (bf16_t*)(ws_ + WS_BMT); bf16_t* CM = (bf16_t*)(ws_ + WS_CM);
    const float* cw = P.in[15]; const float* cb = P.in[16];
    const int gt = blockIdx.x * NTHREADS + tid_, NGT = gridDim.x * NTHREADS;
    for (int it = gt; it < (MTOK / 8) * 192; it += NGT) {
        const int tt = it / 192, cg8 = it % 192, c0 = cg8 * 8, r0 = tt * 8, t0 = r0 & (SEQ - 1), b = r0 >> 13;
        float w[4][8], bias[8];
#pragma unroll
        for (int k = 0; k < 4; ++k) { const f32x4 a = *(const f32x4*)(cw + k * 1536 + c0), bq = *(const f32x4*)(cw + k * 1536 + c0 + 4);
#pragma unroll
            for (int e = 0; e < 4; ++e) { w[k][e] = a[e]; w[k][4 + e] = bq[e]; } }
        { const f32x4 a = *(const f32x4*)(cb + c0), bq = *(const f32x4*)(cb + c0 + 4);
#pragma unroll
          for (int e = 0; e < 4; ++e) { bias[e] = a[e]; bias[4 + e] = bq[e]; } }
        float x[11][8];
#pragma unroll
        for (int i = 0; i < 11; ++i) { u32x4 q = (u32x4){0u, 0u, 0u, 0u}; if (i >= 3 || t0 != 0) q = *(const u32x4*)(XBC + (size_t)(r0 + i - 3) * 1536 + c0);
#pragma unroll
            for (int e = 0; e < 4; ++e) { x[i][2 * e] = bflo(q[e]); x[i][2 * e + 1] = bfhi(q[e]); } }
        unsigned o[8][4];
#pragma unroll
        for (int i = 0; i < 8; ++i) { float y[8];
#pragma unroll
            for (int e = 0; e < 8; ++e) { float s = bias[e];
#pragma unroll
                for (int k = 0; k < 4; ++k) s += w[k][e] * x[i + k][e];
                y[e] = siluf_(s); }
#pragma unroll
            for (int e = 0; e < 4; ++e) o[i][e] = pk2(y[2 * e], y[2 * e + 1]); }
        if (c0 < 1024) {
#pragma unroll
            for (int i = 0; i < 8; ++i) *(u32x4*)(XS + (size_t)(r0 + i) * 1024 + c0) = (u32x4){o[i][0], o[i][1], o[i][2], o[i][3]};
        } else if (c0 < 1280) { const int cc = c0 - 1024, g = cc >> 7, n0 = cc & 127;
#pragma unroll
            for (int i = 0; i < 8; ++i) *(u32x4*)(BM + (size_t)(r0 + i) * 256 + cc) = (u32x4){o[i][0], o[i][1], o[i][2], o[i][3]};
#pragma unroll
            for (int e = 0; e < 8; ++e) { u32x4 q;
#pragma unroll
                for (int i2 = 0; i2 < 4; ++i2) { const unsigned lo = (o[2 * i2][e >> 1] >> ((e & 1) * 16)) & 0xffffu, hi = (o[2 * i2 + 1][e >> 1] >> ((e & 1) * 16)) & 0xffffu; q[i2] = lo | (hi << 16); }
                *(u32x4*)(BMT + ((size_t)(b * 2 + g) * 128 + n0 + e) * SEQ + t0) = q; }
        } else { const int cc = c0 - 1280;
#pragma unroll
            for (int i = 0; i < 8; ++i) *(u32x4*)(CM + (size_t)(r0 + i) * 256 + cc) = (u32x4){o[i][0], o[i][1], o[i][2], o[i][3]};
        }
    }
}

DI void cmp_finish_phase(int wv, const Params& P) {
    unsigned char* const ws_ = ws_fresh(P.ws);
    const int tid_ = tid_fresh(wv);
    const int lane = tid_ & 63, gw = blockIdx.x * NWAVES + (tid_ >> 6), NGW = gridDim.x * NWAVES;
    bf16_t* KCC = (bf16_t*)(ws_ + WS_KCC); bf16_t* VCCT = (bf16_t*)(ws_ + WS_VCCT); const float* peb = (const float*)(ws_ + WS_PEB);
    for (int r = gw; r < 4096; r += NGW) {
        const int kv = r >> 11, bh = (r >> 9) & 3, n = r & 511;
        const float* PP = (const float*)(ws_ + (kv ? WS_PV : WS_PK)); const float* w2 = P.in[kv ? 14 : 11];
        float out = 0.f;
        if (n < 511) {
            const float pre = PP[(size_t)(bh * 512 + n) * 256 + lane] + PP[(size_t)(bh * 512 + n + 1) * 256 + 64 + lane] + peb[kv * 64 + lane];
            const float hid = siluf_(pre);
#pragma unroll 8
            for (int i = 0; i < 64; ++i) out += __shfl(hid, i) * w2[i * 64 + lane];
        }
        const bf16_t ob = (bf16_t)(pk2(out, 0.f) & 0xffff);
        if (kv == 0) KCC[(size_t)(bh * 512 + n) * 64 + lane] = ob; else VCCT[(size_t)(bh * 64 + lane) * 512 + n] = ob;
    }
}

DI void ssd_acs(const float* DT, int row0, int h, float a, LAS float* acs, int lane) {
    float v0 = DT[(size_t)(row0 + lane) * 16 + h] * a, v1 = DT[(size_t)(row0 + 64 + lane) * 16 + h] * a;
#pragma unroll
    for (int o = 1; o < 64; o <<= 1) { const float t0 = __shfl_up(v0, o), t1 = __shfl_up(v1, o); if (lane >= o) { v0 += t0; v1 += t1; } }
    const float tot0 = __shfl(v0, 63);
    acs[lane] = v0; acs[64 + lane] = v1 + tot0;
    asm volatile("s_waitcnt lgkmcnt(0)" ::: "memory");
}
constexpr int XT_LD = 136;
DI void ssd_states_phase(int wv, const Params& P, LAS unsigned char* lds) {
    unsigned char* const ws_ = ws_fresh(P.ws);
    const int tid_ = tid_fresh(wv);
    const int lane = tid_ & 63, wave = tid_ >> 6, q = lane & 31, hh = lane >> 5;
    const float* DT = (const float*)(ws_ + WS_DT); const bf16_t* XS = (const bf16_t*)(ws_ + WS_XS); const bf16_t* BMT = (const bf16_t*)(ws_ + WS_BMT);
    bf16_t* ST = (bf16_t*)(ws_ + WS_ST); float* CDEC = (float*)(ws_ + WS_CDEC);
    LAS bf16_t* xt = (LAS bf16_t*)(lds + wave * (64 * XT_LD * 2));
    LAS float* acs = (LAS float*)(lds + 8 * 64 * XT_LD * 2 + wave * 512);
    for (int u = blockIdx.x; u < 256; u += gridDim.x) {
        const int b = u >> 7, c = (u >> 1) & 63, g = u & 1, h = g * 8 + wave, row0 = b * SEQ + c * 128;
        const float a = -expf(P.in[18][h]);
        ssd_acs(DT, row0, h, a, acs, lane);
        const float alast = acs[127];
        if (lane == 0) CDEC[(b * 64 + c) * 16 + h] = expf(alast);
        for (int it = lane; it < 1024; it += 64) { const int l = it >> 3, pg = (it & 7) * 8; const float sc = DT[(size_t)(row0 + l) * 16 + h] * expf(alast - acs[l]);
            const u32x4 v = *(const u32x4*)(XS + (size_t)(row0 + l) * 1024 + h * 64 + pg);
#pragma unroll
            for (int e = 0; e < 4; ++e) { const unsigned w = pk2(bflo(v[e]) * sc, bfhi(v[e]) * sc); xt[(pg + 2 * e) * XT_LD + l] = (bf16_t)(w & 0xffff); xt[(pg + 2 * e + 1) * XT_LD + l] = (bf16_t)(w >> 16); } }
        asm volatile("s_waitcnt lgkmcnt(0)" ::: "memory");
        f32x16 acc[4][2];
#pragma unroll
        for (int i = 0; i < 4; ++i) { acc[i][0] = f32x16{}; acc[i][1] = f32x16{}; }
        const bf16_t* bt = BMT + ((size_t)(b * 2 + g) * 128 + q) * SEQ + c * 128 + 8 * hh;
#pragma unroll 2
        for (int ks = 0; ks < 8; ++ks) {
            bf16x8 bf[2];
#pragma unroll
            for (int pt = 0; pt < 2; ++pt) bf[pt] = *(const LAS bf16x8*)(xt + (pt * 32 + q) * XT_LD + ks * 16 + 8 * hh);
#pragma unroll
            for (int nt = 0; nt < 4; ++nt) { const bf16x8 af = *(const bf16x8*)(bt + (size_t)nt * 32 * SEQ + ks * 16);
                acc[nt][0] = MFMA32(af, bf[0], acc[nt][0]); acc[nt][1] = MFMA32(af, bf[1], acc[nt][1]); }
        }
        bf16_t* st = ST + ((size_t)((b * 64 + c) * 16 + h) * 64) * 128;
#pragma unroll
        for (int nt = 0; nt < 4; ++nt)
#pragma unroll
            for (int pt = 0; pt < 2; ++pt)
#pragma unroll
                for (int i4 = 0; i4 < 4; ++i4) { u32x2 w; w.x = pk2(acc[nt][pt][4 * i4], acc[nt][pt][4 * i4 + 1]); w.y = pk2(acc[nt][pt][4 * i4 + 2], acc[nt][pt][4 * i4 + 3]);
                    *(u32x2*)(st + (size_t)(pt * 32 + q) * 128 + nt * 32 + 8 * i4 + 4 * hh) = w; }
        asm volatile("s_waitcnt lgkmcnt(0)" ::: "memory");
    }
}
DI void ssd_scan_phase(int wv, const Params& P) {
    unsigned char* const ws_ = ws_fresh(P.ws);
    const int tid_ = tid_fresh(wv);
    bf16_t* ST = (bf16_t*)(ws_ + WS_ST); const float* CDEC = (const float*)(ws_ + WS_CDEC);
    const int gt = blockIdx.x * NTHREADS + tid_, NGT = gridDim.x * NTHREADS;
    for (int e = gt; e < 2 * 16 * 64 * 64; e += NGT) {
        const int b = e >> 16, h = (e >> 12) & 15, pn2 = e & 4095; float c0 = 0.f, c1 = 0.f;
#pragma unroll 8
        for (int c = 0; c < 64; ++c) { unsigned* p = (unsigned*)(ST + ((size_t)((b * 64 + c) * 16 + h) * 64) * 128) + pn2; const unsigned s = *p; const float d = CDEC[(b * 64 + c) * 16 + h];
            *p = pk2(c0, c1); c0 = c0 * d + bflo(s); c1 = c1 * d + bfhi(s); }
    }
}
DI void ssd_out_phase(int wv, const Params& P, LAS unsigned char* lds) {
    unsigned char* const ws_ = ws_fresh(P.ws);
    const int tid_ = tid_fresh(wv);
    const int lane = tid_ & 63, wave = tid_ >> 6, q = lane & 31, hh = lane >> 5;
    const float* DT = (const float*)(ws_ + WS_DT); const bf16_t* XS = (const bf16_t*)(ws_ + WS_XS); const bf16_t* BM = (const bf16_t*)(ws_ + WS_BM); const bf16_t* CM = (const bf16_t*)(ws_ + WS_CM);
    const bf16_t* ST = (const bf16_t*)(ws_ + WS_ST); const bf16_t* Z = (const bf16_t*)(ws_ + WS_Z); bf16_t* OCAT = (bf16_t*)(ws_ + WS_OCAT);
    constexpr int XH_LD = 72;
    LAS bf16_t* cbl = (LAS bf16_t*)lds;
    LAS bf16_t* xt = (LAS bf16_t*)(lds + 128 * XT_LD * 2 + wave * (64 * XH_LD * 2));
    LAS float* acs = (LAS float*)(lds + 128 * XT_LD * 2 + 8 * 64 * XH_LD * 2 + wave * 512);
    LAS float* ssq = (LAS float*)(lds + 128 * XT_LD * 2 + 8 * 64 * XH_LD * 2 + 4096);
    for (int u = blockIdx.x; u < 256; u += gridDim.x) {
        const int b = u >> 7, c = (u >> 1) & 63, g = u & 1, h = g * 8 + wave, row0 = b * SEQ + c * 128;
        __syncthreads();
        { const int st_ = wave >> 1;
#pragma unroll
          for (int li = 0; li < 2; ++li) { const int lt = 2 * (wave & 1) + li; f32x16 d = f32x16{};
#pragma unroll
            for (int ks = 0; ks < 8; ++ks) { const bf16x8 af = *(const bf16x8*)(BM + (size_t)(row0 + st_ * 32 + q) * 256 + g * 128 + ks * 16 + 8 * hh);
                const bf16x8 bfr = *(const bf16x8*)(CM + (size_t)(row0 + lt * 32 + q) * 256 + g * 128 + ks * 16 + 8 * hh); d = MFMA32(af, bfr, d); }
#pragma unroll
            for (int i4 = 0; i4 < 4; ++i4) { u32x2 w; w.x = pk2(d[4 * i4], d[4 * i4 + 1]); w.y = pk2(d[4 * i4 + 2], d[4 * i4 + 3]);
                *(LAS u32x2*)(cbl + (lt * 32 + q) * XT_LD + st_ * 32 + 8 * i4 + 4 * hh) = w; } } }
        const float a = -expf(P.in[18][h]);
        ssd_acs(DT, row0, h, a, acs, lane);
        __syncthreads();
        f32x16 acc[2][4];
#pragma unroll
        for (int i = 0; i < 2; ++i)
#pragma unroll
            for (int j = 0; j < 4; ++j) acc[i][j] = f32x16{};
        { const bf16_t* st = ST + ((size_t)((b * 64 + c) * 16 + h) * 64) * 128;
#pragma unroll 2
          for (int ks = 0; ks < 8; ++ks) { bf16x8 af[2];
#pragma unroll
            for (int pt = 0; pt < 2; ++pt) af[pt] = *(const bf16x8*)(st + (size_t)(pt * 32 + q) * 128 + ks * 16 + 8 * hh);
#pragma unroll
            for (int lt = 0; lt < 4; ++lt) { const bf16x8 bfr = *(const bf16x8*)(CM + (size_t)(row0 + lt * 32 + q) * 256 + g * 128 + ks * 16 + 8 * hh);
                acc[0][lt] = MFMA32(af[0], bfr, acc[0][lt]); acc[1][lt] = MFMA32(af[1], bfr, acc[1][lt]); } } }
        float acl[4];
#pragma unroll
        for (int lt = 0; lt < 4; ++lt) { acl[lt] = acs[lt * 32 + q]; const float e = expf(acl[lt]);
#pragma unroll
            for (int i = 0; i < 16; ++i) { acc[0][lt][i] *= e; acc[1][lt][i] *= e; } }
#pragma unroll 1
        for (int sh = 0; sh < 2; ++sh) {
            for (int it = lane; it < 512; it += 64) { const int s = it >> 3, pg = (it & 7) * 8; const int sg = sh * 64 + s; const float sc = DT[(size_t)(row0 + sg) * 16 + h];
                const u32x4 v = *(const u32x4*)(XS + (size_t)(row0 + sg) * 1024 + h * 64 + pg);
#pragma unroll
                for (int e = 0; e < 4; ++e) { const unsigned w = pk2(bflo(v[e]) * sc, bfhi(v[e]) * sc); xt[(pg + 2 * e) * XH_LD + s] = (bf16_t)(w & 0xffff); xt[(pg + 2 * e + 1) * XH_LD + s] = (bf16_t)(w >> 16); } }
            asm volatile("s_waitcnt lgkmcnt(0)" ::: "memory");
#pragma unroll 1
            for (int ks = 0; ks < 4; ++ks) { const int s0 = sh * 64 + ks * 16 + 8 * hh;
                bf16x8 af[2];
#pragma unroll
                for (int pt = 0; pt < 2; ++pt) af[pt] = *(const LAS bf16x8*)(xt + (pt * 32 + q) * XH_LD + ks * 16 + 8 * hh);
                float as8[8];
#pragma unroll
                for (int j = 0; j < 8; ++j) as8[j] = acs[s0 + j];
#pragma unroll
                for (int lt = 0; lt < 4; ++lt) { if (lt * 32 + 31 < sh * 64 + ks * 16) continue;
                    const int l = lt * 32 + q; const u32x4 cv = *(const LAS u32x4*)(cbl + l * XT_LD + s0); float mv[8];
#pragma unroll
                    for (int j = 0; j < 4; ++j) { mv[2 * j] = bflo(cv[j]); mv[2 * j + 1] = bfhi(cv[j]); }
#pragma unroll
                    for (int j = 0; j < 8; ++j) mv[j] = (s0 + j <= l) ? mv[j] * __expf(acl[lt] - as8[j]) : 0.f;
                    u32x4 pw; pw.x = pk2(mv[0], mv[1]); pw.y = pk2(mv[2], mv[3]); pw.z = pk2(mv[4], mv[5]); pw.w = pk2(mv[6], mv[7]);
                    const bf16x8 bfr = __builtin_bit_cast(bf16x8, pw);
                    acc[0][lt] = MFMA32(af[0], bfr, acc[0][lt]); acc[1][lt] = MFMA32(af[1], bfr, acc[1][lt]); } }
            asm volatile("s_waitcnt lgkmcnt(0)" ::: "memory");
        }
        const float dsk = P.in[19][h];
#pragma unroll
        for (int lt = 0; lt < 4; ++lt) { const size_t rr = (size_t)(row0 + lt * 32 + q); float ss = 0.f;
#pragma unroll
            for (int pt = 0; pt < 2; ++pt)
#pragma unroll
                for (int i4 = 0; i4 < 4; ++i4) { const int p0 = h * 64 + pt * 32 + 8 * i4 + 4 * hh; const u32x2 xv = *(const u32x2*)(XS + rr * 1024 + p0), zv = *(const u32x2*)(Z + rr * 1024 + p0);
                    const float xs4[4] = {bflo(xv.x), bfhi(xv.x), bflo(xv.y), bfhi(xv.y)}, zs4[4] = {bflo(zv.x), bfhi(zv.x), bflo(zv.y), bfhi(zv.y)};
#pragma unroll
                    for (int e = 0; e < 4; ++e) { const float y = (acc[pt][lt][4 * i4 + e] + xs4[e] * dsk) * siluf_(zs4[e]); acc[pt][lt][4 * i4 + e] = y; ss += y * y; } }
            ss += xhalf(ss); if (hh == 0) ssq[wave * 128 + lt * 32 + q] = ss; }
        __syncthreads();
        const float* nw = P.in[20];
#pragma unroll
        for (int lt = 0; lt < 4; ++lt) { float tot = 0.f;
#pragma unroll
            for (int w = 0; w < 8; ++w) tot += ssq[w * 128 + lt * 32 + q];
            const float rs = rsqrtf(tot * (1.f / 512.f) + 1e-5f); const size_t rr = (size_t)(row0 + lt * 32 + q);
#pragma unroll
            for (int pt = 0; pt < 2; ++pt)
#pragma unroll
                for (int i4 = 0; i4 < 4; ++i4) { const int p0 = h * 64 + pt * 32 + 8 * i4 + 4 * hh; const f32x4 nv = *(const f32x4*)(nw + p0);
                    u32x2 w; w.x = pk2(acc[pt][lt][4 * i4] * rs * nv[0], acc[pt][lt][4 * i4 + 1] * rs * nv[1]); w.y = pk2(acc[pt][lt][4 * i4 + 2] * rs * nv[2], acc[pt][lt][4 * i4 + 3] * rs * nv[3]);
                    *(u32x2*)(OCAT + rr * 1536 + 512 + p0) = w; } }
    }
    __syncthreads();
}

struct AttnState { float m, l; f32x16 o[2]; };
DI void qk_tile(f32x16& s, const bf16_t* K, int key0, const bf16x8* qf, int q, int hh) {
    const bf16_t* kp = K + (size_t)(key0 + q) * 64 + 8 * hh; s = f32x16{};
#pragma unroll
    for (int ks = 0; ks < 4; ++ks) { const bf16x8 af = *(const bf16x8*)(kp + 16 * ks); s = MFMA32(af, qf[ks], s); }
}
DI void pv_tile(f32x16* o, const float* p, const bf16_t* VT, int ldv, int key0, int q, int hh) {
#pragma unroll
    for (int s = 0; s < 2; ++s) { u32x4 pw; pw.x = pk2(p[8 * s], p[8 * s + 1]); pw.y = pk2(p[8 * s + 2], p[8 * s + 3]); pw.z = pk2(p[8 * s + 4], p[8 * s + 5]); pw.w = pk2(p[8 * s + 6], p[8 * s + 7]);
        const bf16x8 pf = __builtin_bit_cast(bf16x8, pw);
#pragma unroll
        for (int dt = 0; dt < 2; ++dt) { const bf16_t* vp = VT + (size_t)(dt * 32 + q) * ldv + key0 + 16 * s + 4 * hh; const u32x2 lo = *(const u32x2*)vp, hi = *(const u32x2*)(vp + 8);
            const u32x4 av = (u32x4){lo.x, lo.y, hi.x, hi.y}; o[dt] = MFMA32(__builtin_bit_cast(bf16x8, av), pf, o[dt]); } }
}
DI void attn_step(AttnState& st, const f32x16& s, unsigned vmask, const bf16_t* VT, int ldv, int key0, int q, int hh) {
    float mx = -1e30f;
#pragma unroll
    for (int i = 0; i < 16; ++i) if ((vmask >> i) & 1u) mx = fmaxf(mx, s[i]);
    mx = fmaxf(mx, xhalf(mx));
    const float mn = fmaxf(st.m, mx), al = __expf(st.m - mn); st.m = mn; st.l *= al;
#pragma unroll
    for (int i = 0; i < 16; ++i) { st.o[0][i] *= al; st.o[1][i] *= al; }
    float p[16]; float sum = 0.f;
#pragma unroll
    for (int i = 0; i < 16; ++i) { p[i] = ((vmask >> i) & 1u) ? __expf(s[i] - mn) : 0.f; sum += p[i]; }
    st.l += sum;
    pv_tile(st.o, p, VT, ldv, key0, q, hh);
}
constexpr int KT_LD = 72, VT_LD = 136, STG_KEYS = 128, STG_K_BYTES = STG_KEYS * KT_LD * 2, STAGE_BYTES_A = STG_K_BYTES + 64 * VT_LD * 2;
template <bool MASKED>
DI void attn_step_l(AttnState& st, const LAS bf16_t* Kt, const LAS bf16_t* Vt, const bf16x8* qf, unsigned vmask, bool mine, int q, int hh) {
    f32x16 s = f32x16{};
#pragma unroll
    for (int ks = 0; ks < 4; ++ks) { const bf16x8 af = *(const LAS bf16x8*)(Kt + q * KT_LD + 16 * ks + 8 * hh); s = MFMA32(af, qf[ks], s); }
    if (MASKED) {
#pragma unroll
        for (int i = 0; i < 16; ++i) s[i] = ((vmask >> i) & 1u) ? s[i] : -1e30f; }
    float mx = fmaxf(fmaxf(s[0], s[1]), fmaxf(s[2], s[3]));
#pragma unroll
    for (int i = 4; i < 16; i += 4) mx = fmaxf(mx, fmaxf(fmaxf(s[i], s[i + 1]), fmaxf(s[i + 2], s[i + 3])));
    if (!MASKED) mx = mine ? mx : -1e30f;
    mx = xmax32(mx);
    if (__builtin_amdgcn_ballot_w64(mx > st.m) != 0ull) { const float mn = fmaxf(st.m, mx), al = EXP2(st.m - mn); st.m = mn; st.l *= al;
#pragma unroll
        for (int i = 0; i < 16; ++i) { st.o[0][i] *= al; st.o[1][i] *= al; } }
    const float c = (MASKED || mine) ? fmaxf(st.m, -1e29f) : 1e30f;
    float p[16]; float sum = 0.f;
#pragma unroll
    for (int i = 0; i < 16; ++i) { p[i] = EXP2(s[i] - c); sum += p[i]; }
    st.l += sum;
#pragma unroll
    for (int s2 = 0; s2 < 2; ++s2) { u32x4 pw; pw.x = pk2(p[8 * s2], p[8 * s2 + 1]); pw.y = pk2(p[8 * s2 + 2], p[8 * s2 + 3]); pw.z = pk2(p[8 * s2 + 4], p[8 * s2 + 5]); pw.w = pk2(p[8 * s2 + 6], p[8 * s2 + 7]);
        const bf16x8 pf = __builtin_bit_cast(bf16x8, pw);
#pragma unroll
        for (int dt = 0; dt < 2; ++dt) { const LAS bf16_t* vp = Vt + (dt * 32 + q) * VT_LD + 16 * s2 + 4 * hh; const u32x2 lo = *(const LAS u32x2*)vp, hi = *(const LAS u32x2*)(vp + 8);
            const u32x4 av = (u32x4){lo.x, lo.y, hi.x, hi.y}; st.o[dt] = MFMA32(__builtin_bit_cast(bf16x8, av), pf, st.o[dt]); } }
}
DI void nsa_phase(int wv, const Params& P, LAS unsigned char* lds) {
    const int tid_ = tid_fresh(wv);
    unsigned char* const ws_ = ws_fresh(P.ws);
    const int lane = tid_ & 63, wave = tid_ >> 6, q = lane & 31, hh = lane >> 5, tok = q >> 2, g = q & 3;
    const bf16_t* Q = (const bf16_t*)(ws_ + WS_Q); const bf16_t* KCC = (const bf16_t*)(ws_ + WS_KCC); const bf16_t* VCCT = (const bf16_t*)(ws_ + WS_VCCT);
    const bf16_t* KS = (const bf16_t*)(ws_ + WS_KS); const bf16_t* VST = (const bf16_t*)(ws_ + WS_VST); const bf16_t* KW = (const bf16_t*)(ws_ + WS_KW); const bf16_t* VWT = (const bf16_t*)(ws_ + WS_VWT);
    const float* GATES = (const float*)(ws_ + WS_GATES); bf16_t* OCAT = (bf16_t*)(ws_ + WS_OCAT);
    LAS float* imp = (LAS float*)(lds + wave * 4096);
    LAS unsigned long long* selm = (LAS unsigned long long*)(lds + 32768 + wave * 128);
    LAS unsigned char* tiles = lds + 36864;
    const int ldr = tid_ & 255, isV = tid_ >> 8;
    const int nunits = 512, NG = gridDim.x;
    for (int uu = blockIdx.x; uu < nunits; uu += NG) {
        const int pass = uu / NG, idx = uu - pass * NG; int gi = uu; if ((nunits % (2 * NG)) == 0 && (pass & 1)) gi = pass * NG + (NG - 1 - idx);
        const int bh = gi >> 7, tg = gi & 127, b = bh >> 1, hkv = bh & 1, t0b = tg * 64, t0 = t0b + 8 * wave, t = t0 + tok, head = hkv * 4 + g;
        const size_t row = (size_t)b * SEQ + t;
        bf16x8 qf[4];
#pragma unroll
        for (int ks = 0; ks < 4; ++ks) qf[ks] = *(const bf16x8*)(Q + row * 512 + head * 64 + 16 * ks + 8 * hh);
        const float g0 = GATES[row * 24 + head * 3 + 0], g1 = GATES[row * 24 + head * 3 + 1], g2 = GATES[row * 24 + head * 3 + 2];
        f32x16 out[2]; out[0] = f32x16{}; out[1] = f32x16{};
        for (int i = lane; i < 1024; i += 64) imp[i] = 0.f;
        const int nvmax = (t0 + 7 >= 31) ? ((t0 + 7 - 31) >> 4) + 1 : 0, nvt = (t >= 31) ? ((t - 31) >> 4) + 1 : 0, ntile = (nvmax + 31) >> 5;
        const bf16_t* Kc = KCC + (size_t)bh * 512 * 64; const bf16_t* VcT = VCCT + (size_t)bh * 64 * 512;
        float m = -1e30f, l = 0.f;
        bf16x8 kf[4], kn[4];
#define CMP_KLOAD(dst_, kt_) _Pragma("unroll") for (int ks = 0; ks < 4; ++ks) dst_[ks] = *(const bf16x8*)(Kc + (size_t)((kt_) * 32 + q) * 64 + 8 * hh + 16 * ks)
#define CMP_QK(s_) do { s_ = f32x16{}; _Pragma("unroll") for (int ks = 0; ks < 4; ++ks) s_ = MFMA32(kf[ks], qf[ks], s_); } while (0)
        if (ntile > 0) { CMP_KLOAD(kf, 0); }
        for (int kt = 0; kt < ntile; ++kt) { if (kt + 1 < ntile) { CMP_KLOAD(kn, kt + 1); }
            f32x16 s; CMP_QK(s); float mx = -1e30f;
#pragma unroll
            for (int i = 0; i < 16; ++i) if (kt * 32 + crow(i, hh) < nvt) mx = fmaxf(mx, s[i]);
            mx = xmax32(mx); const float mn = fmaxf(m, mx); l *= EXP2(m - mn); m = mn;
#pragma unroll
            for (int i = 0; i < 16; ++i) if (kt * 32 + crow(i, hh) < nvt) l += EXP2(s[i] - mn);
#pragma unroll
            for (int ks = 0; ks < 4; ++ks) kf[ks] = kn[ks]; }
        l = xsum32(l);
        const float invl = l > 0.f ? 1.f / l : 0.f;
        { f32x16 o[2]; o[0] = f32x16{}; o[1] = f32x16{}; float carry = 0.f;
          if (ntile > 0) { CMP_KLOAD(kf, 0); }
          for (int kt = 0; kt < ntile; ++kt) { if (kt + 1 < ntile) { CMP_KLOAD(kn, kt + 1); }
            f32x16 s; CMP_QK(s); float p[16];
#pragma unroll
            for (int i = 0; i < 16; ++i) p[i] = (kt * 32 + crow(i, hh) < nvt) ? EXP2(s[i] - m) * invl : 0.f;
            pv_tile(o, p, VcT, 512, kt * 32, q, hh);
            float G4[4], oL[4];
#pragma unroll
            for (int rr = 0; rr < 4; ++rr) { G4[rr] = (p[4 * rr] + p[4 * rr + 1]) + (p[4 * rr + 2] + p[4 * rr + 3]); oL[rr] = xother32(p[4 * rr + 3], hh); }
#pragma unroll
            for (int rr = 0; rr < 4; ++rr) { const float prev = hh ? oL[rr] : (rr ? oL[rr > 0 ? rr - 1 : 0] : carry); const float v = quad_sum(G4[rr] + prev);
                if (g == 0) imp[tok * 128 + kt * 8 + 2 * rr + hh] = v; }
            carry = oL[3];
#pragma unroll
            for (int ks = 0; ks < 4; ++ks) kf[ks] = kn[ks]; }
#undef CMP_KLOAD
#undef CMP_QK
#pragma unroll
          for (int i = 0; i < 16; ++i) { out[0][i] += g0 * o[0][i]; out[1][i] += g0 * o[1][i]; } }
        asm volatile("s_waitcnt lgkmcnt(0)" ::: "memory");
        for (int tk = 0; tk < 8; ++tk) { const int tt = t0 + tk, cur = tt >> 6; unsigned long long mlo, mhi;
            if (cur + 1 <= 16) { mlo = (1ull << (cur + 1)) - 1ull; mhi = 0ull; }
            else { const int j0 = lane, j1 = lane + 64;
                const float s0 = imp[tk * 128 + j0], s1 = imp[tk * 128 + j1];
                const unsigned k0 = (j0 > cur) ? 0u : ((j0 == 0 || j0 == cur || j0 == cur - 1) ? 0x7f000000u : __float_as_uint(s0) + 1u);
                const unsigned k1 = (j1 > cur) ? 0u : ((j1 == cur || j1 == cur - 1) ? 0x7f000000u : __float_as_uint(s1) + 1u);
                unsigned T = 0u;
#pragma unroll 1
                for (int bit = 30; bit >= 0; --bit) { const unsigned cand = T | (1u << bit);
                    const int cnt = __builtin_popcountll(__builtin_amdgcn_ballot_w64(k0 >= cand)) + __builtin_popcountll(__builtin_amdgcn_ballot_w64(k1 >= cand)); if (cnt >= 16) T = cand; }
                mlo = __builtin_amdgcn_ballot_w64(k0 > T); mhi = __builtin_amdgcn_ballot_w64(k1 > T);
                int need = 16 - __builtin_popcountll(mlo) - __builtin_popcountll(mhi);
                unsigned long long elo = __builtin_amdgcn_ballot_w64(k0 == T), ehi = __builtin_amdgcn_ballot_w64(k1 == T);
                while (need > 0 && elo) { const unsigned long long bb = elo & (0ull - elo); mlo |= bb; elo ^= bb; --need; }
                while (need > 0 && ehi) { const unsigned long long bb = ehi & (0ull - ehi); mhi |= bb; ehi ^= bb; --need; } }
            if (lane == 0) { selm[tk * 2] = mlo; selm[tk * 2 + 1] = mhi; } }
        asm volatile("s_waitcnt lgkmcnt(0)" ::: "memory");
        const unsigned long long mylo = selm[tok * 2], myhi = selm[tok * 2 + 1];
#pragma unroll 1
        for (int br = 0; br < 2; ++br) {
            const bf16_t* Kb = (br ? KW : KS) + (size_t)bh * SEQ * 64; const bf16_t* Vb = (br ? VWT : VST) + (size_t)bh * 64 * SEQ;
            const int ktb = br ? (((t0b - 511 > 0) ? (t0b - 511) : 0) >> 5) : 0, kte = ((t0b + 63) >> 5) + 1, nt = kte - ktb;
            const int nst = (nt + 3) >> 2;
            const bf16_t* gsrc = (isV ? (Vb + (size_t)(ldr >> 4) * SEQ + (ldr & 15) * 8) : (Kb + (size_t)(ldr >> 3) * 64 + (ldr & 7) * 8)) + (size_t)ktb * (isV ? 32 : 32 * 64);
            const size_t gj = isV ? (size_t)16 * SEQ : (size_t)32 * 64, gstage = isV ? 128 : 128 * 64;
            const int loff = isV ? (STG_K_BYTES + (ldr >> 4) * VT_LD * 2 + (ldr & 15) * 16) : ((ldr >> 3) * KT_LD * 2 + (ldr & 7) * 16), lj = isV ? 16 * VT_LD * 2 : 32 * KT_LD * 2;
            AttnState st; st.m = -1e30f; st.l = 0.f; st.o[0] = f32x16{}; st.o[1] = f32x16{};
            u32x4 pre[4];
#define NSA_LOAD(si_) _Pragma("unroll") for (int j_ = 0; j_ < 4; ++j_) pre[j_] = *(const u32x4*)(gsrc + (size_t)(si_) * gstage + j_ * gj)
#define NSA_STORE(buf_) _Pragma("unroll") for (int j_ = 0; j_ < 4; ++j_) *(LAS u32x4*)(tiles + (buf_) * STAGE_BYTES_A + loff + j_ * lj) = pre[j_]
            NSA_LOAD(0); NSA_STORE(0);
            if (nst > 1) { NSA_LOAD(1); }
            __syncthreads();
#pragma unroll 1
            for (int si = 0; si < nst; ++si) { const int cur = si & 1;
                if (si + 1 < nst) { NSA_STORE(cur ^ 1); if (si + 2 < nst) { NSA_LOAD(si + 2); } }
#pragma unroll 1
                for (int sub = 0; sub < 4; ++sub) { const int ti = si * 4 + sub; if (ti >= nt) break; const int key0 = (ktb + ti) * 32;
                    const bool rel = br ? (key0 <= t0 + 7 && key0 + 31 + 512 > t0) : (key0 <= t0 + 7);
                    if (rel) {
                        const LAS bf16_t* Kt = (const LAS bf16_t*)(tiles + cur * STAGE_BYTES_A) + sub * 32 * KT_LD; const LAS bf16_t* Vt = (const LAS bf16_t*)(tiles + cur * STAGE_BYTES_A + STG_K_BYTES) + sub * 32;
                        const int jb = key0 >> 6; const bool mine = br ? true : ((jb < 64) ? ((mylo >> jb) & 1ull) : ((myhi >> (jb - 64)) & 1ull));
                        const bool full = br ? (key0 + 31 <= t0 && key0 + 512 > t0 + 7) : (key0 + 31 <= t0);
                        if (__builtin_amdgcn_ballot_w64(mine) == 0ull) {   }
                        else if (full) attn_step_l<false>(st, Kt, Vt, qf, 0u, mine, q, hh);
                        else { unsigned vm = 0u;
                            if (br == 0) {
#pragma unroll
                                for (int e = 0; e < 16; ++e) vm |= (mine && (key0 + crow(e, hh) <= t)) ? (1u << e) : 0u; }
                            else {
#pragma unroll
                                for (int e = 0; e < 16; ++e) { const int key = key0 + crow(e, hh); vm |= (key <= t && key + 512 > t) ? (1u << e) : 0u; } }
                            attn_step_l<true>(st, Kt, Vt, qf, vm, true, q, hh); } } }
                __syncthreads(); }
#undef NSA_LOAD
#undef NSA_STORE
            const float lt = xsum32(st.l), gg = br ? g2 : g1, sc = lt > 0.f ? gg / lt : 0.f;
#pragma unroll
            for (int i = 0; i < 16; ++i) { out[0][i] += sc * st.o[0][i]; out[1][i] += sc * st.o[1][i]; }
        }
#pragma unroll
        for (int dt = 0; dt < 2; ++dt)
#pragma unroll
            for (int i4 = 0; i4 < 4; ++i4) { u32x2 w; w.x = pk2(out[dt][4 * i4], out[dt][4 * i4 + 1]); w.y = pk2(out[dt][4 * i4 + 2], out[dt][4 * i4 + 3]);
                *(u32x2*)(OCAT + row * 1536 + head * 64 + dt * 32 + 8 * i4 + 4 * hh) = w; }
    }
}

constexpr int RW_T = 32;
DI float multi4_sum(float q0, float q1, float q2, float q3, int lane) {
    const bool b0 = lane & 1, b1 = lane & 2;
    const float r01 = (b0 ? q1 : q0) + dpp_f<0xB1>(b0 ? q0 : q1);
    const float r23 = (b0 ? q3 : q2) + dpp_f<0xB1>(b0 ? q2 : q3);
    float r = (b1 ? r23 : r01) + dpp_f<0x4E>(b1 ? r01 : r23);
    r += dpp_f<0x124>(r); r += dpp_f<0x128>(r);
    { auto x = __builtin_amdgcn_permlane16_swap(__float_as_uint(r), __float_as_uint(r), false, false); r = __uint_as_float(x[0]) + __uint_as_float(x[1]); }
    { auto x = __builtin_amdgcn_permlane32_swap(__float_as_uint(r), __float_as_uint(r), false, false); r = __uint_as_float(x[0]) + __uint_as_float(x[1]); }
    return r;
}
DI float rdlane(float v, int l) { return __builtin_bit_cast(float, __builtin_amdgcn_readlane(__builtin_bit_cast(int, v), l)); }
DI float row16_sum(float v) { v += dpp_f<0xB1>(v); v += dpp_f<0x4E>(v); v += dpp_f<0x141>(v); v += dpp_f<0x140>(v); return v; }
DI void rwkv_scan_phase(int wv, const Params& P, LAS unsigned char* lds) {
    const int tid_ = tid_fresh(wv);
    unsigned char* const ws_ = ws_fresh(P.ws);
    const int lane = tid_ & 63, wave = tid_ >> 6;
    const bf16_t* R = (const bf16_t*)(ws_ + WS_R); const bf16_t* K = (const bf16_t*)(ws_ + WS_K); const bf16_t* V = (const bf16_t*)(ws_ + WS_V); const bf16_t* AA = (const bf16_t*)(ws_ + WS_AA);
    const _Float16* LD = (const _Float16*)(ws_ + WS_LD); bf16_t* YS = (bf16_t*)(ws_ + WS_YS); float* RK = (float*)(ws_ + WS_RK);
    LAS float* stg = (LAS float*)lds;
    LAS float* vst = (LAS float*)(lds + 2 * RW_T * 5 * 64 * 4);
    LAS float* ybuf = vst + 2 * RW_T * 8;
    const int nck = SEQ / RW_T;
    const int pw = wave - 2;
    volatile LAS unsigned* flg = (volatile LAS unsigned*)(lds + 120832);
    for (int u = blockIdx.x; u < 256; u += gridDim.x) {
        const int bh = u >> 3, rg = u & 7, b = bh >> 4, h = bh & 15;
        __syncthreads();
        if (tid_ < 16) flg[tid_] = 0u;
        __syncthreads();
        if (wave >= 2) {
            const int ch = h * 64 + lane;
            const float kkw = P.in[35][ch], kaw = P.in[36][ch], rkw = P.in[37][ch];
            const int hf = lane >> 5, c2 = lane & 31, chp = h * 64 + 2 * c2;
            const f32x2 kkw2 = *(const f32x2*)(P.in[35] + chp), kaw2 = *(const f32x2*)(P.in[36] + chp), rkw2 = *(const f32x2*)(P.in[37] + chp);
            unsigned gk[3], ga[3], gr[3], gl[3]; float gv[3];
#define RW_LOADG(cn_) _Pragma("unroll") for (int i = 0; i < 3; ++i) { const int pp = pw + 6 * i; const size_t row = (size_t)b * SEQ + (cn_) * RW_T + 2 * (pp < 16 ? pp : 0) + hf; \
                gk[i] = *(const unsigned*)(K + row * 1024 + chp); ga[i] = *(const unsigned*)(AA + row * 1024 + chp); gr[i] = *(const unsigned*)(R + row * 1024 + chp); gl[i] = *(const unsigned*)(LD + row * 1024 + chp); \
                gv[i] = bf2f(V[row * 1024 + h * 64 + rg * 8 + (c2 & 7)]); }
            RW_LOADG(0)
#pragma unroll 1
            for (int ck = -1; ck <= nck; ++ck) {
                {
                    if (ck >= 1) { const LAS float* yb = ybuf + ((ck - 1) & 1) * RW_T * 128;
                        while (true) { const unsigned c0 = flg[8], c1 = flg[9]; if ((c0 < c1 ? c0 : c1) >= (unsigned)ck) break; __builtin_amdgcn_s_sleep(1); }
                        asm volatile("" ::: "memory");
#pragma unroll 2
                        for (int it = pw; it < 64; it += 6) { const float y = row16_sum(yb[it * 64 + lane]);
                            const float y0 = __builtin_bit_cast(float, __builtin_amdgcn_readlane(__builtin_bit_cast(int, y), 0)), y1 = __builtin_bit_cast(float, __builtin_amdgcn_readlane(__builtin_bit_cast(int, y), 16)),
                                        y2 = __builtin_bit_cast(float, __builtin_amdgcn_readlane(__builtin_bit_cast(int, y), 32)), y3 = __builtin_bit_cast(float, __builtin_amdgcn_readlane(__builtin_bit_cast(int, y), 48));
                            if (lane == 0) { u32x2 w; w.x = pk2(y0, y1); w.y = pk2(y2, y3); *(u32x2*)(YS + ((size_t)b * SEQ + (ck - 1) * RW_T + (it >> 1)) * 1024 + h * 64 + rg * 8 + (it & 1) * 4) = w; } } }
                    if (ck + 1 < nck) { const int cn = ck + 1, buf = cn & 1;
#pragma unroll
                        for (int i = 0; i < 3; ++i) { const int pp = pw + 6 * i; if (pp < 16) { const int tt = 2 * pp + hf; const size_t row = (size_t)b * SEQ + cn * RW_T + tt;
                            const f32x2 k = {bflo(gk[i]), bfhi(gk[i])}, a = {bflo(ga[i]), bfhi(ga[i])}, r = {bflo(gr[i]), bfhi(gr[i])};
                            const h16x2 lh = __builtin_bit_cast(h16x2, gl[i]);
                            const f32x2 kr = k * kkw2, kp = k * ((a - 1.f) * kaw2 + 1.f);
                            const float sp = kr[0] * kr[0] + kr[1] * kr[1], rp = r[0] * kp[0] * rkw2[0] + r[1] * kp[1] * rkw2[1];
                            const bool odd = lane & 1;
                            float red = (odd ? rp : sp) + dpp_f<0xB1>(odd ? sp : rp);
                            red += dpp_f<0x4E>(red); red += dpp_f<0x124>(red); red += dpp_f<0x128>(red);
                            { auto x = __builtin_amdgcn_permlane16_swap(__float_as_uint(red), __float_as_uint(red), false, false); red = __uint_as_float(x[0]) + __uint_as_float(x[1]); }
                            const float oth = dpp_f<0xB1>(red); const float ss = odd ? oth : red, rks = odd ? red : oth;
                            const f32x2 kk = kr * __builtin_amdgcn_rsqf(fmaxf(ss, 1e-24f));
                            LAS float* d = stg + ((buf * RW_T + tt) * 5) * 64 + 2 * c2;
                            *(LAS f32x2*)(d) = -kk; *(LAS f32x2*)(d + 64) = (f32x2){__expf((float)lh[0]), __expf((float)lh[1])}; *(LAS f32x2*)(d + 128) = kk * a; *(LAS f32x2*)(d + 192) = kp; *(LAS f32x2*)(d + 256) = r;
                            if (rg == 0 && c2 == 0) RK[row * 16 + h] = rks;
                            if (c2 < 8) vst[(buf * RW_T + tt) * 8 + c2] = gv[i]; } }
                        asm volatile("s_waitcnt lgkmcnt(0)" ::: "memory");
                        if (lane == 0) flg[pw] = (unsigned)(cn + 1);
                        if (ck + 2 < nck) { RW_LOADG(ck + 2) } }
                }
            }
        } else {
            const int cg = lane & 15, rloc = wave * 4 + (lane >> 4);
            f32x4 S = (f32x4){0.f, 0.f, 0.f, 0.f};
            __builtin_amdgcn_s_setprio(3);
#pragma unroll 1
            for (int ck = 0; ck < nck; ++ck) { const int buf = ck & 1;
                const LAS float* sb = stg + buf * RW_T * 5 * 64 + 4 * cg; const LAS float* vb = vst + buf * RW_T * 8 + rloc; LAS float* yb = ybuf + buf * RW_T * 128 + wave * 64 + lane;
                const unsigned sba = (unsigned)(size_t)sb, vba = (unsigned)(size_t)vb;
                while (true) { unsigned mn = flg[0]; { const unsigned a1 = flg[1], a2 = flg[2], a3 = flg[3], a4 = flg[4], a5 = flg[5]; mn = mn < a1 ? mn : a1; mn = mn < a2 ? mn : a2; mn = mn < a3 ? mn : a3; mn = mn < a4 ? mn : a4; mn = mn < a5 ? mn : a5; }
                    if (mn >= (unsigned)(ck + 1)) break; __builtin_amdgcn_s_sleep(1); }
                asm volatile("" ::: "memory");
                f32x4 nkA, ddA, bbA, kpA, rrA, nkB, ddB, bbB, kpB, rrB; float vvA, vvB;
#define RW_LDS_LOAD(X, j_) asm volatile("ds_read_b128 %0, %6 offset:%c8\n\tds_read_b128 %1, %6 offset:%c9\n\tds_read_b128 %2, %6 offset:%c10\n\tds_read_b128 %3, %6 offset:%c11\n\tds_read_b128 %4, %6 offset:%c12\n\tds_read_b32 %5, %7 offset:%c13" \
                    : "=&v"(nk##X), "=&v"(dd##X), "=&v"(bb##X), "=&v"(kp##X), "=&v"(rr##X), "=&v"(vv##X) : "v"(sbt), "v"(vbt), "i"((j_) * 1280), "i"((j_) * 1280 + 256), "i"((j_) * 1280 + 512), "i"((j_) * 1280 + 768), "i"((j_) * 1280 + 1024), "i"((j_) * 32) : "memory")
#define RW_LDS_WAIT(X) asm volatile("s_waitcnt lgkmcnt(0)" : "+v"(nk##X), "+v"(dd##X), "+v"(bb##X), "+v"(kp##X), "+v"(rr##X), "+v"(vv##X) :: "memory")
#define SB_() __builtin_amdgcn_sched_barrier(0)
#define LO2(v_) __builtin_shufflevector(v_, v_, 0, 1)
#define HI2(v_) __builtin_shufflevector(v_, v_, 2, 3)
#define RW_STEP(X, tt_) do { \
                    f32x2 pa_ = LO2(S) * LO2(nk##X); pa_ = HI2(S) * HI2(nk##X) + pa_; float q_ = pa_[0] + pa_[1]; SB_(); \
                    q_ += dpp_f<0xB1>(q_); const f32x2 kvl_ = LO2(kp##X) * vv##X; SB_(); \
                    q_ += dpp_f<0x4E>(q_); const f32x2 kvh_ = HI2(kp##X) * vv##X; SB_(); \
                    q_ += dpp_f<0x141>(q_); const float yp_ = yacc[0] + yacc[1]; SB_(); \
                    q_ += dpp_f<0x140>(q_); if ((tt_) > 0 || tt > 0) ybt[((tt_) - 1) * 128] = yp_; SB_(); \
                    const f32x2 sl_ = LO2(S) * LO2(dd##X) + (LO2(bb##X) * q_ + kvl_), sh_ = HI2(S) * HI2(dd##X) + (HI2(bb##X) * q_ + kvh_); SB_(); \
                    yacc = sl_ * LO2(rr##X); yacc = sh_ * HI2(rr##X) + yacc; S = __builtin_shufflevector(sl_, sh_, 0, 1, 2, 3); SB_(); } while (0)
                f32x2 yacc = (f32x2){0.f, 0.f};
                unsigned sbt = sba, vbt = vba; LAS float* ybt = yb;
                RW_LDS_LOAD(A, 0); RW_LDS_WAIT(A);
#pragma unroll 1
                for (int tt = 0; tt < RW_T; tt += 8) { sbt = sba + (unsigned)tt * 1280u; vbt = vba + (unsigned)tt * 32u; ybt = yb + tt * 128;
                    RW_LDS_LOAD(B, 1); RW_STEP(A, 0); RW_LDS_WAIT(B);
                    RW_LDS_LOAD(A, 2); RW_STEP(B, 1); RW_LDS_WAIT(A);
                    RW_LDS_LOAD(B, 3); RW_STEP(A, 2); RW_LDS_WAIT(B);
                    RW_LDS_LOAD(A, 4); RW_STEP(B, 3); RW_LDS_WAIT(A);
                    RW_LDS_LOAD(B, 5); RW_STEP(A, 4); RW_LDS_WAIT(B);
                    RW_LDS_LOAD(A, 6); RW_STEP(B, 5); RW_LDS_WAIT(A);
                    RW_LDS_LOAD(B, 7); RW_STEP(A, 6); RW_LDS_WAIT(B);
                    RW_LDS_LOAD(A, 8); RW_STEP(B, 7); RW_LDS_WAIT(A);
                }
                yb[(RW_T - 1) * 128] = yacc[0] + yacc[1];
#undef SB_
#undef LO2
#undef HI2
#undef RW_LDS_LOAD
#undef RW_LDS_WAIT
#undef RW_STEP
                asm volatile("s_waitcnt lgkmcnt(0)" ::: "memory");
                if (lane == 0) flg[8 + wave] = (unsigned)(ck + 1);
            }
            __builtin_amdgcn_s_setprio(0);
        }
    }
}
DI void rwkv_post_phase(int wv, const Params& P) {
    const int tid_ = tid_fresh(wv);
    unsigned char* const ws_ = ws_fresh(P.ws);
    const int lane = tid_ & 63, gw = blockIdx.x * NWAVES + (tid_ >> 6), NGW = gridDim.x * NWAVES;
    const bf16_t* YS = (const bf16_t*)(ws_ + WS_YS); const bf16_t* V = (const bf16_t*)(ws_ + WS_V); const bf16_t* G = (const bf16_t*)(ws_ + WS_G); const float* RK = (const float*)(ws_ + WS_RK);
    bf16_t* A2 = (bf16_t*)(ws_ + WS_A2); const float* lng = P.in[38]; const float* lnb = P.in[39];
    for (int r = gw; r < MTOK; r += NGW) {
#pragma unroll
        for (int it = 0; it < 2; ++it) { const int head = it * 8 + (lane >> 3), ch = head * 64 + (lane & 7) * 8; const size_t off = (size_t)r * 1024 + ch;
            const u32x4 yv = *(const u32x4*)(YS + off), vv = *(const u32x4*)(V + off), gv = *(const u32x4*)(G + off);
            float y[8], v8[8], g8[8];
#pragma unroll
            for (int e = 0; e < 4; ++e) { y[2 * e] = bflo(yv[e]); y[2 * e + 1] = bfhi(yv[e]); v8[2 * e] = bflo(vv[e]); v8[2 * e + 1] = bfhi(vv[e]); g8[2 * e] = bflo(gv[e]); g8[2 * e + 1] = bfhi(gv[e]); }
            float s = 0.f;
#pragma unroll
            for (int e = 0; e < 8; ++e) s += y[e];
            s += dpp_f<0xB1>(s); s += dpp_f<0x4E>(s); s += dpp_f<0x141>(s);
            const float mean = s * (1.f / 64.f); float q = 0.f;
#pragma unroll
            for (int e = 0; e < 8; ++e) { y[e] -= mean; q += y[e] * y[e]; }
            q += dpp_f<0xB1>(q); q += dpp_f<0x4E>(q); q += dpp_f<0x141>(q);
            const float rstd = rsqrtf(q * (1.f / 64.f) + 64e-5f), rk = RK[(size_t)r * 16 + head];
            const f32x4 l0 = *(const f32x4*)(lng + ch), l1 = *(const f32x4*)(lng + ch + 4), b0 = *(const f32x4*)(lnb + ch), b1 = *(const f32x4*)(lnb + ch + 4);
            float o[8];
#pragma unroll
            for (int e = 0; e < 8; ++e) { const float lg = e < 4 ? l0[e & 3] : l1[e & 3], lb = e < 4 ? b0[e & 3] : b1[e & 3]; o[e] = (y[e] * rstd * lg + lb + rk * v8[e]) * g8[e]; }
            u32x4 w; w.x = pk2(o[0], o[1]); w.y = pk2(o[2], o[3]); w.z = pk2(o[4], o[5]); w.w = pk2(o[6], o[7]);
            *(u32x4*)(A2 + off) = w; }
    }
}


#define XB_TMO      128
#define XB_XCNT(j)  (256  + 64 * (j))
#define XB_XSUB(j)  (1280 + 64 * (j))
#define XB_XGEN(j)  (2304 + 64 * (j))
#define XB_TOP      3328
#define XB_TOPGEN   3392
#define XCD_BAR_WORDS 3456
#define XB_SPIN_CAP (1u << 22)
DI unsigned xb_ld(unsigned* p)              { return __hip_atomic_load(p, __ATOMIC_RELAXED, __HIP_MEMORY_SCOPE_AGENT); }
DI unsigned xb_add(unsigned* p, unsigned v) { return __hip_atomic_fetch_add(p, v, __ATOMIC_RELAXED, __HIP_MEMORY_SCOPE_AGENT); }
DI unsigned xb_xcc_id() { return (unsigned)__builtin_amdgcn_s_getreg((3 << 11) | 20) & 0xFu; }
#define XB_SPIN(cond, bar) do { unsigned _sp = 0; while (cond) { __builtin_amdgcn_s_sleep(1); \
    if ((++_sp & 255u) == 0u) { if (xb_ld(&(bar)[XB_TMO])) break; if (_sp > XB_SPIN_CAP) { atomicAdd(&(bar)[XB_TMO], 1u); break; } } } } while (0)
DI void xcd_barrier_complete(unsigned* bar, unsigned x, unsigned& nloc, unsigned& nx) {
    const unsigned G = gridDim.x * gridDim.y * gridDim.z;
    unsigned sum, cnt, mine, sp = 0u;
    for (;;) {
        sum = 0u; cnt = 0u; mine = 0u;
#pragma unroll
        for (unsigned j = 0; j < 16; ++j) { const unsigned c = xb_ld(&bar[XB_XCNT(j)]); sum += c; cnt += (c > 0u) ? 1u : 0u; mine = (j == x) ? c : mine; }
        if (sum == G) break;
        __builtin_amdgcn_s_sleep(1);
        if ((++sp & 255u) == 0u) { if (xb_ld(&bar[XB_TMO])) break; if (sp > XB_SPIN_CAP) { atomicAdd(&bar[XB_TMO], 1u); break; } }
    }
    nloc = mine > 0u ? mine : 1u; nx = cnt > 0u ? cnt : 1u;
}
DI void xcd_barrier(unsigned* bar, volatile LAS unsigned* st, bool leader) {
    asm volatile("s_waitcnt vmcnt(0)" ::: "memory");
    __syncthreads();
    if (leader) {
        const unsigned x = xb_xcc_id();
        __builtin_amdgcn_s_waitcnt(0);
        unsigned nloc = st[0], nx = st[1];
        if (nloc == 0u) { xcd_barrier_complete(bar, x, nloc, nx); st[0] = nloc; st[1] = nx; }
        const unsigned old = xb_add(&bar[XB_XSUB(x)], 1u);
        const unsigned gen = old / nloc;
        if (old + 1u == (gen + 1u) * nloc) {
            __builtin_amdgcn_fence(__ATOMIC_RELEASE, "agent");
            asm volatile("s_waitcnt vmcnt(0)" ::: "memory");
            const unsigned og = xb_add(&bar[XB_TOP], 1u);
            const unsigned tg = og / nx;
            if (og + 1u == (tg + 1u) * nx) xb_add(&bar[XB_TOPGEN], 1u);
            else XB_SPIN(xb_ld(&bar[XB_TOPGEN]) == tg, bar);
            __builtin_amdgcn_fence(__ATOMIC_ACQUIRE, "agent");
            xb_add(&bar[XB_XGEN(x)], 1u);
            asm volatile("s_waitcnt vmcnt(0)" ::: "memory");
        } else {
            XB_SPIN(xb_ld(&bar[XB_XGEN(x)]) == gen, bar);
            __builtin_amdgcn_fence(__ATOMIC_ACQUIRE, "agent");
            asm volatile("s_waitcnt vmcnt(0)" ::: "memory");
        }
    }
    __syncthreads();
}

#ifndef REP_GEMM
#define REP_GEMM 1
#endif
#ifndef REP_NSA
#define REP_NSA 1
#endif
#ifndef REP_SCAN
#define REP_SCAN 1
#endif
#ifndef REP_SSD
#define REP_SSD 1
#endif
#define GEMM_RUN(EpiT, epi, Aptr, Bptr, M_, N_, K_, lda_, padA_, cshift) for (int rep_ = 0; rep_ < REP_GEMM; ++rep_) do { pg8::Gemm g_{(const bf16_t*)(Aptr), (const bf16_t*)(Bptr), (M_), (N_), (K_), (lda_), (padA_)}; pg8::StaticOrder S_; \
    S_.init((M_), (N_), (int)gridDim.x, (int)((blockIdx.x + gridDim.x - (cshift)) % gridDim.x)); pg8::gemm_phase<EpiT>(wv, lds, g_, S_, (epi)); } while (0)

DI unsigned* bar_ptr(const Params& P) { return (unsigned*)(P.ws + WS_BAR); }
#define ws ws_fresh(P.ws)
#define A ((bf16_t*)(ws + WS_A))
#define H ((bf16_t*)(ws + WS_H))
#define Y ((bf16_t*)(ws + WS_Y))
#define GSYNC() do { unsigned* const barp_ = bar_ptr(P); const bool lead_ = (tid_fresh(wv) == 0); xcd_barrier(barp_, (volatile LAS unsigned*)(lds + LDS_BYTES - 64), lead_); } while (0)
template <int layer> DI void layer_body(const Params& P, cg::grid_group& grid, const int wv, LAS unsigned char* lds) {
    float* X = P.out; const float* ng = P.in[1];
        const float* gl = ng + layer * 6 * DM;
        { EpiSwiglu e{H}; GEMM_RUN(EpiSwiglu, e, A, ws + WS_WGU, MTOK, 2 * DFF, DM, DM, 0, 0); }
        GSYNC();
        { EpiBf16 e{Y, DM}; GEMM_RUN(EpiBf16, e, H, ws + WS_WD, MTOK, DM, DFF, DFF, 0, 0); }
        GSYNC();
        row_phase(wv, 1, layer == 0 ? P.in[0] : X, Y, gl + 1 * DM, 0.5f, gl + 2 * DM, X, A, layer);
        run_jobs(wv, P.ffn2[layer], 3, nullptr, 0, lds);
        GSYNC();
        if (layer == 0) {
            { EpiWin e{ws, P.in[17]};
              GEMM_RUN(EpiWin, e, A, ws + WS_WIN, MTOK, 4096, DM, DM, 0, 0); }
            GSYNC();
            { EpiF32 e{(float*)(ws + WS_PK), 256}; GEMM_RUN(EpiF32, e, ws + WS_KCN, ws + WS_W1K, 2048, 256, 1024, 1024, 0, 0); }
            { EpiF32 e{(float*)(ws + WS_PV), 256}; GEMM_RUN(EpiF32, e, ws + WS_VCN, ws + WS_W1V, 2048, 256, 1024, 1024, 0, 8); }
            for (int r_ = 0; r_ < REP_SSD; ++r_) conv_phase(wv, P);
            GSYNC();
            cmp_finish_phase(wv, P); for (int r_ = 0; r_ < REP_SSD; ++r_) ssd_states_phase(wv, P, lds);
            GSYNC();
            ssd_scan_phase(wv, P); for (int r_ = 0; r_ < REP_NSA; ++r_) nsa_phase(wv, P, lds);
            GSYNC();
            for (int r_ = 0; r_ < REP_SSD; ++r_) ssd_out_phase(wv, P, lds);
            GSYNC();
            { EpiBf16 e{(bf16_t*)(ws + WS_YMIX0), DM}; GEMM_RUN(EpiBf16, e, ws + WS_OCAT, ws + WS_WOUT, MTOK, DM, 1536, 1536, 0, 0); }
            GSYNC();
            row_phase(wv, 1, X, (const bf16_t*)(ws + WS_YMIX0), gl + 3 * DM, 1.f, gl + 4 * DM, X, A, 0);
            GSYNC();
        } else {
            { EpiRwkv1 e{ws}; GEMM_RUN(EpiRwkv1, e, A, ws + WS_WG1, MTOK, 3584, 2048, DM, DM * 2, 0); }
            GSYNC();
            { EpiRwkv2 e{(_Float16*)(ws + WS_LD), (bf16_t*)(ws + WS_AA), P.in[27], P.in[30]}; GEMM_RUN(EpiRwkv2, e, ws + WS_LH, ws + WS_W2A, MTOK, 2048, 128, 512, 0, 0); }
            GSYNC();
            for (int r_ = 0; r_ < REP_SCAN; ++r_) rwkv_scan_phase(wv, P, lds);
            GSYNC();
            { EpiBf16 e{(bf16_t*)(ws + WS_G), DM}; GEMM_RUN(EpiBf16, e, (bf16_t*)(ws + WS_LH) + 128, ws + WS_W2B, MTOK, DM, 256, 512, 0, 0); }
            GSYNC();
            rwkv_post_phase(wv, P);
            GSYNC();
            { EpiBf16 e{(bf16_t*)(ws + WS_YMIX1), DM}; GEMM_RUN(EpiBf16, e, ws + WS_A2, ws + WS_WO, MTOK, DM, DM, DM, 0, 0); }
            GSYNC();
            row_phase(wv, 1, X, (const bf16_t*)(ws + WS_YMIX1), gl + 3 * DM, 1.f, gl + 4 * DM, X, A, 0);
            GSYNC();
        }
        { EpiSwiglu e{H}; GEMM_RUN(EpiSwiglu, e, A, ws + WS_WGU, MTOK, 2 * DFF, DM, DM, 0, 0); }
        GSYNC();
        { EpiBf16 e{Y, DM}; GEMM_RUN(EpiBf16, e, H, ws + WS_WD, MTOK, DM, DFF, DFF, 0, 0); }
        GSYNC();
        if (layer == 0) { row_phase(wv, 1, X, Y, gl + 5 * DM, 0.5f, ng + 6 * DM, X, A, 0); run_jobs(wv, P.js[1].cj, P.js[1].ncj, P.js[1].zj, P.js[1].nzj, lds); GSYNC(); }
        else row_phase(wv, 1, X, Y, gl + 5 * DM, 0.5f, nullptr, X, nullptr, 0);
}

__global__ void __launch_bounds__(NTHREADS, 2) mega_fwd(Params P) {
    extern __shared__ __attribute__((aligned(16))) unsigned char lds_raw[];
    LAS unsigned char* lds = (LAS unsigned char*)lds_raw;
    cg::grid_group grid = cg::this_grid();
    const int wv = __builtin_amdgcn_readfirstlane(threadIdx.x >> 6);
    { unsigned* const barp = bar_ptr(P); const unsigned xid = xb_xcc_id();
      if (threadIdx.x == 0) { ((volatile LAS unsigned*)(lds + LDS_BYTES - 64))[0] = 0u; ((volatile LAS unsigned*)(lds + LDS_BYTES - 64))[1] = 0u; (void)xb_add(barp + XB_XCNT(xid), 1u); } }
    __syncthreads();
    float* X = P.out;
    const float* ng = P.in[1];
    grid.sync();
    run_jobs(wv, P.js[0].cj, P.js[0].ncj, P.js[0].zj, P.js[0].nzj, lds); p0_misc(wv, P, lds);
    row_phase(wv, 0, P.in[0], nullptr, nullptr, 0.f, ng + 0 * DM, nullptr, A, 0);
    GSYNC();
    layer_body<0>(P, grid, wv, lds);
    layer_body<1>(P, grid, wv, lds);
}
#undef ws
#undef A
#undef H
#undef Y
static void add_cvt(JobSet& js, const float* src, int ldw, int K, int N, bf16_t* dst, int ldk, int koff, int mode, int rowoff, const float* scale = nullptr, int smode = 0) {
    CvtJob& j = js.cj[js.ncj++]; j.src = src; j.scale = scale; j.dst = dst; j.ldw = ldw; j.K = K; j.N = N; j.ldk = ldk; j.koff = koff; j.mode = mode; j.rowoff = rowoff; j.smode = smode;
}
static void add_zero(JobSet& js, bf16_t* dst, int rows, int ldk, int c0, int nc) { ZeroJob& z = js.zj[js.nzj++]; z.dst = dst; z.rows = rows; z.ldk = ldk; z.c0 = c0; z.nc = nc; z.pad = 0; }
static void set_cvt(CvtJob& j, const float* src, int ldw, int K, int N, bf16_t* dst, int ldk, int koff, int mode, int rowoff) {
    j.src = src; j.scale = nullptr; j.dst = dst; j.ldw = ldw; j.K = K; j.N = N; j.ldk = ldk; j.koff = koff; j.mode = mode; j.rowoff = rowoff; j.smode = 0;
}
static void set_ffn(CvtJob* j, unsigned char* ws, const float* wg, const float* wu, const float* wd) {
    set_cvt(j[0], wg, DFF, DM, DFF, (bf16_t*)(ws + WS_WGU), DM, 0, 1, 0); set_cvt(j[1], wu, DFF, DM, DFF, (bf16_t*)(ws + WS_WGU), DM, 0, 1, 128); set_cvt(j[2], wd, DM, DFF, DM, (bf16_t*)(ws + WS_WD), DFF, 0, 0, 0);
}
static void add_ffn(JobSet& js, unsigned char* ws, const float* wg, const float* wu, const float* wd) {
    add_cvt(js, wg, DFF, DM, DFF, (bf16_t*)(ws + WS_WGU), DM, 0, 1, 0);
    add_cvt(js, wu, DFF, DM, DFF, (bf16_t*)(ws + WS_WGU), DM, 0, 1, 128);
    add_cvt(js, wd, DM, DFF, DM, (bf16_t*)(ws + WS_WD), DFF, 0, 0, 0);
}

extern "C" void kernel_launch(void* const* d_in, const int* in_sizes, int n_in, void* d_out, int out_size, void* d_ws, size_t ws_size, hipStream_t stream) {
    static int grid = 0;
    if (grid == 0) {
        int dev = 0, cus = 0, per_cu = 0;
        hipGetDevice(&dev); hipDeviceGetAttribute(&cus, hipDeviceAttributeMultiprocessorCount, dev);
        hipFuncSetAttribute((const void*)mega_fwd, hipFuncAttributeMaxDynamicSharedMemorySize, LDS_BYTES);
        hipOccupancyMaxActiveBlocksPerMultiprocessor(&per_cu, (const void*)mega_fwd, NTHREADS, LDS_BYTES);
        if (per_cu < 1) { fprintf(stderr, "occupancy query returned %d\n", per_cu); per_cu = 1; }
        grid = cus * 1;
        if (n_in != 40 || ws_size < 256 * MiB) fprintf(stderr, "unexpected n_in %d / ws %zu\n", n_in, ws_size);
    }
    static Params P;
    memset(&P, 0, sizeof(P));
    for (int i = 0; i < 40; ++i) P.in[i] = (const float*)d_in[i];
    P.out = (float*)d_out; P.ws = (unsigned char*)d_ws;
    unsigned char* ws = P.ws;
    const float* const* in = P.in;
    const size_t FW = (size_t)DM * DFF;
    { JobSet& js = P.js[0]; add_ffn(js, ws, in[2], in[3], in[4]);
      add_cvt(js, in[8], 3880, DM, 3880, (bf16_t*)(ws + WS_WIN), DM, 0, 2, 0);
      add_cvt(js, in[21], DM, 1536, DM, (bf16_t*)(ws + WS_WOUT), 1536, 0, 0, 0);
      add_cvt(js, in[10], 64, 1024, 64, (bf16_t*)(ws + WS_W1K), 1024, 0, 0, 0); add_cvt(js, in[10] + 1024 * 64, 64, 1024, 64, (bf16_t*)(ws + WS_W1K), 1024, 0, 0, 64);
      add_cvt(js, in[13], 64, 1024, 64, (bf16_t*)(ws + WS_W1V), 1024, 0, 0, 0); add_cvt(js, in[13] + 1024 * 64, 64, 1024, 64, (bf16_t*)(ws + WS_W1V), 1024, 0, 0, 64);
      add_zero(js, (bf16_t*)(ws + WS_W1K) + 128 * 1024, 128, 1024, 0, 1024); add_zero(js, (bf16_t*)(ws + WS_W1V) + 128 * 1024, 128, 1024, 0, 1024);
      add_zero(js, (bf16_t*)(ws + WS_WIN) + (size_t)(768 + 64) * DM, 64, DM, 0, DM); add_zero(js, (bf16_t*)(ws + WS_WIN) + (size_t)(768 + 128 + 64) * DM, 64, DM, 0, DM);
      add_zero(js, (bf16_t*)(ws + WS_WIN) + (size_t)(1280 + 128 + 40) * DM, 88, DM, 0, DM); }
    set_ffn(P.ffn2[0], ws, in[5], in[6], in[7]);
    { JobSet& js = P.js[1]; add_ffn(js, ws, in[2] + FW, in[3] + FW, in[4] + FW);
      bf16_t* wg1 = (bf16_t*)(ws + WS_WG1); const float* mu = in[22];
      const float* srcs[6] = {in[23], in[24], in[25], in[28], in[31], in[33]}; const int ncol[6] = {1024, 1024, 1024, 64, 64, 160}; const int roff[6] = {0, 1024, 2048, 3072, 3072 + 64, 3072 + 128}; const int mui[6] = {0, 2, 3, 1, 4, 5};
      for (int i = 0; i < 6; ++i) { add_cvt(js, srcs[i], ncol[i], DM, ncol[i], wg1, 2048, 0, 0, roff[i], mu + mui[i] * DM, 1); add_cvt(js, srcs[i], ncol[i], DM, ncol[i], wg1, 2048, 1024, 0, roff[i], mu + mui[i] * DM, 2); }
      add_zero(js, wg1 + (size_t)(3072 + 288) * 2048, 224, 2048, 0, 2048);
      add_cvt(js, in[26], DM, DM, DM, (bf16_t*)(ws + WS_WO), DM, 0, 0, 0);
      bf16_t* w2a = (bf16_t*)(ws + WS_W2A); add_cvt(js, in[29], DM, 64, DM, w2a, 128, 0, 0, 0); add_cvt(js, in[32], DM, 64, DM, w2a, 128, 64, 0, 1024);
      add_zero(js, w2a, 1024, 128, 64, 64); add_zero(js, w2a + 1024 * 128, 1024, 128, 0, 64);
      bf16_t* w2b = (bf16_t*)(ws + WS_W2B); add_cvt(js, in[34], DM, 160, DM, w2b, 256, 0, 0, 0); add_zero(js, w2b, 1024, 256, 192, 64); }
    set_ffn(P.ffn2[1], ws, in[5] + FW, in[6] + FW, in[7] + FW);
    hipMemsetAsync((char*)d_ws + WS_BAR, 0, 16384, stream);
    void* args[] = {&P};
    hipError_t e = hipLaunchCooperativeKernel((const void*)mega_fwd, dim3(grid), dim3(NTHREADS), args, LDS_BYTES, stream);
    if (e != hipSuccess) fprintf(stderr, "cooperative launch failed: %s (grid %d)\n", hipGetErrorString(e), grid);
}

#ifdef PHASE_TEST
#define TK(name, ...) __global__ void __launch_bounds__(NTHREADS, 2) name(Params P) { extern __shared__ __attribute__((aligned(16))) unsigned char lds_raw[]; LAS unsigned char* lds = (LAS unsigned char*)lds_raw; unsigned char* ws = P.ws; const int wv = __builtin_amdgcn_readfirstlane(threadIdx.x >> 6); __VA_ARGS__ }
TK(t_jobs, run_jobs(wv, P.js[0].cj, P.js[0].ncj, P.js[0].zj, P.js[0].nzj, lds); p0_misc(wv, P, lds);)
TK(t_row, row_phase(wv, 1, P.out, (const bf16_t*)(ws + WS_Y), P.in[1], 0.5f, P.in[1] + DM, P.out, (bf16_t*)(ws + WS_A), 1);)
TK(t_swiglu, { EpiSwiglu e{(bf16_t*)(ws + WS_H)}; GEMM_RUN(EpiSwiglu, e, ws + WS_A, ws + WS_WGU, MTOK, 2 * DFF, DM, DM, 0, 0); })
TK(t_f32, { EpiF32 e{(float*)(ws + WS_Y), DM}; GEMM_RUN(EpiF32, e, ws + WS_H, ws + WS_WD, MTOK, DM, DFF, DFF, 0, 0); })
TK(t_win, { EpiWin e{ws, P.in[17]};
              GEMM_RUN(EpiWin, e, ws + WS_A, ws + WS_WIN, MTOK, 4096, DM, DM, 0, 0); })
TK(t_conv, conv_phase(wv, P);)
TK(t_cmpfin, cmp_finish_phase(wv, P);)
TK(t_sstates, ssd_states_phase(wv, P, lds);)
TK(t_sscan, ssd_scan_phase(wv, P);)
TK(t_sout, ssd_out_phase(wv, P, lds);)
TK(t_nsa, nsa_phase(wv, P, lds);)
TK(t_rw1, { EpiRwkv1 e{ws}; GEMM_RUN(EpiRwkv1, e, ws + WS_A, ws + WS_WG1, MTOK, 3584, 2048, DM, DM * 2, 0); })
TK(t_rw2, { EpiRwkv2 e{(_Float16*)(ws + WS_LD), (bf16_t*)(ws + WS_AA), P.in[27], P.in[30]}; GEMM_RUN(EpiRwkv2, e, ws + WS_LH, ws + WS_W2A, MTOK, 2048, 128, 512, 0, 0); })
TK(t_bf16, { EpiBf16 e{(bf16_t*)(ws + WS_G), DM}; GEMM_RUN(EpiBf16, e, (bf16_t*)(ws + WS_LH) + 128, ws + WS_W2B, MTOK, DM, 256, 512, 0, 0); })
TK(t_scan, rwkv_scan_phase(wv, P, lds);)
TK(t_rpost, rwkv_post_phase(wv, P);)
#endif
```

```cpp
#include <hip/hip_runtime.h>
#include <hip/hip_cooperative_groups.h>
#include <cstdio>
#include <cstdint>
#include <cstring>
namespace cg = cooperative_groups;

#define LAS __attribute__((address_space(3)))
typedef unsigned short bf16_t;
typedef short bf16x8 __attribute__((ext_vector_type(8)));
typedef short s16x4 __attribute__((ext_vector_type(4)));
typedef float f32x4 __attribute__((ext_vector_type(4)));
typedef float f32x2 __attribute__((ext_vector_type(2)));
typedef float f32x16 __attribute__((ext_vector_type(16)));
typedef unsigned u32x4 __attribute__((ext_vector_type(4)));
typedef unsigned u32x2 __attribute__((ext_vector_type(2)));
typedef __bf16 bf16x2_t __attribute__((ext_vector_type(2)));
typedef _Float16 h16x2 __attribute__((ext_vector_type(2)));
#define DI __device__ __forceinline__

constexpr int NB = 2, SEQ = 8192, MTOK = NB * SEQ, DM = 1024, DFF = 2816;
constexpr int NTHREADS = 512, NWAVES = 8;
constexpr int LDS_BYTES = 147456;
constexpr size_t MiB = 1u << 20;
constexpr size_t WS_WGU = 0, WS_WD = 11 * MiB;
constexpr size_t WS_MIX = 17 * MiB;
constexpr size_t WS_WIN = WS_MIX, WS_WOUT = WS_MIX + 8 * MiB, WS_W1K = WS_MIX + 11 * MiB, WS_W1V = WS_W1K + MiB / 2;
constexpr size_t WS_WG1 = WS_MIX, WS_WO = WS_MIX + 14 * MiB, WS_W2A = WS_MIX + 16 * MiB, WS_W2B = WS_W2A + MiB / 2;
constexpr size_t WS_ROPE = 35 * MiB;
constexpr size_t WS_GATES = 37 * MiB;
constexpr size_t WS_DT = WS_GATES + 3 * MiB / 2;
constexpr size_t WS_PK = 40 * MiB, WS_PV = 42 * MiB;
constexpr size_t WS_KCC = 44 * MiB, WS_VCCT = WS_KCC + MiB / 4;
constexpr size_t WS_CDEC = WS_KCC + MiB / 2;
constexpr size_t WS_PEB = WS_CDEC + 64 * 1024;
constexpr size_t WS_RK = 45 * MiB;
constexpr size_t WS_BAR = 46 * MiB;
constexpr size_t WS_A = 47 * MiB;
constexpr size_t WS_BIG = 80 * MiB;
constexpr size_t WS_H = WS_BIG, WS_Y = WS_BIG + 88 * MiB;
constexpr size_t WS_Q = WS_BIG, WS_KCN = WS_BIG + 16 * MiB, WS_VCN = WS_KCN + 4 * MiB, WS_KS = WS_VCN + 4 * MiB, WS_VST = WS_KS + 4 * MiB,
                 WS_KW = WS_VST + 4 * MiB, WS_VWT = WS_KW + 4 * MiB, WS_Z = WS_BIG + 40 * MiB, WS_XBC = WS_BIG + 72 * MiB, WS_OCAT = WS_XBC,
                 WS_BM = WS_BIG + 120 * MiB, WS_BMT = WS_BM + 8 * MiB, WS_CM = WS_BMT + 8 * MiB, WS_ST = WS_BIG + 144 * MiB;
constexpr size_t WS_XS = WS_A;
constexpr size_t WS_YMIX0 = WS_BIG;
constexpr size_t WS_R = WS_BIG, WS_K = WS_BIG + 32 * MiB, WS_V = WS_BIG + 64 * MiB, WS_LH = WS_BIG + 96 * MiB, WS_LD = WS_BIG + 112 * MiB,
                 WS_AA = WS_BIG + 144 * MiB, WS_YS = WS_A, WS_G = WS_LD, WS_A2 = WS_R, WS_YMIX1 = WS_K;
static_assert(WS_ST + 32 * MiB <= 256 * MiB && WS_AA + 32 * MiB <= 256 * MiB && WS_Y + 64 * MiB <= 256 * MiB, "ws map");

DI unsigned pk2(float lo, float hi) { f32x2 v = {lo, hi}; bf16x2_t b = __builtin_convertvector(v, bf16x2_t); return __builtin_bit_cast(unsigned, b); }
DI float bf2f(unsigned short u) { return __uint_as_float(((unsigned)u) << 16); }
DI float bflo(unsigned u) { return __uint_as_float(u << 16); }
DI float bfhi(unsigned u) { return __uint_as_float(u & 0xffff0000u); }
DI float sigmoidf_(float x) { return 1.f / (1.f + __expf(-x)); }
DI float siluf_(float x) { return x / (1.f + __expf(-x)); }
DI float softplusf_(float x) { return fmaxf(x, 0.f) + log1pf(expf(-fabsf(x))); }
DI float softplus_fast(float x) { return fmaxf(x, 0.f) + __logf(1.f + __expf(-fabsf(x))); }
DI float tanh_fast(float x) { const float e = __expf(2.f * x); return 1.f - 2.f / (e + 1.f); }
DI int tid_fresh(int wv) { int l; asm volatile("v_mbcnt_lo_u32_b32 %0, -1, 0\n\tv_mbcnt_hi_u32_b32 %0, -1, %0" : "=v"(l)); return wv * 64 + l; }
DI unsigned char* ws_fresh(unsigned char* w) { asm volatile("" : "+s"(w)); return w; }
DI int crow(int r, int hi) { return (r & 3) + 8 * (r >> 2) + 4 * hi; }
template <int CTRL> DI float dpp_f(float v) { return __builtin_bit_cast(float, __builtin_amdgcn_update_dpp(0, __builtin_bit_cast(int, v), CTRL, 0xf, 0xf, true)); }
DI float wave_sum(float v) {
    v += dpp_f<0xB1>(v); v += dpp_f<0x4E>(v); v += dpp_f<0x141>(v); v += dpp_f<0x140>(v);
    { auto r = __builtin_amdgcn_permlane16_swap(__float_as_uint(v), __float_as_uint(v), false, false); v = __uint_as_float(r[0]) + __uint_as_float(r[1]); }
    { auto r = __builtin_amdgcn_permlane32_swap(__float_as_uint(v), __float_as_uint(v), false, false); v = __uint_as_float(r[0]) + __uint_as_float(r[1]); }
    return v;
}
DI float quad_sum(float v) { v += dpp_f<0xB1>(v); v += dpp_f<0x4E>(v); return v; }
DI float xhalf(float v) { return __shfl_xor(v, 32); }
DI float xmax32(float v) { auto r = __builtin_amdgcn_permlane32_swap(__float_as_uint(v), __float_as_uint(v), false, false); return fmaxf(__uint_as_float(r[0]), __uint_as_float(r[1])); }
DI float xsum32(float v) { auto r = __builtin_amdgcn_permlane32_swap(__float_as_uint(v), __float_as_uint(v), false, false); return __uint_as_float(r[0]) + __uint_as_float(r[1]); }
DI float xother32(float v, int hh) { auto r = __builtin_amdgcn_permlane32_swap(__float_as_uint(v), __float_as_uint(v), false, false); return __uint_as_float(hh ? r[0] : r[1]); }
#define EXP2(x) __builtin_amdgcn_exp2f(x)
#define MFMA32(a, b, c) __builtin_amdgcn_mfma_f32_32x32x16_bf16((a), (b), (c), 0, 0, 0)

namespace pg8 {
constexpr int BM = 256, BK = 64, HALF = 128, HTB = HALF * BK * 2, STAGE_BYTES = 8 * HTB, NXCD = 8, WGM = 8;
DI int lds_byte(int r, int c) { const int st = (r >> 4) * 2 + (c >> 5), rr = r & 15, cc = c & 31, ob = rr * 64 + cc * 2; return st * 1024 + (ob ^ (((ob >> 9) & 1) << 5)); }
DI void stage_rc(int b, int& R, int& C) { const int st = b / 1024, sb = b % 1024, swz = sb ^ (((sb >> 9) & 1) << 5); R = (st >> 1) * 16 + swz / 64; C = (st & 1) * 32 + (swz % 64) / 2; }
DI int perm32(int rho) { const int n = rho >> 4, i = rho & 15; return 8 * (i >> 2) + 4 * n + (i & 3); }
struct Unit { int pm, pn; };
struct Gemm { const bf16_t* A; const bf16_t* Bt; int M, N, K; int lda; int padA; };
struct StaticOrder {
    int nM, nN, nwg, G, c;
    DI void init(int M, int N, int G_, int c_) { nM = M / BM; nN = N / BM; nwg = nM * nN; G = G_; c = c_; }
    DI bool next(int i, Unit& u) const {
        const long L = (long)i * G + c; if (L >= nwg) return false;
        int wgid = (int)L; { const int q = nwg / NXCD, r = nwg % NXCD, xcd = wgid % NXCD, off = wgid / NXCD; wgid = (xcd < r ? xcd * (q + 1) : r * (q + 1) + (xcd - r) * q) + off; }
        const int nig = WGM * nN, gid = wgid / nig, fm = gid * WGM, gsz = (nM - fm) < WGM ? (nM - fm) : WGM;
        u.pm = fm + ((wgid % nig) % gsz); u.pn = (wgid % nig) / gsz; return true;
    }
};
template <class Epi>
DI void gemm_phase(int wv, LAS unsigned char* lds, const Gemm g, const StaticOrder& S, const Epi& E) {
    const int tid = tid_fresh(wv), wid = __builtin_amdgcn_readfirstlane(tid >> 6), lane = tid & 63, wr = wid >> 2, wc = wid & 3, fr = lane & 15, fq = lane >> 4;
    const int K = g.K, nt = K / BK, lda = g.lda;
    unsigned voffA[2], voffB[2];
#pragma unroll
    for (int i = 0; i < 2; ++i) { int R, C; stage_rc(tid * 16 + i * 8192, R, C); const int Rb = (R & ~31) + perm32(R & 31);
        voffA[i] = (unsigned)(R * lda + C) * 2u; voffB[i] = (unsigned)(Rb * K + C) * 2u; }
    const size_t kstep = (size_t)(BK * 2);
    const size_t hA = (size_t)HALF * lda * 2, hB = (size_t)HALF * K * 2, tA = 2 * hA, tB = 2 * hB;
    const unsigned ldsw = (unsigned)wid * 1024u;
    const int aoff = lds_byte(wr * 64 + fr, fq * 8), boff = lds_byte(wc * 32 + fr, fq * 8);
#define PG8_SA(b, h) (((b) * 2 + (h)) * HTB)
#define PG8_SB(b, h) ((4 + (b) * 2 + (h)) * HTB)
#define PG8_STAGE(bufoff, gbase, voff) do { _Pragma("unroll") for (int _i = 0; _i < 2; ++_i) \
        __builtin_amdgcn_global_load_lds((const unsigned*)((const char*)(gbase) + (voff)[_i]), (LAS unsigned*)(lds + (bufoff) + ldsw + _i * 8192), 16, 0, 0); } while (0)
#define PG8_LDA(dst, b, h) do { _Pragma("unroll") for (int m = 0; m < 4; ++m) _Pragma("unroll") for (int k = 0; k < 2; ++k) dst[m][k] = *(const LAS bf16x8*)(lds + PG8_SA(b, h) + aoff + m * 2048 + k * 1024); } while (0)
#define PG8_LDB(dst, b, h) do { _Pragma("unroll") for (int n = 0; n < 2; ++n) _Pragma("unroll") for (int k = 0; k < 2; ++k) dst[n][k] = *(const LAS bf16x8*)(lds + PG8_SB(b, h) + boff + n * 2048 + k * 1024); } while (0)
#define PG8_MMA(ai, bj, At, Bt) do { __builtin_amdgcn_s_setprio(1); _Pragma("unroll") for (int m = 0; m < 4; ++m) _Pragma("unroll") for (int n = 0; n < 2; ++n) _Pragma("unroll") for (int k = 0; k < 2; ++k) \
        acc[ai][bj][m][n] = __builtin_amdgcn_mfma_f32_16x16x32_bf16(Bt[n][k], At[m][k], acc[ai][bj][m][n], 0, 0, 0); __builtin_amdgcn_s_setprio(0); } while (0)
#define PG8_WAIT_V(n) asm volatile("s_waitcnt vmcnt(" #n ")" ::: "memory")
#define PG8_WAIT_L(n) asm volatile("s_waitcnt lgkmcnt(" #n ")" ::: "memory")
#define PG8_BAR __builtin_amdgcn_s_barrier()
#define PG8_SCHED __builtin_amdgcn_sched_barrier(0)
#define PG8_ABASE(u) ((const char*)g.A + (size_t)(u).pm * tA + (size_t)((u).pm >> 5) * (size_t)g.padA)
    Unit cur, nxt; int ui = 0;
    if (!S.next(0, cur)) return;
    f32x4 acc[2][2][4][2];
#pragma unroll
    for (int a = 0; a < 2; ++a)
#pragma unroll
        for (int b = 0; b < 2; ++b)
#pragma unroll
            for (int m = 0; m < 4; ++m)
#pragma unroll
                for (int n = 0; n < 2; ++n) acc[a][b][m][n] = (f32x4){0.f, 0.f, 0.f, 0.f};
    bf16x8 At[4][2], B0[2][2], B1[2][2];
    const char* cA = PG8_ABASE(cur); const char* cB = (const char*)g.Bt + (size_t)cur.pn * tB;
    PG8_STAGE(PG8_SB(0, 0), cB, voffB); PG8_STAGE(PG8_SB(0, 1), cB + hB, voffB); PG8_STAGE(PG8_SA(0, 0), cA, voffA); PG8_STAGE(PG8_SA(0, 1), cA + hA, voffA);
    if (wr == 1) PG8_BAR;
    PG8_WAIT_V(2); PG8_BAR;
    PG8_STAGE(PG8_SB(1, 0), cB + kstep, voffB); PG8_STAGE(PG8_SA(1, 0), cA + kstep, voffA); PG8_STAGE(PG8_SB(1, 1), cB + hB + kstep, voffB);
    PG8_WAIT_V(6); PG8_BAR;
    for (;;) {
        const bool has_next = S.next(ui + 1, nxt);
        const char* nA = has_next ? PG8_ABASE(nxt) : cA; const char* nB = has_next ? (const char*)g.Bt + (size_t)nxt.pn * tB : cB;
#pragma unroll 1
        for (int t = 0; t < nt; t += 2) {
            const bool last = (t == nt - 2);
            const char* a1 = cA + (size_t)(t + 1) * kstep;
            const char* a2 = last ? nA : cA + (size_t)(t + 2) * kstep; const char* b2 = last ? nB : cB + (size_t)(t + 2) * kstep;
            const char* a3 = a2 + kstep; const char* b3 = b2 + kstep;
            PG8_LDB(B0, 0, 0); PG8_LDB(B1, 0, 1); PG8_SCHED; PG8_LDA(At, 0, 0); PG8_STAGE(PG8_SA(1, 1), a1 + hA, voffA);
            PG8_WAIT_V(8); PG8_WAIT_L(0); PG8_BAR; PG8_MMA(0, 0, At, B0); PG8_MMA(0, 1, At, B1); PG8_BAR; PG8_SCHED;
            PG8_LDA(At, 0, 1); PG8_STAGE(PG8_SB(0, 0), b2, voffB); PG8_STAGE(PG8_SB(0, 1), b2 + hB, voffB); PG8_STAGE(PG8_SA(0, 0), a2, voffA);
            PG8_WAIT_V(8); PG8_WAIT_L(0); PG8_BAR; PG8_MMA(1, 0, At, B0); PG8_MMA(1, 1, At, B1); PG8_BAR; PG8_SCHED;
            PG8_LDB(B0, 1, 0); PG8_LDB(B1, 1, 1); PG8_SCHED; PG8_LDA(At, 1, 0); PG8_STAGE(PG8_SA(0, 1), a2 + hA, voffA);
            PG8_WAIT_V(8); PG8_WAIT_L(0); PG8_BAR; PG8_MMA(0, 0, At, B0); PG8_MMA(0, 1, At, B1); PG8_BAR; PG8_SCHED;
            PG8_LDA(At, 1, 1); PG8_STAGE(PG8_SB(1, 0), b3, voffB); PG8_STAGE(PG8_SB(1, 1), b3 + hB, voffB); PG8_STAGE(PG8_SA(1, 0), a3, voffA);
            PG8_WAIT_V(8); PG8_WAIT_L(0); PG8_BAR; PG8_MMA(1, 0, At, B0); PG8_MMA(1, 1, At, B1); PG8_BAR; PG8_SCHED;
        }
        if (wr == 0) PG8_BAR;
        { int fr2 = fr, fq2 = fq; asm volatile("" : "+v"(fr2), "+v"(fq2)); E(acc, cur, wr, wc, fr2, fq2); }
        if (!has_next) break;
#pragma unroll
        for (int a = 0; a < 2; ++a)
#pragma unroll
            for (int b = 0; b < 2; ++b)
#pragma unroll
                for (int m = 0; m < 4; ++m)
#pragma unroll
                    for (int n = 0; n < 2; ++n) acc[a][b][m][n] = (f32x4){0.f, 0.f, 0.f, 0.f};
        cur = nxt; cA = nA; cB = nB; ++ui;
        if (wr == 1) PG8_BAR;
    }
    PG8_WAIT_V(0);
    PG8_BAR;
#undef PG8_SA
#undef PG8_SB
#undef PG8_STAGE
#undef PG8_LDA
#undef PG8_LDB
#undef PG8_MMA
#undef PG8_WAIT_V
#undef PG8_WAIT_L
#undef PG8_BAR
#undef PG8_SCHED
#undef PG8_ABASE
}
}
using pg8::Unit;
typedef f32x4 Acc[2][2][4][2];

#define EPI_ROWS(...) _Pragma("unroll") for (int ai = 0; ai < 2; ++ai) _Pragma("unroll") for (int m = 0; m < 4; ++m) { const int row = u.pm * 256 + ai * 128 + wr * 64 + m * 16 + fr; __VA_ARGS__ }
DI void st16_wt(void* p, u32x4 v) { asm volatile("global_store_dwordx4 %0, %1, off sc0 sc1\n\ts_nop 1" :: "v"(p), "v"(v) : "memory"); }
DI u32x4 pack8(f32x4 a, f32x4 b) { u32x4 w; w.x = pk2(a[0], a[1]); w.y = pk2(a[2], a[3]); w.z = pk2(b[0], b[1]); w.w = pk2(b[2], b[3]); return w; }

struct EpiF32 {
    float* O; int ldc;
    DI void operator()(const Acc& acc, const Unit& u, int wr, int wc, int fr, int fq) const {
        const int c0 = u.pn * 256 + wc * 32 + 8 * fq;
        EPI_ROWS( float* rp = O + (size_t)row * ldc + c0;
            _Pragma("unroll") for (int bj = 0; bj < 2; ++bj) { *(f32x4*)(rp + bj * 128) = acc[ai][bj][m][0]; *(f32x4*)(rp + bj * 128 + 4) = acc[ai][bj][m][1]; } )
    }
};
struct EpiBf16 {
    bf16_t* O; int ldc;
    DI void operator()(const Acc& acc, const Unit& u, int wr, int wc, int fr, int fq) const {
        const int c0 = u.pn * 256 + wc * 32 + 8 * fq;
        EPI_ROWS( bf16_t* rp = O + (size_t)row * ldc + c0;
            _Pragma("unroll") for (int bj = 0; bj < 2; ++bj) st16_wt(rp + bj * 128, pack8(acc[ai][bj][m][0], acc[ai][bj][m][1])); )
    }
};
struct EpiSwiglu {
    bf16_t* H;
    DI void operator()(const Acc& acc, const Unit& u, int wr, int wc, int fr, int fq) const {
        const int c0 = u.pn * 128 + wc * 32 + 8 * fq;
        EPI_ROWS( f32x4 a, b;
            _Pragma("unroll") for (int e = 0; e < 4; ++e) { a[e] = siluf_(acc[ai][0][m][0][e]) * acc[ai][1][m][0][e]; b[e] = siluf_(acc[ai][0][m][1][e]) * acc[ai][1][m][1][e]; }
            st16_wt(H + (size_t)row * DFF + c0, pack8(a, b)); )
    }
};
#define TS_(e) { const unsigned w0_ = pk2(ta0[e], ta1[e]); vt[(size_t)(e) * SEQ] = (bf16_t)(w0_ & 0xffff); vt[(size_t)((e) + 4) * SEQ] = (bf16_t)(w0_ >> 16); }
#define GV_(n, e) { const int c_ = cb + 4 * (n) + (e); const float v_ = (n) ? tb1[e] : tb0[e]; if (c_ < 24) GATES[(size_t)row * 24 + c_] = sigmoidf_(v_); else if (c_ < 40) DT[(size_t)row * 16 + c_ - 24] = softplus_fast(v_ + dt_bias[c_ - 24]); }
struct EpiWin {
    unsigned char* ws; const float* dt_bias;
    DI void operator()(const Acc& acc, const Unit& u, int wr, int wc, int fr, int fq) const {
        const int pn = u.pn;
        bf16_t* const Q = (bf16_t*)(ws + WS_Q); bf16_t* const VCN = (bf16_t*)(ws + WS_VCN); bf16_t* const VST = (bf16_t*)(ws + WS_VST); bf16_t* const VWT = (bf16_t*)(ws + WS_VWT);
        float* const GATES = (float*)(ws + WS_GATES); float* const DT = (float*)(ws + WS_DT); const float* const cosT = (const float*)(ws + WS_ROPE); const float* const sinT = cosT + SEQ * 32;
        if (pn <= 3) {
            if (pn == 3 && wc >= 2) return;
            const int d0 = 8 * fq;
            EPI_ROWS( const int t = row & (SEQ - 1), b = row >> 13;
                const f32x4 c0 = *(const f32x4*)(cosT + t * 32 + d0), c1 = *(const f32x4*)(cosT + t * 32 + d0 + 4);
                const f32x4 s0 = *(const f32x4*)(sinT + t * 32 + d0), s1 = *(const f32x4*)(sinT + t * 32 + d0 + 4);
                const f32x4 x10 = acc[ai][0][m][0], x11 = acc[ai][0][m][1], x20 = acc[ai][1][m][0], x21 = acc[ai][1][m][1];
                f32x4 o10 = x10 * c0 - x20 * s0, o11 = x11 * c1 - x21 * s1, o20 = x20 * c0 + x10 * s0, o21 = x21 * c1 + x11 * s1;
                bf16_t* dst;
                if (pn < 2) { const float qs = 0.125f * 1.4426950408889634f; o10 *= qs; o11 *= qs; o20 *= qs; o21 *= qs; dst = Q + (size_t)row * 512 + (pn * 4 + wc) * 64; }
                else { const size_t boff = (pn == 2) ? (wc < 2 ? WS_KCN : WS_KS) : WS_KW; dst = (bf16_t*)(ws + boff) + ((size_t)(b * 2 + (wc & 1)) * SEQ + t) * 64; }
                *(u32x4*)(dst + d0) = pack8(o10, o11); *(u32x4*)(dst + 32 + d0) = pack8(o20, o21); asm volatile("" ::: "memory"); )
        } else if (pn == 4 || pn == 5) {
            const int h = wc >> 1, d0 = (wc & 1) * 32 + 8 * fq;
            EPI_ROWS( const int t = row & (SEQ - 1), b = row >> 13;
                if (pn == 4) *(u32x4*)(VCN + ((size_t)(b * 2 + h) * SEQ + t) * 64 + d0) = pack8(acc[ai][0][m][0], acc[ai][0][m][1]);
                if (pn == 4) { bf16_t* vt = VST + ((size_t)(b * 2 + h) * 64 + d0) * SEQ + t; const f32x4 ta0 = acc[ai][1][m][0], ta1 = acc[ai][1][m][1]; TS_(0) TS_(1) TS_(2) TS_(3) }
                else { bf16_t* vt = VWT + ((size_t)(b * 2 + h) * 64 + d0) * SEQ + t; const f32x4 ta0 = acc[ai][0][m][0], ta1 = acc[ai][0][m][1]; TS_(0) TS_(1) TS_(2) TS_(3)
                  const int cb = wc * 32 + 8 * fq; const f32x4 tb0 = acc[ai][1][m][0], tb1 = acc[ai][1][m][1];
                  if (cb < 40) { GV_(0, 0) GV_(0, 1) GV_(0, 2) GV_(0, 3) GV_(1, 0) GV_(1, 1) GV_(1, 2) GV_(1, 3) } } )
        } else {
            bf16_t* O = (bf16_t*)(ws + ((pn < 10) ? WS_Z : WS_XBC)); const int ldc = (pn < 10) ? 1024 : 1536; const int c0 = (pn < 10 ? (pn - 6) : (pn - 10)) * 256 + wc * 32 + 8 * fq;
            EPI_ROWS( bf16_t* rp = O + (size_t)row * ldc + c0;
                _Pragma("unroll") for (int bj = 0; bj < 2; ++bj) st16_wt(rp + bj * 128, pack8(acc[ai][bj][m][0], acc[ai][bj][m][1])); )
        }
    }
};
struct EpiRwkv1 {
    unsigned char* ws;
    DI void operator()(const Acc& acc, const Unit& u, int wr, int wc, int fr, int fq) const {
        const int pn = u.pn; bf16_t* const LH = (bf16_t*)(ws + WS_LH);
        if (pn < 12) { bf16_t* O = (bf16_t*)(ws + (pn < 4 ? WS_R : (pn < 8 ? WS_K : WS_V))); const int c0 = (pn & 3) * 256 + wc * 32 + 8 * fq;
            EPI_ROWS( bf16_t* rp = O + (size_t)row * 1024 + c0;
                _Pragma("unroll") for (int bj = 0; bj < 2; ++bj) st16_wt(rp + bj * 128, pack8(acc[ai][bj][m][0], acc[ai][bj][m][1])); )
        } else {
            EPI_ROWS( _Pragma("unroll") for (int bj = 0; bj < 2; ++bj) { const int c0 = (pn - 12) * 256 + bj * 128 + wc * 32 + 8 * fq; f32x4 a = acc[ai][bj][m][0], b = acc[ai][bj][m][1];
                    if (c0 < 64) { _Pragma("unroll") for (int e = 0; e < 4; ++e) { a[e] = tanh_fast(a[e]); b[e] = tanh_fast(b[e]); } }
                    else if (c0 >= 128) { _Pragma("unroll") for (int e = 0; e < 4; ++e) { a[e] = sigmoidf_(a[e]); b[e] = sigmoidf_(b[e]); } }
                    *(u32x4*)(LH + (size_t)row * 512 + c0) = pack8(a, b); } )
        }
    }
};
struct EpiRwkv2 {
    _Float16* LD; bf16_t* AA; const float *w0, *a0;
    DI void operator()(const Acc& acc, const Unit& u, int wr, int wc, int fr, int fq) const {
        const int pn = u.pn;
        EPI_ROWS( _Pragma("unroll") for (int bj = 0; bj < 2; ++bj) { const int c0 = (pn & 3) * 256 + bj * 128 + wc * 32 + 8 * fq;
                if (pn < 4) { u32x4 o;
                    _Pragma("unroll") for (int n = 0; n < 2; ++n) _Pragma("unroll") for (int e2 = 0; e2 < 2; ++e2) {
                        const float wa = -softplus_fast(-(w0[c0 + 4 * n + 2 * e2] + acc[ai][bj][m][n][2 * e2])) - 0.5f, wb = -softplus_fast(-(w0[c0 + 4 * n + 2 * e2 + 1] + acc[ai][bj][m][n][2 * e2 + 1])) - 0.5f;
                        h16x2 hv = {(_Float16)(-__expf(wa)), (_Float16)(-__expf(wb))}; o[2 * n + e2] = __builtin_bit_cast(unsigned, hv); }
                    *(u32x4*)(LD + (size_t)row * 1024 + c0) = o;
                } else { f32x4 a, b;
                    _Pragma("unroll") for (int e = 0; e < 4; ++e) { a[e] = sigmoidf_(a0[c0 + e] + acc[ai][bj][m][0][e]); b[e] = sigmoidf_(a0[c0 + 4 + e] + acc[ai][bj][m][1][e]); }
                    *(u32x4*)(AA + (size_t)row * 1024 + c0) = pack8(a, b); } } )
    }
};

struct CvtJob { const float* src; const float* scale; bf16_t* dst; int ldw, K, N, ldk, koff, mode, rowoff, smode; };
struct ZeroJob { bf16_t* dst; int rows, ldk, c0, nc; int pad; };
constexpr int MAXJ = 20, MAXZ = 8;
struct JobSet { CvtJob cj[MAXJ]; ZeroJob zj[MAXZ]; int ncj, nzj; };
struct Params {
    const float* in[40]; float* out; unsigned char* ws;
    JobSet js[2];
    CvtJob ffn2[2][3];
};

DI int win_rowmap(int c) {
    if (c < 512) { const int hq = c >> 6, d = c & 63; return (hq >> 2) * 256 + (d < 32 ? 0 : 128) + (hq & 3) * 32 + (d & 31); }
    if (c < 1280) { const int seg = (c - 512) >> 7, cc = (c - 512) & 127, h = cc >> 6, d = cc & 63;
        if (seg == 0 || seg == 2 || seg == 4) { const int tile = (seg == 4) ? 3 : 2, hl = (seg == 2 ? 2 : 0) + h; return tile * 256 + (d < 32 ? 0 : 128) + hl * 32 + (d & 31); }
        if (seg == 1) return 1024 + cc; if (seg == 3) return 1024 + 128 + cc; return 1280 + cc; }
    if (c < 1304) return 1280 + 128 + (c - 1280);
    if (c < 2328) return 1536 + (c - 1304);
    if (c < 3864) return 2560 + (c - 2328);
    return 1280 + 128 + 24 + (c - 3864);
}
DI void cvt_item(const CvtJob& J, int item, LAS float* scr, int lane) {
    const int nblk = (J.N + 31) >> 5, kb = item / nblk, nb = item % nblk, k0 = 64 * kb, n0 = 32 * nb;
#pragma unroll 8
    for (int i = 0; i < 32; ++i) { const int kk = 2 * i + (lane >> 5), k = k0 + kk, n = n0 + (lane & 31);
        float v = 0.f; if (k < J.K && n < J.N) { v = J.src[(size_t)k * J.ldw + n]; if (J.smode == 1) v *= J.scale[k]; else if (J.smode == 2) v *= (1.f - J.scale[k]); }
        scr[kk * 33 + (lane & 31)] = v; }
    asm volatile("s_waitcnt lgkmcnt(0)" ::: "memory");
    const int c = lane & 7;
#pragma unroll
    for (int j = 0; j < 4; ++j) { const int nl = (lane >> 3) + 8 * j, n = n0 + nl; const LAS float* s = scr + (8 * c) * 33 + nl;
        if (n < J.N) { u32x4 o; o.x = pk2(s[0], s[33]); o.y = pk2(s[2 * 33], s[3 * 33]); o.z = pk2(s[4 * 33], s[5 * 33]); o.w = pk2(s[6 * 33], s[7 * 33]);
            int row; if (J.mode == 0) row = J.rowoff + n; else if (J.mode == 1) row = (n >> 7) * 256 + (n & 127) + J.rowoff; else row = win_rowmap(n);
            *(u32x4*)(J.dst + (size_t)row * J.ldk + J.koff + k0 + 8 * c) = o; } }
    asm volatile("s_waitcnt lgkmcnt(0)" ::: "memory");
}
DI void run_jobs(int wv, const CvtJob* cjs, int ncj, const ZeroJob* zjs, int nzj, LAS unsigned char* lds) {
    const int tid_ = tid_fresh(wv);
    const int lane = tid_ & 63, wave = tid_ >> 6, gw = blockIdx.x * NWAVES + wave, NGW = gridDim.x * NWAVES;
    LAS float* scr = (LAS float*)(lds + wave * 16384);
    int base = 0;
    for (int j = 0; j < ncj; ++j) { const CvtJob& J = cjs[j]; const int nit = ((J.K + 63) >> 6) * ((J.N + 31) >> 5);
        int first = (gw - base) % NGW; if (first < 0) first += NGW;
        for (int it = first; it < nit; it += NGW) cvt_item(J, it, scr, lane);
        base = (base + nit) % NGW; }
    const int gt = blockIdx.x * NTHREADS + tid_, NGT = gridDim.x * NTHREADS;
    for (int j = 0; j < nzj; ++j) { const ZeroJob& Z = zjs[j]; const int per = Z.nc >> 3, tot = Z.rows * per;
        for (int i = gt; i < tot; i += NGT) { const int r = i / per, c = (i % per) * 8; *(u32x4*)(Z.dst + (size_t)r * Z.ldk + Z.c0 + c) = (u32x4){0u, 0u, 0u, 0u}; } }
}

DI void row_phase(int wv, int mode, const float* X, const bf16_t* Y, const float* ga, float coef, const float* gb, float* Xout, bf16_t* A, int a_pad) {
    const int tid_ = tid_fresh(wv);
    const int lane = tid_ & 63, gw = blockIdx.x * NWAVES + (tid_ >> 6), NGW = gridDim.x * NWAVES;
    for (int r = gw; r < MTOK; r += NGW) {
        f32x4 v[4];
#pragma unroll
        for (int j = 0; j < 4; ++j) v[j] = *(const f32x4*)(X + (size_t)r * DM + 4 * lane + 256 * j);
        if (mode == 1) { f32x4 y[4]; float s = 0.f;
#pragma unroll
            for (int j = 0; j < 4; ++j) { const u32x2 yv = *(const u32x2*)(Y + (size_t)r * DM + 4 * lane + 256 * j); y[j] = (f32x4){bflo(yv.x), bfhi(yv.x), bflo(yv.y), bfhi(yv.y)}; s += y[j][0] * y[j][0] + y[j][1] * y[j][1] + y[j][2] * y[j][2] + y[j][3] * y[j][3]; }
            const float rs = coef * rsqrtf(wave_sum(s) * (1.f / DM) + 1e-6f);
#pragma unroll
            for (int j = 0; j < 4; ++j) { const f32x4 gg = *(const f32x4*)(ga + 4 * lane + 256 * j); v[j] += y[j] * gg * rs; } }
        if (Xout) {
#pragma unroll
            for (int j = 0; j < 4; ++j) st16_wt(Xout + (size_t)r * DM + 4 * lane + 256 * j, __builtin_bit_cast(u32x4, v[j])); }
        if (gb) { float s = 0.f;
#pragma unroll
            for (int j = 0; j < 4; ++j) s += v[j][0] * v[j][0] + v[j][1] * v[j][1] + v[j][2] * v[j][2] + v[j][3] * v[j][3];
            const float rs = rsqrtf(wave_sum(s) * (1.f / DM) + 1e-6f);
            const size_t ar = a_pad ? (size_t)(r + (r >> 13) + 1) : (size_t)r;
#pragma unroll
            for (int j = 0; j < 4; ++j) { const f32x4 gg = *(const f32x4*)(gb + 4 * lane + 256 * j); const f32x4 o = v[j] * gg * rs;
                u32x2 w; w.x = pk2(o[0], o[1]); w.y = pk2(o[2], o[3]); *(u32x2*)(A + ar * DM + 4 * lane + 256 * j) = w; } }
    }
    if (a_pad && gb) { const int gt = blockIdx.x * NTHREADS + tid_; if (gt < 256) { const int b = gt >> 7, c = (gt & 127) * 8; *(u32x4*)(A + (size_t)b * (SEQ + 1) * DM + c) = (u32x4){0u, 0u, 0u, 0u}; } }
}

DI void p0_misc(int wv, const Params& P, LAS unsigned char* lds) {
    unsigned char* const ws_ = ws_fresh(P.ws);
    const int tid_ = tid_fresh(wv);
    float* cosT = (float*)(ws_ + WS_ROPE); float* sinT = cosT + SEQ * 32;
    const int gt = blockIdx.x * NTHREADS + tid_, NGT = gridDim.x * NTHREADS;
    for (int i = gt; i < SEQ * 32; i += NGT) { const int t = i >> 5, k = i & 31; const float inv = powf(10000.f, -(float)(2 * k) / 64.f); const float ang = (float)t * inv; cosT[i] = cosf(ang); sinT[i] = sinf(ang); }
    if (blockIdx.x < 2) {
        const float* pe = P.in[blockIdx.x == 0 ? 9 : 12]; const float* w1 = P.in[blockIdx.x == 0 ? 10 : 13];
        LAS float* red = (LAS float*)lds; const int j = tid_ & 63, part = tid_ >> 6; float s = 0.f;
        for (int k = part; k < 2048; k += 8) s += pe[k] * w1[k * 64 + j];
        red[part * 64 + j] = s; __syncthreads();
        if (tid_ < 64) { float t = 0.f; for (int p = 0; p < 8; ++p) t += red[p * 64 + j]; ((float*)(ws_ + WS_PEB))[blockIdx.x * 64 + j] = t; }
        __syncthreads();
    }
}

DI void conv_phase(int wv, const Params& P) {
    unsigned char* const ws_ = ws_fresh(P.ws);
    const int tid_ = tid_fresh(wv);
    const bf16_t* XBC = (const bf16_t*)(ws_ + WS_XBC); bf16_t* XS = (bf16_t*)(ws_ + WS_XS); bf16_t* BM = (bf16_t*)(ws_ + WS_BM); bf16_t* BMT = (bf16_t*)(ws_ + WS_BMT); bf16_t* CM = (bf16_t*)(ws_ + WS_CM);
    const float* cw = P.in[15]; const float* cb = P.in[16];
    const int gt = blockIdx.x * NTHREADS + tid_, NGT = gridDim.x * NTHREADS;
    for (int it = gt; it < (MTOK / 8) * 192; it += NGT) {
        const int tt = it / 192, cg8 = it % 192, c0 = cg8 * 8, r0 = tt * 8, t0 = r0 & (SEQ - 1), b = r0 >> 13;
        float w[4][8], bias[8];
#pragma unroll
        for (int k = 0; k < 4; ++k) { const f32x4 a = *(const f32x4*)(cw + k * 1536 + c0), bq = *(const f32x4*)(cw + k * 1536 + c0 + 4);
#pragma unroll
            for (int e = 0; e < 4; ++e) { w[k][e] = a[e]; w[k][4 + e] = bq[e]; } }
        { const f32x4 a = *(const f32x4*)(cb + c0), bq = *(const f32x4*)(cb + c0 + 4);
#pragma unroll
          for (int e = 0; e < 4; ++e) { bias[e] = a[e]; bias[4 + e] = bq[e]; } }
        float x[11][8];
#pragma unroll
        for (int i = 0; i < 11; ++i) { u32x4 q = (u32x4){0u, 0u, 0u, 0u}; if (i >= 3 || t0 != 0) q = *(const u32x4*)(XBC + (size_t)(r0 + i - 3) * 1536 + c0);
#pragma unroll
            for (int e = 0; e < 4; ++e) { x[i][2 * e] = bflo(q[e]); x[i][2 * e + 1] = bfhi(q[e]); } }
        unsigned o[8][4];
#pragma unroll
        for (int i = 0; i < 8; ++i) { float y[8];
#pragma unroll
            for (int e = 0; e < 8; ++e) { float s = bias[e];
#pragma unroll
                for (int k = 0; k < 4; ++k) s += w[k][e] * x[i + k][e];
                y[e] = siluf_(s); }
#pragma unroll
            for (int e = 0; e < 4; ++e) o[i][e] = pk2(y[2 * e], y[2 * e + 1]); }
        if (c0 < 1024) {
#pragma unroll
            for (int i = 0; i < 8; ++i) *(u32x4*)(XS + (size_t)(r0 + i) * 1024 + c0) = (u32x4){o[i][0], o[i][1], o[i][2], o[i][3]};
        } else if (c0 < 1280) { const int cc = c0 - 1024, g = cc >> 7, n0 = cc & 127;
#pragma unroll
            for (int i = 0; i < 8; ++i) *(u32x4*)(BM + (size_t)(r0 + i) * 256 + cc) = (u32x4){o[i][0], o[i][1], o[i][2], o[i][3]};
#pragma unroll
            for (int e = 0; e < 8; ++e) { u32x4 q;
#pragma unroll
                for (int i2 = 0; i2 < 4; ++i2) { const unsigned lo = (o[2 * i2][e >> 1] >> ((e & 1) * 16)) & 0xffffu, hi = (o[2 * i2 + 1][e >> 1] >> ((e & 1) * 16)) & 0xffffu; q[i2] = lo | (hi << 16); }
                *(u32x4*)(BMT + ((size_t)(b * 2 + g) * 128 + n0 + e) * SEQ + t0) = q; }
        } else { const int cc = c0 - 1280;
#pragma unroll
            for (int i = 0; i < 8; ++i) *(u32x4*)(CM + (size_t)(r0 + i) * 256 + cc) = (u32x4){o[i][0], o[i][1], o[i][2], o[i][3]};
        }
    }
}

DI void cmp_finish_phase(int wv, const Params& P) {
    unsigned char* const ws_ = ws_fresh(P.ws);
    const int tid_ = tid_fresh(wv);
    const int lane = tid_ & 63, gw = blockIdx.x * NWAVES + (tid_ >> 6), NGW = gridDim.x * NWAVES;
    bf16_t* KCC = (bf16_t*)(ws_ + WS_KCC); bf16_t* VCCT = (bf16_t*)(ws_ + WS_VCCT); const float* peb = (const float*)(ws_ + WS_PEB);
    for (int r = gw; r < 4096; r += NGW) {
        const int kv = r >> 11, bh = (r >> 9) & 3, n = r & 511;
        const float* PP = (const float*)(ws_ + (kv ? WS_PV : WS_PK)); const float* w2 = P.in[kv ? 14 : 11];
        float out = 0.f;
        if (n < 511) {
            const float pre = PP[(size_t)(bh * 512 + n) * 256 + lane] + PP[(size_t)(bh * 512 + n + 1) * 256 + 64 + lane] + peb[kv * 64 + lane];
            const float hid = siluf_(pre);
#pragma unroll 8
            for (int i = 0; i < 64; ++i) out += __shfl(hid, i) * w2[i * 64 + lane];
        }
        const bf16_t ob = (bf16_t)(pk2(out, 0.f) & 0xffff);
        if (kv == 0) KCC[(size_t)(bh * 512 + n) * 64 + lane] = ob; else VCCT[(size_t)(bh * 64 + lane) * 512 + n] = ob;
    }
}

DI void ssd_acs(const float* DT, int row0, int h, float a, LAS float* acs, int lane) {
    float v0 = DT[(size_t)(row0 + lane) * 16 + h] * a, v1 = DT[(size_t)(row0 + 64 + lane) * 16 + h] * a;
#pragma unroll
    for (int o = 1; o < 64; o <<= 1) { const float t0 = __shfl_up(v0, o), t1 = __shfl_up(v1, o); if (lane >= o) { v0 += t0; v1 += t1; } }
    const float tot0 = __shfl(v0, 63);
    acs[lane] = v0; acs[64 + lane] = v1 + tot0;
    asm volatile("s_waitcnt lgkmcnt(0)" ::: "memory");
}
constexpr int XT_LD = 136;
DI void ssd_states_phase(int wv, const Params& P, LAS unsigned char* lds) {
    unsigned char* const ws_ = ws_fresh(P.ws);
    const int tid_ = tid_fresh(wv);
    const int lane = tid_ & 63, wave = tid_ >> 6, q = lane & 31, hh = lane >> 5;
    const float* DT = (const float*)(ws_ + WS_DT); const bf16_t* XS = (const bf16_t*)(ws_ + WS_XS); const bf16_t* BMT = (const bf16_t*)(ws_ + WS_BMT);
    bf16_t* ST = (bf16_t*)(ws_ + WS_ST); float* CDEC = (float*)(ws_ + WS_CDEC);
    LAS bf16_t* xt = (LAS bf16_t*)(lds + wave * (64 * XT_LD * 2));
    LAS float* acs = (LAS float*)(lds + 8 * 64 * XT_LD * 2 + wave * 512);
    for (int u = blockIdx.x; u < 256; u += gridDim.x) {
        const int b = u >> 7, c = (u >> 1) & 63, g = u & 1, h = g * 8 + wave, row0 = b * SEQ + c * 128;
        const float a = -expf(P.in[18][h]);
        ssd_acs(DT, row0, h, a, acs, lane);
        const float alast = acs[127];
        if (lane == 0) CDEC[(b * 64 + c) * 16 + h] = expf(alast);
        for (int it = lane; it < 1024; it += 64) { const int l = it >> 3, pg = (it & 7) * 8; const float sc = DT[(size_t)(row0 + l) * 16 + h] * expf(alast - acs[l]);
            const u32x4 v = *(const u32x4*)(XS + (size_t)(row0 + l) * 1024 + h * 64 + pg);
#pragma unroll
            for (int e = 0; e < 4; ++e) { const unsigned w = pk2(bflo(v[e]) * sc, bfhi(v[e]) * sc); xt[(pg + 2 * e) * XT_LD + l] = (bf16_t)(w & 0xffff); xt[(pg + 2 * e + 1) * XT_LD + l] = (bf16_t)(w >> 16); } }
        asm volatile("s_waitcnt lgkmcnt(0)" ::: "memory");
        f32x16 acc[4][2];
#pragma unroll
        for (int i = 0; i < 4; ++i) { acc[i][0] = f32x16{}; acc[i][1] = f32x16{}; }
        const bf16_t* bt = BMT + ((size_t)(b * 2 + g) * 128 + q) * SEQ + c * 128 + 8 * hh;
#pragma unroll 2
        for (int ks = 0; ks < 8; ++ks) {
            bf16x8 bf[2];
#pragma unroll
            for (int pt = 0; pt < 2; ++pt) bf[pt] = *(const LAS bf16x8*)(xt + (pt * 32 + q) * XT_LD + ks * 16 + 8 * hh);
#pragma unroll
            for (int nt = 0; nt < 4; ++nt) { const bf16x8 af = *(const bf16x8*)(bt + (size_t)nt * 32 * SEQ + ks * 16);
                acc[nt][0] = MFMA32(af, bf[0], acc[nt][0]); acc[nt][1] = MFMA32(af, bf[1], acc[nt][1]); }
        }
        bf16_t* st = ST + ((size_t)((b * 64 + c) * 16 + h) * 64) * 128;
#pragma unroll
        for (int nt = 0; nt < 4; ++nt)
#pragma unroll
            for (int pt = 0; pt < 2; ++pt)
#pragma unroll
                for (int i4 = 0; i4 < 4; ++i4) { u32x2 w; w.x = pk2(acc[nt][pt][4 * i4], acc[nt][pt][4 * i4 + 1]); w.y = pk2(acc[nt][pt][4 * i4 + 2], acc[nt][pt][4 * i4 + 3]);
                    *(u32x2*)(st + (size_t)(pt * 32 + q) * 128 + nt * 32 + 8 * i4 + 4 * hh) = w; }
        asm volatile("s_waitcnt lgkmcnt(0)" ::: "memory");
    }
}
DI void ssd_scan_phase(int wv, const Params& P) {
    unsigned char* const ws_ = ws_fresh(P.ws);
    const int tid_ = tid_fresh(wv);
    bf16_t* ST = (bf16_t*)(ws_ + WS_ST); const float* CDEC = (const float*)(ws_ + WS_CDEC);
    const int gt = blockIdx.x * NTHREADS + tid_, NGT = gridDim.x * NTHREADS;
    for (int e = gt; e < 2 * 16 * 64 * 64; e += NGT) {
        const int b = e >> 16, h = (e >> 12) & 15, pn2 = e & 4095; float c0 = 0.f, c1 = 0.f;
#pragma unroll 8
        for (int c = 0; c < 64; ++c) { unsigned* p = (unsigned*)(ST + ((size_t)((b * 64 + c) * 16 + h) * 64) * 128) + pn2; const unsigned s = *p; const float d = CDEC[(b * 64 + c) * 16 + h];
            *p = pk2(c0, c1); c0 = c0 * d + bflo(s); c1 = c1 * d + bfhi(s); }
    }
}
DI void ssd_out_phase(int wv, const Params& P, LAS unsigned char* lds) {
    unsigned char* const ws_ = ws_fresh(P.ws);
    const int tid_ = tid_fresh(wv);
    const int lane = tid_ & 63, wave = tid_ >> 6, q = lane & 31, hh = lane >> 5;
    const float* DT = (const float*)(ws_ + WS_DT); const bf16_t* XS = (const bf16_t*)(ws_ + WS_XS); const bf16_t* BM = (const bf16_t*)(ws_ + WS_BM); const bf16_t* CM = (const bf16_t*)(ws_ + WS_CM);
    const bf16_t* ST = (const bf16_t*)(ws_ + WS_ST); const bf16_t* Z = (const bf16_t*)(ws_ + WS_Z); bf16_t* OCAT = (bf16_t*)(ws_ + WS_OCAT);
    constexpr int XH_LD = 72;
    LAS bf16_t* cbl = (LAS bf16_t*)lds;
    LAS bf16_t* xt = (LAS bf16_t*)(lds + 128 * XT_LD * 2 + wave * (64 * XH_LD * 2));
    LAS float* acs = (LAS float*)(lds + 128 * XT_LD * 2 + 8 * 64 * XH_LD * 2 + wave * 512);
    LAS float* ssq = (LAS float*)(lds + 128 * XT_LD * 2 + 8 * 64 * XH_LD * 2 + 4096);
    for (int u = blockIdx.x; u < 256; u += gridDim.x) {
        const int b = u >> 7, c = (u >> 1) & 63, g = u & 1, h = g * 8 + wave, row0 = b * SEQ + c * 128;
        __syncthreads();
        { const int st_ = wave >> 1;
#pragma unroll
          for (int li = 0; li < 2; ++li) { const int lt = 2 * (wave & 1) + li; f32x16 d = f32x16{};
#pragma unroll
            for (int ks = 0; ks < 8; ++ks) { const bf16x8 af = *(const bf16x8*)(BM + (size_t)(row0 + st_ * 32 + q) * 256 + g * 128 + ks * 16 + 8 * hh);
                const bf16x8 bfr = *(const bf16x8*)(CM + (size_t)(row0 + lt * 32 + q) * 256 + g * 128 + ks * 16 + 8 * hh); d = MFMA32(af, bfr, d); }
#pragma unroll
            for (int i4 = 0; i4 < 4; ++i4) { u32x2 w; w.x = pk2(d[4 * i4], d[4 * i4 + 1]); w.y = pk2(d[4 * i4 + 2], d[4 * i4 + 3]);
                *(LAS u32x2*)(cbl + (lt * 32 + q) * XT_LD + st_ * 32 + 8 * i4 + 4 * hh) = w; } } }
        const float a = -expf(P.in[18][h]);
        ssd_acs(DT, row0, h, a, acs, lane);
        __syncthreads();
        f32x16 acc[2][4];
#pragma unroll
        for (int i = 0; i < 2; ++i)
#pragma unroll
            for (int j = 0; j < 4; ++j) acc[i][j] = f32x16{};
        { const bf16_t* st = ST + ((size_t)((b * 64 + c) * 16 + h) * 64) * 128;
#pragma unroll 2
          for (int ks = 0; ks < 8; ++ks) { bf16x8 af[2];
#pragma unroll
            for (int pt = 0; pt < 2; ++pt) af[pt] = *(const bf16x8*)(st + (size_t)(pt * 32 + q) * 128 + ks * 16 + 8 * hh);
#pragma unroll
            for (int lt = 0; lt < 4; ++lt) { const bf16x8 bfr = *(const bf16x8*)(CM + (size_t)(row0 + lt * 32 + q) * 256 + g * 128 + ks * 16 + 8 * hh);
                acc[0][lt] = MFMA32(af[0], bfr, acc[0][lt]); acc[1][lt] = MFMA32(af[1], bfr, acc[1][lt]); } } }
        float acl[4];
#pragma unroll
        for (int lt = 0; lt < 4; ++lt) { acl[lt] = acs[lt * 32 + q]; const float e = expf(acl[lt]);
#pragma unroll
            for (int i = 0; i < 16; ++i) { acc[0][lt][i] *= e; acc[1][lt][i] *= e; } }
#pragma unroll 1
        for (int sh = 0; sh < 2; ++sh) {
            for (int it = lane; it < 512; it += 64) { const int s = it >> 3, pg = (it & 7) * 8; const int sg = sh * 64 + s; const float sc = DT[(size_t)(row0 + sg) * 16 + h];
                const u32x4 v = *(const u32x4*)(XS + (size_t)(row0 + sg) * 1024 + h * 64 + pg);
#pragma unroll
                for (int e = 0; e < 4; ++e) { const unsigned w = pk2(bflo(v[e]) * sc, bfhi(v[e]) * sc); xt[(pg + 2 * e) * XH_LD + s] = (bf16_t)(w & 0xffff); xt[(pg + 2 * e + 1) * XH_LD + s] = (bf16_t)(w >> 16); } }
            asm volatile("s_waitcnt lgkmcnt(0)" ::: "memory");
#pragma unroll 1
            for (int ks = 0; ks < 4; ++ks) { const int s0 = sh * 64 + ks * 16 + 8 * hh;
                bf16x8 af[2];
#pragma unroll
                for (int pt = 0; pt < 2; ++pt) af[pt] = *(const LAS bf16x8*)(xt + (pt * 32 + q) * XH_LD + ks * 16 + 8 * hh);
                float as8[8];
#pragma unroll
                for (int j = 0; j < 8; ++j) as8[j] = acs[s0 + j];
#pragma unroll
                for (int lt = 0; lt < 4; ++lt) { if (lt * 32 + 31 < sh * 64 + ks * 16) continue;
                    const int l = lt * 32 + q; const u32x4 cv = *(const LAS u32x4*)(cbl + l * XT_LD + s0); float mv[8];
#pragma unroll
                    for (int j = 0; j < 4; ++j) { mv[2 * j] = bflo(cv[j]); mv[2 * j + 1] = bfhi(cv[j]); }
#pragma unroll
                    for (int j = 0; j < 8; ++j) mv[j] = (s0 + j <= l) ? mv[j] * __expf(acl[lt] - as8[j]) : 0.f;
                    u32x4 pw; pw.x = pk2(mv[0], mv[1]); pw.y = pk2(mv[2], mv[3]); pw.z = pk2(mv[4], mv[5]); pw.w = pk2(mv[6], mv[7]);
                    const bf16x8 bfr = __builtin_bit_cast(bf16x8, pw);
                    acc[0][lt] = MFMA32(af[0], bfr, acc[0][lt]); acc[1][lt] = MFMA32(af[1], bfr, acc[1][lt]); } }
            asm volatile("s_waitcnt lgkmcnt(0)" ::: "memory");
        }
        const float dsk = P.in[19][h];
#pragma unroll
        for (int lt = 0; lt < 4; ++lt) { const size_t rr = (size_t)(row0 + lt * 32 + q); float ss = 0.f;
#pragma unroll
            for (int pt = 0; pt < 2; ++pt)
#pragma unroll
                for (int i4 = 0; i4 < 4; ++i4) { const int p0 = h * 64 + pt * 32 + 8 * i4 + 4 * hh; const u32x2 xv = *(const u32x2*)(XS + rr * 1024 + p0), zv = *(const u32x2*)(Z + rr * 1024 + p0);
                    const float xs4[4] = {bflo(xv.x), bfhi(xv.x), bflo(xv.y), bfhi(xv.y)}, zs4[4] = {bflo(zv.x), bfhi(zv.x), bflo(zv.y), bfhi(zv.y)};
#pragma unroll
                    for (int e = 0; e < 4; ++e) { const float y = (acc[pt][lt][4 * i4 + e] + xs4[e] * dsk) * siluf_(zs4[e]); acc[pt][lt][4 * i4 + e] = y; ss += y * y; } }
            ss += xhalf(ss); if (hh == 0) ssq[wave * 128 + lt * 32 + q] = ss; }
        __syncthreads();
        const float* nw = P.in[20];
#pragma unroll
        for (int lt = 0; lt < 4; ++lt) { float tot = 0.f;
#pragma unroll
            for (int w = 0; w < 8; ++w) tot += ssq[w * 128 + lt * 32 + q];
            const float rs = rsqrtf(tot * (1.f / 512.f) + 1e-5f); const size_t rr = (size_t)(row0 + lt * 32 + q);
#pragma unroll
            for (int pt = 0; pt < 2; ++pt)
#pragma unroll
                for (int i4 = 0; i4 < 4; ++i4) { const int p0 = h * 64 + pt * 32 + 8 * i4 + 4 * hh; const f32x4 nv = *(const f32x4*)(nw + p0);
                    u32x2 w; w.x = pk2(acc[pt][lt][4 * i4] * rs * nv[0], acc[pt][lt][4 * i4 + 1] * rs * nv[1]); w.y = pk2(acc[pt][lt][4 * i4 + 2] * rs * nv[2], acc[pt][lt][4 * i4 + 3] * rs * nv[3]);
                    *(u32x2*)(OCAT + rr * 1536 + 512 + p0) = w; } }
    }
    __syncthreads();
}

struct AttnState { float m, l; f32x16 o[2]; };
DI void qk_tile(f32x16& s, const bf16_t* K, int key0, const bf16x8* qf, int q, int hh) {
    const bf16_t* kp = K + (size_t)(key0 + q) * 64 + 8 * hh; s = f32x16{};
#pragma unroll
    for (int ks = 0; ks < 4; ++ks) { const bf16x8 af = *(const bf16x8*)(kp + 16 * ks); s = MFMA32(af, qf[ks], s); }
}
DI void pv_tile(f32x16* o, const float* p, const bf16_t* VT, int ldv, int key0, int q, int hh) {
#pragma unroll
    for (int s = 0; s < 2; ++s) { u32x4 pw; pw.x = pk2(p[8 * s], p[8 * s + 1]); pw.y = pk2(p[8 * s + 2], p[8 * s + 3]); pw.z = pk2(p[8 * s + 4], p[8 * s + 5]); pw.w = pk2(p[8 * s + 6], p[8 * s + 7]);
        const bf16x8 pf = __builtin_bit_cast(bf16x8, pw);
#pragma unroll
        for (int dt = 0; dt < 2; ++dt) { const bf16_t* vp = VT + (size_t)(dt * 32 + q) * ldv + key0 + 16 * s + 4 * hh; const u32x2 lo = *(const u32x2*)vp, hi = *(const u32x2*)(vp + 8);
            const u32x4 av = (u32x4){lo.x, lo.y, hi.x, hi.y}; o[dt] = MFMA32(__builtin_bit_cast(bf16x8, av), pf, o[dt]); } }
}
DI void attn_step(AttnState& st, const f32x16& s, unsigned vmask, const bf16_t* VT, int ldv, int key0, int q, int hh) {
    float mx = -1e30f;
#pragma unroll
    for (int i = 0; i < 16; ++i) if ((vmask >> i) & 1u) mx = fmaxf(mx, s[i]);
    mx = fmaxf(mx, xhalf(mx));
    const float mn = fmaxf(st.m, mx), al = __expf(st.m - mn); st.m = mn; st.l *= al;
#pragma unroll
    for (int i = 0; i < 16; ++i) { st.o[0][i] *= al; st.o[1][i] *= al; }
    float p[16]; float sum = 0.f;
#pragma unroll
    for (int i = 0; i < 16; ++i) { p[i] = ((vmask >> i) & 1u) ? __expf(s[i] - mn) : 0.f; sum += p[i]; }
    st.l += sum;
    pv_tile(st.o, p, VT, ldv, key0, q, hh);
}
constexpr int KT_LD = 72, VT_LD = 136, STG_KEYS = 128, STG_K_BYTES = STG_KEYS * KT_LD * 2, STAGE_BYTES_A = STG_K_BYTES + 64 * VT_LD * 2;
template <bool MASKED>
DI void attn_step_l(AttnState& st, const LAS bf16_t* Kt, const LAS bf16_t* Vt, const bf16x8* qf, unsigned vmask, bool mine, int q, int hh) {
    f32x16 s = f32x16{};
#pragma unroll
    for (int ks = 0; ks < 4; ++ks) { const bf16x8 af = *(const LAS bf16x8*)(Kt + q * KT_LD + 16 * ks + 8 * hh); s = MFMA32(af, qf[ks], s); }
    if (MASKED) {
#pragma unroll
        for (int i = 0; i < 16; ++i) s[i] = ((vmask >> i) & 1u) ? s[i] : -1e30f; }
    float mx = fmaxf(fmaxf(s[0], s[1]), fmaxf(s[2], s[3]));
#pragma unroll
    for (int i = 4; i < 16; i += 4) mx = fmaxf(mx, fmaxf(fmaxf(s[i], s[i + 1]), fmaxf(s[i + 2], s[i + 3])));
    if (!MASKED) mx = mine ? mx : -1e30f;
    mx = xmax32(mx);
    if (__builtin_amdgcn_ballot_w64(mx > st.m) != 0ull) { const float mn = fmaxf(st.m, mx), al = EXP2(st.m - mn); st.m = mn; st.l *= al;
#pragma unroll
        for (int i = 0; i < 16; ++i) { st.o[0][i] *= al; st.o[1][i] *= al; } }
    const float c = (MASKED || mine) ? fmaxf(st.m, -1e29f) : 1e30f;
    float p[16]; float sum = 0.f;
#pragma unroll
    for (int i = 0; i < 16; ++i) { p[i] = EXP2(s[i] - c); sum += p[i]; }
    st.l += sum;
#pragma unroll
    for (int s2 = 0; s2 < 2; ++s2) { u32x4 pw; pw.x = pk2(p[8 * s2], p[8 * s2 + 1]); pw.y = pk2(p[8 * s2 + 2], p[8 * s2 + 3]); pw.z = pk2(p[8 * s2 + 4], p[8 * s2 + 5]); pw.w = pk2(p[8 * s2 + 6], p[8 * s2 + 7]);
        const bf16x8 pf = __builtin_bit_cast(bf16x8, pw);
#pragma unroll
        for (int dt = 0; dt < 2; ++dt) { const LAS bf16_t* vp = Vt + (dt * 32 + q) * VT_LD + 16 * s2 + 4 * hh; const u32x2 lo = *(const LAS u32x2*)vp, hi = *(const LAS u32x2*)(vp + 8);
            const u32x4 av = (u32x4){lo.x, lo.y, hi.x, hi.y}; st.o[dt] = MFMA32(__builtin_bit_cast(bf16x8, av), pf, st.o[dt]); } }
}
DI void nsa_phase(int wv, const Params& P, LAS unsigned char* lds) {
    const int tid_ = tid_fresh(wv);
    unsigned char* const ws_ = ws_fresh(P.ws);
    const int lane = tid_ & 63, wave = tid_ >> 6, q = lane & 31, hh = lane >> 5, tok = q >> 2, g = q & 3;
    const bf16_t* Q = (const bf16_t*)(ws_ + WS_Q); const bf16_t* KCC = (const bf16_t*)(ws_ + WS_KCC); const bf16_t* VCCT = (const bf16_t*)(ws_ + WS_VCCT);
    const bf16_t* KS = (const bf16_t*)(ws_ + WS_KS); const bf16_t* VST = (const bf16_t*)(ws_ + WS_VST); const bf16_t* KW = (const bf16_t*)(ws_ + WS_KW); const bf16_t* VWT = (const bf16_t*)(ws_ + WS_VWT);
    const float* GATES = (const float*)(ws_ + WS_GATES); bf16_t* OCAT = (bf16_t*)(ws_ + WS_OCAT);
    LAS float* imp = (LAS float*)(lds + wave * 4096);
    LAS unsigned long long* selm = (LAS unsigned long long*)(lds + 32768 + wave * 128);
    LAS unsigned char* tiles = lds + 36864;
    const int ldr = tid_ & 255, isV = tid_ >> 8;
    const int nunits = 512, NG = gridDim.x;
    for (int uu = blockIdx.x; uu < nunits; uu += NG) {
        const int pass = uu / NG, idx = uu - pass * NG; int gi = uu; if ((nunits % (2 * NG)) == 0 && (pass & 1)) gi = pass * NG + (NG - 1 - idx);
        const int bh = gi >> 7, tg = gi & 127, b = bh >> 1, hkv = bh & 1, t0b = tg * 64, t0 = t0b + 8 * wave, t = t0 + tok, head = hkv * 4 + g;
        const size_t row = (size_t)b * SEQ + t;
        bf16x8 qf[4];
#pragma unroll
        for (int ks = 0; ks < 4; ++ks) qf[ks] = *(const bf16x8*)(Q + row * 512 + head * 64 + 16 * ks + 8 * hh);
        const float g0 = GATES[row * 24 + head * 3 + 0], g1 = GATES[row * 24 + head * 3 + 1], g2 = GATES[row * 24 + head * 3 + 2];
        f32x16 out[2]; out[0] = f32x16{}; out[1] = f32x16{};
        for (int i = lane; i < 1024; i += 64) imp[i] = 0.f;
        const int nvmax = (t0 + 7 >= 31) ? ((t0 + 7 - 31) >> 4) + 1 : 0, nvt = (t >= 31) ? ((t - 31) >> 4) + 1 : 0, ntile = (nvmax + 31) >> 5;
        const bf16_t* Kc = KCC + (size_t)bh * 512 * 64; const bf16_t* VcT = VCCT + (size_t)bh * 64 * 512;
        float m = -1e30f, l = 0.f;
        bf16x8 kf[4], kn[4];
#define CMP_KLOAD(dst_, kt_) _Pragma("unroll") for (int ks = 0; ks < 4; ++ks) dst_[ks] = *(const bf16x8*)(Kc + (size_t)((kt_) * 32 + q) * 64 + 8 * hh + 16 * ks)
#define CMP_QK(s_) do { s_ = f32x16{}; _Pragma("unroll") for (int ks = 0; ks < 4; ++ks) s_ = MFMA32(kf[ks], qf[ks], s_); } while (0)
        if (ntile > 0) { CMP_KLOAD(kf, 0); }
        for (int kt = 0; kt < ntile; ++kt) { if (kt + 1 < ntile) { CMP_KLOAD(kn, kt + 1); }
            f32x16 s; CMP_QK(s); float mx = -1e30f;
#pragma unroll
            for (int i = 0; i < 16; ++i) if (kt * 32 + crow(i, hh) < nvt) mx = fmaxf(mx, s[i]);
            mx = xmax32(mx); const float mn = fmaxf(m, mx); l *= EXP2(m - mn); m = mn;
#pragma unroll
            for (int i = 0; i < 16; ++i) if (kt * 32 + crow(i, hh) < nvt) l += EXP2(s[i] - mn);
#pragma unroll
            for (int ks = 0; ks < 4; ++ks) kf[ks] = kn[ks]; }
        l = xsum32(l);
        const float invl = l > 0.f ? 1.f / l : 0.f;
        { f32x16 o[2]; o[0] = f32x16{}; o[1] = f32x16{}; float carry = 0.f;
          if (ntile > 0) { CMP_KLOAD(kf, 0); }
          for (int kt = 0; kt < ntile; ++kt) { if (kt + 1 < ntile) { CMP_KLOAD(kn, kt + 1); }
            f32x16 s; CMP_QK(s); float p[16];
#pragma unroll
            for (int i = 0; i < 16; ++i) p[i] = (kt * 32 + crow(i, hh) < nvt) ? EXP2(s[i] - m) * invl : 0.f;
            pv_tile(o, p, VcT, 512, kt * 32, q, hh);
            float G4[4], oL[4];
#pragma unroll
            for (int rr = 0; rr < 4; ++rr) { G4[rr] = (p[4 * rr] + p[4 * rr + 1]) + (p[4 * rr + 2] + p[4 * rr + 3]); oL[rr] = xother32(p[4 * rr + 3], hh); }
#pragma unroll
            for (int rr = 0; rr < 4; ++rr) { const float prev = hh ? oL[rr] : (rr ? oL[rr > 0 ? rr - 1 : 0] : carry); const float v = quad_sum(G4[rr] + prev);
                if (g == 0) imp[tok * 128 + kt * 8 + 2 * rr + hh] = v; }
            carry = oL[3];
#pragma unroll
            for (int ks = 0; ks < 4; ++ks) kf[ks] = kn[ks]; }
#undef CMP_KLOAD
#undef CMP_QK
#pragma unroll
          for (int i = 0; i < 16; ++i) { out[0][i] += g0 * o[0][i]; out[1][i] += g0 * o[1][i]; } }
        asm volatile("s_waitcnt lgkmcnt(0)" ::: "memory");
        for (int tk = 0; tk < 8; ++tk) { const int tt = t0 + tk, cur = tt >> 6; unsigned long long mlo, mhi;
            if (cur + 1 <= 16) { mlo = (1ull << (cur + 1)) - 1ull; mhi = 0ull; }
            else { const int j0 = lane, j1 = lane + 64;
                const float s0 = imp[tk * 128 + j0], s1 = imp[tk * 128 + j1];
                const unsigned k0 = (j0 > cur) ? 0u : ((j0 == 0 || j0 == cur || j0 == cur - 1) ? 0x7f000000u : __float_as_uint(s0) + 1u);
                const unsigned k1 = (j1 > cur) ? 0u : ((j1 == cur || j1 == cur - 1) ? 0x7f000000u : __float_as_uint(s1) + 1u);
                unsigned T = 0u;
#pragma unroll 1
                for (int bit = 30; bit >= 0; --bit) { const unsigned cand = T | (1u << bit);
                    const int cnt = __builtin_popcountll(__builtin_amdgcn_ballot_w64(k0 >= cand)) + __builtin_popcountll(__builtin_amdgcn_ballot_w64(k1 >= cand)); if (cnt >= 16) T = cand; }
                mlo = __builtin_amdgcn_ballot_w64(k0 > T); mhi = __builtin_amdgcn_ballot_w64(k1 > T);
                int need = 16 - __builtin_popcountll(mlo) - __builtin_popcountll(mhi);
                unsigned long long elo = __builtin_amdgcn_ballot_w64(k0 == T), ehi = __builtin_amdgcn_ballot_w64(k1 == T);
                while (need > 0 && elo) { const unsigned long long bb = elo & (0ull - elo); mlo |= bb; elo ^= bb; --need; }
                while (need > 0 && ehi) { const unsigned long long bb = ehi & (0ull - ehi); mhi |= bb; ehi ^= bb; --need; } }
            if (lane == 0) { selm[tk * 2] = mlo; selm[tk * 2 + 1] = mhi; } }
        asm volatile("s_waitcnt lgkmcnt(0)" ::: "memory");
        const unsigned long long mylo = selm[tok * 2], myhi = selm[tok * 2 + 1];
#pragma unroll 1
        for (int br = 0; br < 2; ++br) {
            const bf16_t* Kb = (br ? KW : KS) + (size_t)bh * SEQ * 64; const bf16_t* Vb = (br ? VWT : VST) + (size_t)bh * 64 * SEQ;
            const int ktb = br ? (((t0b - 511 > 0) ? (t0b - 511) : 0) >> 5) : 0, kte = ((t0b + 63) >> 5) + 1, nt = kte - ktb;
            const int nst = (nt + 3) >> 2;
            const bf16_t* gsrc = (isV ? (Vb + (size_t)(ldr >> 4) * SEQ + (ldr & 15) * 8) : (Kb + (size_t)(ldr >> 3) * 64 + (ldr & 7) * 8)) + (size_t)ktb * (isV ? 32 : 32 * 64);
            const size_t gj = isV ? (size_t)16 * SEQ : (size_t)32 * 64, gstage = isV ? 128 : 128 * 64;
            const int loff = isV ? (STG_K_BYTES + (ldr >> 4) * VT_LD * 2 + (ldr & 15) * 16) : ((ldr >> 3) * KT_LD * 2 + (ldr & 7) * 16), lj = isV ? 16 * VT_LD * 2 : 32 * KT_LD * 2;
            AttnState st; st.m = -1e30f; st.l = 0.f; st.o[0] = f32x16{}; st.o[1] = f32x16{};
            u32x4 pre[4];
#define NSA_LOAD(si_) _Pragma("unroll") for (int j_ = 0; j_ < 4; ++j_) pre[j_] = *(const u32x4*)(gsrc + (size_t)(si_) * gstage + j_ * gj)
#define NSA_STORE(buf_) _Pragma("unroll") for (int j_ = 0; j_ < 4; ++j_) *(LAS u32x4*)(tiles + (buf_) * STAGE_BYTES_A + loff + j_ * lj) = pre[j_]
            NSA_LOAD(0); NSA_STORE(0);
            if (nst > 1) { NSA_LOAD(1); }
            __syncthreads();
#pragma unroll 1
            for (int si = 0; si < nst; ++si) { const int cur = si & 1;
                if (si + 1 < nst) { NSA_STORE(cur ^ 1); if (si + 2 < nst) { NSA_LOAD(si + 2); } }
#pragma unroll 1
                for (int sub = 0; sub < 4; ++sub) { const int ti = si * 4 + sub; if (ti >= nt) break; const int key0 = (ktb + ti) * 32;
                    const bool rel = br ? (key0 <= t0 + 7 && key0 + 31 + 512 > t0) : (key0 <= t0 + 7);
                    if (rel) {
                        const LAS bf16_t* Kt = (const LAS bf16_t*)(tiles + cur * STAGE_BYTES_A) + sub * 32 * KT_LD; const LAS bf16_t* Vt = (const LAS bf16_t*)(tiles + cur * STAGE_BYTES_A + STG_K_BYTES) + sub * 32;
                        const int jb = key0 >> 6; const bool mine = br ? true : ((jb < 64) ? ((mylo >> jb) & 1ull) : ((myhi >> (jb - 64)) & 1ull));
                        const bool full = br ? (key0 + 31 <= t0 && key0 + 512 > t0 + 7) : (key0 + 31 <= t0);
                        if (__builtin_amdgcn_ballot_w64(mine) == 0ull) {   }
                        else if (full) attn_step_l<false>(st, Kt, Vt, qf, 0u, mine, q, hh);
                        else { unsigned vm = 0u;
                            if (br == 0) {
#pragma unroll
                                for (int e = 0; e < 16; ++e) vm |= (mine && (key0 + crow(e, hh) <= t)) ? (1u << e) : 0u; }
                            else {
#pragma unroll
                                for (int e = 0; e < 16; ++e) { const int key = key0 + crow(e, hh); vm |= (key <= t && key + 512 > t) ? (1u << e) : 0u; } }
                            attn_step_l<true>(st, Kt, Vt, qf, vm, true, q, hh); } } }
                __syncthreads(); }
#undef NSA_LOAD
#undef NSA_STORE
            const float lt = xsum32(st.l), gg = br ? g2 : g1, sc = lt > 0.f ? gg / lt : 0.f;
#pragma unroll
            for (int i = 0; i < 16; ++i) { out[0][i] += sc * st.o[0][i]; out[1][i] += sc * st.o[1][i]; }
        }
#pragma unroll
        for (int dt = 0; dt < 2; ++dt)
#pragma unroll
            for (int i4 = 0; i4 < 4; ++i4) { u32x2 w; w.x = pk2(out[dt][4 * i4], out[dt][4 * i4 + 1]); w.y = pk2(out[dt][4 * i4 + 2], out[dt][4 * i4 + 3]);
                *(u32x2*)(OCAT + row * 1536 + head * 64 + dt * 32 + 8 * i4 + 4 * hh) = w; }
    }
}

constexpr int RW_T = 32;
DI float multi4_sum(float q0, float q1, float q2, float q3, int lane) {
    const bool b0 = lane & 1, b1 = lane & 2;
    const float r01 = (b0 ? q1 : q0) + dpp_f<0xB1>(b0 ? q0 : q1);
    const float r23 = (b0 ? q3 : q2) + dpp_f<0xB1>(b0 ? q2 : q3);
    float r = (b1 ? r23 : r01) + dpp_f<0x4E>(b1 ? r01 : r23);
    r += dpp_f<0x124>(r); r += dpp_f<0x128>(r);
    { auto x = __builtin_amdgcn_permlane16_swap(__float_as_uint(r), __float_as_uint(r), false, false); r = __uint_as_float(x[0]) + __uint_as_float(x[1]); }
    { auto x = __builtin_amdgcn_permlane32_swap(__float_as_uint(r), __float_as_uint(r), false, false); r = __uint_as_float(x[0]) + __uint_as_float(x[1]); }
    return r;
}
DI float rdlane(float v, int l) { return __builtin_bit_cast(float, __builtin_amdgcn_readlane(__builtin_bit_cast(int, v), l)); }
DI float row16_sum(float v) { v += dpp_f<0xB1>(v); v += dpp_f<0x4E>(v); v += dpp_f<0x141>(v); v += dpp_f<0x140>(v); return v; }
DI void rwkv_scan_phase(int wv, const Params& P, LAS unsigned char* lds) {
    const int tid_ = tid_fresh(wv);
    unsigned char* const ws_ = ws_fresh(P.ws);
    const int lane = tid_ & 63, wave = tid_ >> 6;
    const bf16_t* R = (const bf16_t*)(ws_ + WS_R); const bf16_t* K = (const bf16_t*)(ws_ + WS_K); const bf16_t* V = (const bf16_t*)(ws_ + WS_V); const bf16_t* AA = (const bf16_t*)(ws_ + WS_AA);
    const _Float16* LD = (const _Float16*)(ws_ + WS_LD); bf16_t* YS = (bf16_t*)(ws_ + WS_YS); float* RK = (float*)(ws_ + WS_RK);
    LAS float* stg = (LAS float*)lds;
    LAS float* vst = (LAS float*)(lds + 2 * RW_T * 5 * 64 * 4);
    LAS float* ybuf = vst + 2 * RW_T * 8;
    const int nck = SEQ / RW_T;
    const int pw = wave - 2;
    for (int u = blockIdx.x; u < 256; u += gridDim.x) {
        const int ux = (gridDim.x == 256) ? (((u & 7) * 4 + (u >> 6)) * 8 + ((u >> 3) & 7)) : u;
        const int bh = ux >> 3, rg = ux & 7, b = bh >> 4, h = bh & 15;
        __syncthreads();
        if (wave >= 2) {
            const int ch = h * 64 + lane;
            const float kkw = P.in[35][ch], kaw = P.in[36][ch], rkw = P.in[37][ch];
            const int hf = lane >> 5, c2 = lane & 31, chp = h * 64 + 2 * c2;
            const f32x2 kkw2 = *(const f32x2*)(P.in[35] + chp), kaw2 = *(const f32x2*)(P.in[36] + chp), rkw2 = *(const f32x2*)(P.in[37] + chp);
            unsigned gk[3], ga[3], gr[3], gl[3]; float gv[3];
#define RW_LOADG(cn_) _Pragma("unroll") for (int i = 0; i < 3; ++i) { const int pp = pw + 6 * i; const size_t row = (size_t)b * SEQ + (cn_) * RW_T + 2 * (pp < 16 ? pp : 0) + hf; \
                gk[i] = *(const unsigned*)(K + row * 1024 + chp); ga[i] = *(const unsigned*)(AA + row * 1024 + chp); gr[i] = *(const unsigned*)(R + row * 1024 + chp); gl[i] = *(const unsigned*)(LD + row * 1024 + chp); \
                gv[i] = bf2f(V[row * 1024 + h * 64 + rg * 8 + (c2 & 7)]); }
            RW_LOADG(0)
#pragma unroll 1
            for (int ck = -1; ck <= nck; ++ck) {
                {
                    if (ck >= 1) { const LAS float* yb = ybuf + ((ck - 1) & 1) * RW_T * 128;
#pragma unroll 2
                        for (int it = pw; it < 64; it += 6) { const float y = row16_sum(yb[it * 64 + lane]);
                            const float y0 = __builtin_bit_cast(float, __builtin_amdgcn_readlane(__builtin_bit_cast(int, y), 0)), y1 = __builtin_bit_cast(float, __builtin_amdgcn_readlane(__builtin_bit_cast(int, y), 16)),
                                        y2 = __builtin_bit_cast(float, __builtin_amdgcn_readlane(__builtin_bit_cast(int, y), 32)), y3 = __builtin_bit_cast(float, __builtin_amdgcn_readlane(__builtin_bit_cast(int, y), 48));
                            if (lane == 0) { u32x2 w; w.x = pk2(y0, y1); w.y = pk2(y2, y3); *(u32x2*)(YS + ((size_t)b * SEQ + (ck - 1) * RW_T + (it >> 1)) * 1024 + h * 64 + rg * 8 + (it & 1) * 4) = w; } } }
                    if (ck + 1 < nck) { const int cn = ck + 1, buf = cn & 1;
#pragma unroll
                        for (int i = 0; i < 3; ++i) { const int pp = pw + 6 * i; if (pp < 16) { const int tt = 2 * pp + hf; const size_t row = (size_t)b * SEQ + cn * RW_T + tt;
                            const f32x2 k = {bflo(gk[i]), bfhi(gk[i])}, a = {bflo(ga[i]), bfhi(ga[i])}, r = {bflo(gr[i]), bfhi(gr[i])};
                            const h16x2 lh = __builtin_bit_cast(h16x2, gl[i]);
                            const f32x2 kr = k * kkw2, kp = k * ((a - 1.f) * kaw2 + 1.f);
                            const float sp = kr[0] * kr[0] + kr[1] * kr[1], rp = r[0] * kp[0] * rkw2[0] + r[1] * kp[1] * rkw2[1];
                            const bool odd = lane & 1;
                            float red = (odd ? rp : sp) + dpp_f<0xB1>(odd ? sp : rp);
                            red += dpp_f<0x4E>(red); red += dpp_f<0x124>(red); red += dpp_f<0x128>(red);
                            { auto x = __builtin_amdgcn_permlane16_swap(__float_as_uint(red), __float_as_uint(red), false, false); red = __uint_as_float(x[0]) + __uint_as_float(x[1]); }
                            const float oth = dpp_f<0xB1>(red); const float ss = odd ? oth : red, rks = odd ? red : oth;
                            const f32x2 kk = kr * __builtin_amdgcn_rsqf(fmaxf(ss, 1e-24f));
                            LAS float* d = stg + ((buf * RW_T + tt) * 5) * 64 + 2 * c2;
                            *(LAS f32x2*)(d) = -kk; *(LAS f32x2*)(d + 64) = (f32x2){__expf((float)lh[0]), __expf((float)lh[1])}; *(LAS f32x2*)(d + 128) = kk * a; *(LAS f32x2*)(d + 192) = kp; *(LAS f32x2*)(d + 256) = r;
                            if (rg == 0 && c2 == 0) RK[row * 16 + h] = rks;
                            if (c2 < 8) vst[(buf * RW_T + tt) * 8 + c2] = gv[i]; } }
                        if (ck + 2 < nck) { RW_LOADG(ck + 2) } }
                }
                if (ck < nck) __syncthreads();
            }
        } else {
            const int cg = lane & 15, rloc = wave * 4 + (lane >> 4);
            f32x4 S = (f32x4){0.f, 0.f, 0.f, 0.f};
            __syncthreads();
            __builtin_amdgcn_s_setprio(3);
#pragma unroll 1
            for (int ck = 0; ck < nck; ++ck) { const int buf = ck & 1;
                const LAS float* sb = stg + buf * RW_T * 5 * 64 + 4 * cg; const LAS float* vb = vst + buf * RW_T * 8 + rloc; LAS float* yb = ybuf + buf * RW_T * 128 + wave * 64 + lane;
                const unsigned sba = (unsigned)(size_t)sb, vba = (unsigned)(size_t)vb;
                f32x4 nkA, ddA, bbA, kpA, rrA, nkB, ddB, bbB, kpB, rrB; float vvA, vvB;
#define RW_LDS_LOAD(X, j_) asm volatile("ds_read_b128 %0, %6 offset:%c8\n\tds_read_b128 %1, %6 offset:%c9\n\tds_read_b128 %2, %6 offset:%c10\n\tds_read_b128 %3, %6 offset:%c11\n\tds_read_b128 %4, %6 offset:%c12\n\tds_read_b32 %5, %7 offset:%c13" \
                    : "=&v"(nk##X), "=&v"(dd##X), "=&v"(bb##X), "=&v"(kp##X), "=&v"(rr##X), "=&v"(vv##X) : "v"(sbt), "v"(vbt), "i"((j_) * 1280), "i"((j_) * 1280 + 256), "i"((j_) * 1280 + 512), "i"((j_) * 1280 + 768), "i"((j_) * 1280 + 1024), "i"((j_) * 32) : "memory")
#define RW_LDS_WAIT(X) asm volatile("s_waitcnt lgkmcnt(0)" : "+v"(nk##X), "+v"(dd##X), "+v"(bb##X), "+v"(kp##X), "+v"(rr##X), "+v"(vv##X) :: "memory")
#define SB_() __builtin_amdgcn_sched_barrier(0)
#define LO2(v_) __builtin_shufflevector(v_, v_, 0, 1)
#define HI2(v_) __builtin_shufflevector(v_, v_, 2, 3)
#define RW_STEP(X, tt_) do { \
                    f32x2 pa_ = LO2(S) * LO2(nk##X); pa_ = HI2(S) * HI2(nk##X) + pa_; float q_ = pa_[0] + pa_[1]; SB_(); \
                    q_ += dpp_f<0xB1>(q_); const f32x2 kvl_ = LO2(kp##X) * vv##X; SB_(); \
                    q_ += dpp_f<0x4E>(q_); const f32x2 kvh_ = HI2(kp##X) * vv##X; SB_(); \
                    q_ += dpp_f<0x141>(q_); const float yp_ = yacc[0] + yacc[1]; SB_(); \
                    q_ += dpp_f<0x140>(q_); if ((tt_) > 0 || tt > 0) ybt[((tt_) - 1) * 128] = yp_; SB_(); \
                    const f32x2 sl_ = LO2(S) * LO2(dd##X) + (LO2(bb##X) * q_ + kvl_), sh_ = HI2(S) * HI2(dd##X) + (HI2(bb##X) * q_ + kvh_); SB_(); \
                    yacc = sl_ * LO2(rr##X); yacc = sh_ * HI2(rr##X) + yacc; S = __builtin_shufflevector(sl_, sh_, 0, 1, 2, 3); SB_(); } while (0)
                f32x2 yacc = (f32x2){0.f, 0.f};
                unsigned sbt = sba, vbt = vba; LAS float* ybt = yb;
                RW_LDS_LOAD(A, 0); RW_LDS_WAIT(A);
#pragma unroll 1
                for (int tt = 0; tt < RW_T; tt += 8) { sbt = sba + (unsigned)tt * 1280u; vbt = vba + (unsigned)tt * 32u; ybt = yb + tt * 128;
                    RW_LDS_LOAD(B, 1); RW_STEP(A, 0); RW_LDS_WAIT(B);
                    RW_LDS_LOAD(A, 2); RW_STEP(B, 1); RW_LDS_WAIT(A);
                    RW_LDS_LOAD(B, 3); RW_STEP(A, 2); RW_LDS_WAIT(B);
                    RW_LDS_LOAD(A, 4); RW_STEP(B, 3); RW_LDS_WAIT(A);
                    RW_LDS_LOAD(B, 5); RW_STEP(A, 4); RW_LDS_WAIT(B);
                    RW_LDS_LOAD(A, 6); RW_STEP(B, 5); RW_LDS_WAIT(A);
                    RW_LDS_LOAD(B, 7); RW_STEP(A, 6); RW_LDS_WAIT(B);
                    RW_LDS_LOAD(A, 8); RW_STEP(B, 7); RW_LDS_WAIT(A);
                }
                yb[(RW_T - 1) * 128] = yacc[0] + yacc[1];
#undef SB_
#undef LO2
#undef HI2
#undef RW_LDS_LOAD
#undef RW_LDS_WAIT
#undef RW_STEP
                __syncthreads();
            }
            __builtin_amdgcn_s_setprio(0);
        }
    }
}
DI void rwkv_post_phase(int wv, const Params& P) {
    const int tid_ = tid_fresh(wv);
    unsigned char* const ws_ = ws_fresh(P.ws);
    const int lane = tid_ & 63, gw = blockIdx.x * NWAVES + (tid_ >> 6), NGW = gridDim.x * NWAVES;
    const bf16_t* YS = (const bf16_t*)(ws_ + WS_YS); const bf16_t* V = (const bf16_t*)(ws_ + WS_V); const bf16_t* G = (const bf16_t*)(ws_ + WS_G); const float* RK = (const float*)(ws_ + WS_RK);
    bf16_t* A2 = (bf16_t*)(ws_ + WS_A2); const float* lng = P.in[38]; const float* lnb = P.in[39];
    for (int r = gw; r < MTOK; r += NGW) {
#pragma unroll
        for (int it = 0; it < 2; ++it) { const int head = it * 8 + (lane >> 3), ch = head * 64 + (lane & 7) * 8; const size_t off = (size_t)r * 1024 + ch;
            const u32x4 yv = *(const u32x4*)(YS + off), vv = *(const u32x4*)(V + off), gv = *(const u32x4*)(G + off);
            float y[8], v8[8], g8[8];
#pragma unroll
            for (int e = 0; e < 4; ++e) { y[2 * e] = bflo(yv[e]); y[2 * e + 1] = bfhi(yv[e]); v8[2 * e] = bflo(vv[e]); v8[2 * e + 1] = bfhi(vv[e]); g8[2 * e] = bflo(gv[e]); g8[2 * e + 1] = bfhi(gv[e]); }
            float s = 0.f;
#pragma unroll
            for (int e = 0; e < 8; ++e) s += y[e];
            s += dpp_f<0xB1>(s); s += dpp_f<0x4E>(s); s += dpp_f<0x141>(s);
            const float mean = s * (1.f / 64.f); float q = 0.f;
#pragma unroll
            for (int e = 0; e < 8; ++e) { y[e] -= mean; q += y[e] * y[e]; }
            q += dpp_f<0xB1>(q); q += dpp_f<0x4E>(q); q += dpp_f<0x141>(q);
            const float rstd = rsqrtf(q * (1.f / 64.f) + 64e-5f), rk = RK[(size_t)r * 16 + head];
            const f32x4 l0 = *(const f32x4*)(lng + ch), l1 = *(const f32x4*)(lng + ch + 4), b0 = *(const f32x4*)(lnb + ch), b1 = *(const f32x4*)(lnb + ch + 4);
            float o[8];
#pragma unroll
            for (int e = 0; e < 8; ++e) { const float lg = e < 4 ? l0[e & 3] : l1[e & 3], lb = e < 4 ? b0[e & 3] : b1[e & 3]; o[e] = (y[e] * rstd * lg + lb + rk * v8[e]) * g8[e]; }
            u32x4 w; w.x = pk2(o[0], o[1]); w.y = pk2(o[2], o[3]); w.z = pk2(o[4], o[5]); w.w = pk2(o[6], o[7]);
            *(u32x4*)(A2 + off) = w; }
    }
}


#define XB_TMO      128
#define XB_XCNT(j)  (256  + 64 * (j))
#define XB_XSUB(j)  (1280 + 64 * (j))
#define XB_XGEN(j)  (2304 + 64 * (j))
#define XB_TOP      3328
#define XB_TOPGEN   3392
#define XCD_BAR_WORDS 3456
#define XB_SPIN_CAP (1u << 22)
DI unsigned xb_ld(unsigned* p)              { return __hip_atomic_load(p, __ATOMIC_RELAXED, __HIP_MEMORY_SCOPE_AGENT); }
DI unsigned xb_add(unsigned* p, unsigned v) { return __hip_atomic_fetch_add(p, v, __ATOMIC_RELAXED, __HIP_MEMORY_SCOPE_AGENT); }
DI unsigned xb_xcc_id() { return (unsigned)__builtin_amdgcn_s_getreg((3 << 11) | 20) & 0xFu; }
#define XB_SPIN(cond, bar) do { unsigned _sp = 0; while (cond) { __builtin_amdgcn_s_sleep(1); \
    if ((++_sp & 255u) == 0u) { if (xb_ld(&(bar)[XB_TMO])) break; if (_sp > XB_SPIN_CAP) { atomicAdd(&(bar)[XB_TMO], 1u); break; } } } } while (0)
DI void xcd_barrier_complete(unsigned* bar, unsigned x, unsigned& nloc, unsigned& nx) {
    const unsigned G = gridDim.x * gridDim.y * gridDim.z;
    unsigned sum, cnt, mine, sp = 0u;
    for (;;) {
        sum = 0u; cnt = 0u; mine = 0u;
#pragma unroll
        for (unsigned j = 0; j < 16; ++j) { const unsigned c = xb_ld(&bar[XB_XCNT(j)]); sum += c; cnt += (c > 0u) ? 1u : 0u; mine = (j == x) ? c : mine; }
        if (sum == G) break;
        __builtin_amdgcn_s_sleep(1);
        if ((++sp & 255u) == 0u) { if (xb_ld(&bar[XB_TMO])) break; if (sp > XB_SPIN_CAP) { atomicAdd(&bar[XB_TMO], 1u); break; } }
    }
    nloc = mine > 0u ? mine : 1u; nx = cnt > 0u ? cnt : 1u;
}
DI void xcd_barrier(unsigned* bar, volatile LAS unsigned* st, bool leader) {
    asm volatile("s_waitcnt vmcnt(0)" ::: "memory");
    __syncthreads();
    if (leader) {
        const unsigned x = xb_xcc_id();
        __builtin_amdgcn_s_waitcnt(0);
        unsigned nloc = st[0], nx = st[1];
        if (nloc == 0u) { xcd_barrier_complete(bar, x, nloc, nx); st[0] = nloc; st[1] = nx; }
        const unsigned old = xb_add(&bar[XB_XSUB(x)], 1u);
        const unsigned gen = old / nloc;
        if (old + 1u == (gen + 1u) * nloc) {
            __builtin_amdgcn_fence(__ATOMIC_RELEASE, "agent");
            asm volatile("s_waitcnt vmcnt(0)" ::: "memory");
            const unsigned og = xb_add(&bar[XB_TOP], 1u);
            const unsigned tg = og / nx;
            if (og + 1u == (tg + 1u) * nx) xb_add(&bar[XB_TOPGEN], 1u);
            else XB_SPIN(xb_ld(&bar[XB_TOPGEN]) == tg, bar);
            __builtin_amdgcn_fence(__ATOMIC_ACQUIRE, "agent");
            xb_add(&bar[XB_XGEN(x)], 1u);
            asm volatile("s_waitcnt vmcnt(0)" ::: "memory");
        } else {
            XB_SPIN(xb_ld(&bar[XB_XGEN(x)]) == gen, bar);
            __builtin_amdgcn_fence(__ATOMIC_ACQUIRE, "agent");
            asm volatile("s_waitcnt vmcnt(0)" ::: "memory");
        }
    }
    __syncthreads();
}

#ifndef REP_GEMM
#define REP_GEMM 1
#endif
#ifndef REP_NSA
#define REP_NSA 1
#endif
#ifndef REP_SCAN
#define REP_SCAN 1
#endif
#ifndef REP_SSD
#define REP_SSD 1
#endif
#define GEMM_RUN(EpiT, epi, Aptr, Bptr, M_, N_, K_, lda_, padA_, cshift) for (int rep_ = 0; rep_ < REP_GEMM; ++rep_) do { pg8::Gemm g_{(const bf16_t*)(Aptr), (const bf16_t*)(Bptr), (M_), (N_), (K_), (lda_), (padA_)}; pg8::StaticOrder S_; \
    S_.init((M_), (N_), (int)gridDim.x, (int)((blockIdx.x + gridDim.x - (cshift)) % gridDim.x)); pg8::gemm_phase<EpiT>(wv, lds, g_, S_, (epi)); } while (0)

DI unsigned* bar_ptr(const Params& P) { return (unsigned*)(P.ws + WS_BAR); }
#define ws ws_fresh(P.ws)
#define A ((bf16_t*)(ws + WS_A))
#define H ((bf16_t*)(ws + WS_H))
#define Y ((bf16_t*)(ws + WS_Y))
#define GSYNC() do { unsigned* const barp_ = bar_ptr(P); const bool lead_ = (tid_fresh(wv) == 0); xcd_barrier(barp_, (volatile LAS unsigned*)(lds + LDS_BYTES - 64), lead_); } while (0)
template <int layer> DI void layer_body(const Params& P, cg::grid_group& grid, const int wv, LAS unsigned char* lds) {
    float* X = P.out; const float* ng = P.in[1];
        const float* gl = ng + layer * 6 * DM;
        { EpiSwiglu e{H}; GEMM_RUN(EpiSwiglu, e, A, ws + WS_WGU, MTOK, 2 * DFF, DM, DM, 0, 0); }
        GSYNC();
        { EpiBf16 e{Y, DM}; GEMM_RUN(EpiBf16, e, H, ws + WS_WD, MTOK, DM, DFF, DFF, 0, 0); }
        GSYNC();
        row_phase(wv, 1, layer == 0 ? P.in[0] : X, Y, gl + 1 * DM, 0.5f, gl + 2 * DM, X, A, layer);
        run_jobs(wv, P.ffn2[layer], 3, nullptr, 0, lds);
        GSYNC();
        if (layer == 0) {
            { EpiWin e{ws, P.in[17]};
              GEMM_RUN(EpiWin, e, A, ws + WS_WIN, MTOK, 4096, DM, DM, 0, 0); }
            GSYNC();
            { EpiF32 e{(float*)(ws + WS_PK), 256}; GEMM_RUN(EpiF32, e, ws + WS_KCN, ws + WS_W1K, 2048, 256, 1024, 1024, 0, 0); }
            { EpiF32 e{(float*)(ws + WS_PV), 256}; GEMM_RUN(EpiF32, e, ws + WS_VCN, ws + WS_W1V, 2048, 256, 1024, 1024, 0, 8); }
            for (int r_ = 0; r_ < REP_SSD; ++r_) conv_phase(wv, P);
            GSYNC();
            cmp_finish_phase(wv, P); for (int r_ = 0; r_ < REP_SSD; ++r_) ssd_states_phase(wv, P, lds);
            GSYNC();
            ssd_scan_phase(wv, P); for (int r_ = 0; r_ < REP_NSA; ++r_) nsa_phase(wv, P, lds);
            GSYNC();
            for (int r_ = 0; r_ < REP_SSD; ++r_) ssd_out_phase(wv, P, lds);
            GSYNC();
            { EpiBf16 e{(bf16_t*)(ws + WS_YMIX0), DM}; GEMM_RUN(EpiBf16, e, ws + WS_OCAT, ws + WS_WOUT, MTOK, DM, 1536, 1536, 0, 0); }
            GSYNC();
            row_phase(wv, 1, X, (const bf16_t*)(ws + WS_YMIX0), gl + 3 * DM, 1.f, gl + 4 * DM, X, A, 0);
            GSYNC();
        } else {
            { EpiRwkv1 e{ws}; GEMM_RUN(EpiRwkv1, e, A, ws + WS_WG1, MTOK, 3584, 2048, DM, DM * 2, 0); }
            GSYNC();
            { EpiRwkv2 e{(_Float16*)(ws + WS_LD), (bf16_t*)(ws + WS_AA), P.in[27], P.in[30]}; GEMM_RUN(EpiRwkv2, e, ws + WS_LH, ws + WS_W2A, MTOK, 2048, 128, 512, 0, 0); }
            GSYNC();
            for (int r_ = 0; r_ < REP_SCAN; ++r_) rwkv_scan_phase(wv, P, lds);
            GSYNC();
            { EpiBf16 e{(bf16_t*)(ws + WS_G), DM}; GEMM_RUN(EpiBf16, e, (bf16_t*)(ws + WS_LH) + 128, ws + WS_W2B, MTOK, DM, 256, 512, 0, 0); }
            GSYNC();
            rwkv_post_phase(wv, P);
            GSYNC();
            { EpiBf16 e{(bf16_t*)(ws + WS_YMIX1), DM}; GEMM_RUN(EpiBf16, e, ws + WS_A2, ws + WS_WO, MTOK, DM, DM, DM, 0, 0); }
            GSYNC();
            row_phase(wv, 1, X, (const bf16_t*)(ws + WS_YMIX1), gl + 3 * DM, 1.f, gl + 4 * DM, X, A, 0);
            GSYNC();
        }
        { EpiSwiglu e{H}; GEMM_RUN(EpiSwiglu, e, A, ws + WS_WGU, MTOK, 2 * DFF, DM, DM, 0, 0); }
        GSYNC();
        { EpiBf16 e{Y, DM}; GEMM_RUN(EpiBf16, e, H, ws + WS_WD, MTOK, DM, DFF, DFF, 0, 0); }
        GSYNC();
        if (layer == 0) { row_phase(wv, 1, X, Y, gl + 5 * DM, 0.5f, ng + 6 * DM, X, A, 0); run_jobs(wv, P.js[1].cj, P.js[1].ncj, P.js[1].zj, P.js[1].nzj, lds); GSYNC(); }
        else row_phase(wv, 1, X, Y, gl + 5 * DM, 0.5f, nullptr, X, nullptr, 0);
}

__global__ void __launch_bounds__(NTHREADS, 2) mega_fwd(Params P) {
    extern __shared__ __attribute__((aligned(16))) unsigned char lds_raw[];
    LAS unsigned char* lds = (LAS unsigned char*)lds_raw;
    cg::grid_group grid = cg::this_grid();
    const int wv = __builtin_amdgcn_readfirstlane(threadIdx.x >> 6);
    { unsigned* const barp = bar_ptr(P); const unsigned xid = xb_xcc_id();
      if (threadIdx.x == 0) { ((volatile LAS unsigned*)(lds + LDS_BYTES - 64))[0] = 0u; ((volatile LAS unsigned*)(lds + LDS_BYTES - 64))[1] = 0u; (void)xb_add(barp + XB_XCNT(xid), 1u); } }
    __syncthreads();
    float* X = P.out;
    const float* ng = P.in[1];
    grid.sync();
    run_jobs(wv, P.js[0].cj, P.js[0].ncj, P.js[0].zj, P.js[0].nzj, lds); p0_misc(wv, P, lds);
    row_phase(wv, 0, P.in[0], nullptr, nullptr, 0.f, ng + 0 * DM, nullptr, A, 0);
    GSYNC();
    layer_body<0>(P, grid, wv, lds);
    layer_body<1>(P, grid, wv, lds);
}
#undef ws
#undef A
#undef H
#undef Y
static void add_cvt(JobSet& js, const float* src, int ldw, int K, int N, bf16_t* dst, int ldk, int koff, int mode, int rowoff, const float* scale = nullptr, int smode = 0) {
    CvtJob& j = js.cj[js.ncj++]; j.src = src; j.scale = scale; j.dst = dst; j.ldw = ldw; j.K = K; j.N = N; j.ldk = ldk; j.koff = koff; j.mode = mode; j.rowoff = rowoff; j.smode = smode;
}
static void add_zero(JobSet& js, bf16_t* dst, int rows, int ldk, int c0, int nc) { ZeroJob& z = js.zj[js.nzj++]; z.dst = dst; z.rows = rows; z.ldk = ldk; z.c0 = c0; z.nc = nc; z.pad = 0; }
static void set_cvt(CvtJob& j, const float* src, int ldw, int K, int N, bf16_t* dst, int ldk, int koff, int mode, int rowoff) {
    j.src = src; j.scale = nullptr; j.dst = dst; j.ldw = ldw; j.K = K; j.N = N; j.ldk = ldk; j.koff = koff; j.mode = mode; j.rowoff = rowoff; j.smode = 0;
}
static void set_ffn(CvtJob* j, unsigned char* ws, const float* wg, const float* wu, const float* wd) {
    set_cvt(j[0], wg, DFF, DM, DFF, (bf16_t*)(ws + WS_WGU), DM, 0, 1, 0); set_cvt(j[1], wu, DFF, DM, DFF, (bf16_t*)(ws + WS_WGU), DM, 0, 1, 128); set_cvt(j[2], wd, DM, DFF, DM, (bf16_t*)(ws + WS_WD), DFF, 0, 0, 0);
}
static void add_ffn(JobSet& js, unsigned char* ws, const float* wg, const float* wu, const float* wd) {
    add_cvt(js, wg, DFF, DM, DFF, (bf16_t*)(ws + WS_WGU), DM, 0, 1, 0);
    add_cvt(js, wu, DFF, DM, DFF, (bf16_t*)(ws + WS_WGU), DM, 0, 1, 128);
    add_cvt(js, wd, DM, DFF, DM, (bf16_t*)(ws + WS_WD), DFF, 0, 0, 0);
}

extern "C" void kernel_launch(void* const* d_in, const int* in_sizes, int n_in, void* d_out, int out_size, void* d_ws, size_t ws_size, hipStream_t stream) {
    static int grid = 0;
    if (grid == 0) {
        int dev = 0, cus = 0, per_cu = 0;
        hipGetDevice(&dev); hipDeviceGetAttribute(&cus, hipDeviceAttributeMultiprocessorCount, dev);
        hipFuncSetAttribute((const void*)mega_fwd, hipFuncAttributeMaxDynamicSharedMemorySize, LDS_BYTES);
        hipOccupancyMaxActiveBlocksPerMultiprocessor(&per_cu, (const void*)mega_fwd, NTHREADS, LDS_BYTES);
        if (per_cu < 1) { fprintf(stderr, "occupancy query returned %d\n", per_cu); per_cu = 1; }
        grid = cus * 1;
        if (n_in != 40 || ws_size < 256 * MiB) fprintf(stderr, "unexpected n_in %d / ws %zu\n", n_in, ws_size);
    }
    static Params P;
    memset(&P, 0, sizeof(P));
    for (int i = 0; i < 40; ++i) P.in[i] = (const float*)d_in[i];
    P.out = (float*)d_out; P.ws = (unsigned char*)d_ws;
    unsigned char* ws = P.ws;
    const float* const* in = P.in;
    const size_t FW = (size_t)DM * DFF;
    { JobSet& js = P.js[0]; add_ffn(js, ws, in[2], in[3], in[4]);
      add_cvt(js, in[8], 3880, DM, 3880, (bf16_t*)(ws + WS_WIN), DM, 0, 2, 0);
      add_cvt(js, in[21], DM, 1536, DM, (bf16_t*)(ws + WS_WOUT), 1536, 0, 0, 0);
      add_cvt(js, in[10], 64, 1024, 64, (bf16_t*)(ws + WS_W1K), 1024, 0, 0, 0); add_cvt(js, in[10] + 1024 * 64, 64, 1024, 64, (bf16_t*)(ws + WS_W1K), 1024, 0, 0, 64);
      add_cvt(js, in[13], 64, 1024, 64, (bf16_t*)(ws + WS_W1V), 1024, 0, 0, 0); add_cvt(js, in[13] + 1024 * 64, 64, 1024, 64, (bf16_t*)(ws + WS_W1V), 1024, 0, 0, 64);
      add_zero(js, (bf16_t*)(ws + WS_W1K) + 128 * 1024, 128, 1024, 0, 1024); add_zero(js, (bf16_t*)(ws + WS_W1V) + 128 * 1024, 128, 1024, 0, 1024);
      add_zero(js, (bf16_t*)(ws + WS_WIN) + (size_t)(768 + 64) * DM, 64, DM, 0, DM); add_zero(js, (bf16_t*)(ws + WS_WIN) + (size_t)(768 + 128 + 64) * DM, 64, DM, 0, DM);
      add_zero(js, (bf16_t*)(ws + WS_WIN) + (size_t)(1280 + 128 + 40) * DM, 88, DM, 0, DM); }
    set_ffn(P.ffn2[0], ws, in[5], in[6], in[7]);
    { JobSet& js = P.js[1]; add_ffn(js, ws, in[2] + FW, in[3] + FW, in[4] + FW);
      bf16_t* wg1 = (bf16_t*)(ws + WS_WG1); const float* mu = in[22];
      const float* srcs[6] = {in[23], in[24], in[25], in[28], in[31], in[33]}; const int ncol[6] = {1024, 1024, 1024, 64, 64, 160}; const int roff[6] = {0, 1024, 2048, 3072, 3072 + 64, 3072 + 128}; const int mui[6] = {0, 2, 3, 1, 4, 5};
      for (int i = 0; i < 6; ++i) { add_cvt(js, srcs[i], ncol[i], DM, ncol[i], wg1, 2048, 0, 0, roff[i], mu + mui[i] * DM, 1); add_cvt(js, srcs[i], ncol[i], DM, ncol[i], wg1, 2048, 1024, 0, roff[i], mu + mui[i] * DM, 2); }
      add_zero(js, wg1 + (size_t)(3072 + 288) * 2048, 224, 2048, 0, 2048);
      add_cvt(js, in[26], DM, DM, DM, (bf16_t*)(ws + WS_WO), DM, 0, 0, 0);
      bf16_t* w2a = (bf16_t*)(ws + WS_W2A); add_cvt(js, in[29], DM, 64, DM, w2a, 128, 0, 0, 0); add_cvt(js, in[32], DM, 64, DM, w2a, 128, 64, 0, 1024);
      add_zero(js, w2a, 1024, 128, 64, 64); add_zero(js, w2a + 1024 * 128, 1024, 128, 0, 64);
      bf16_t* w2b = (bf16_t*)(ws + WS_W2B); add_cvt(js, in[34], DM, 160, DM, w2b, 256, 0, 0, 0); add_zero(js, w2b, 1024, 256, 192, 64); }
    set_ffn(P.ffn2[1], ws, in[5] + FW, in[6] + FW, in[7] + FW);
    hipMemsetAsync((char*)d_ws + WS_BAR, 0, 16384, stream);
    void* args[] = {&P};
    hipError_t e = hipLaunchCooperativeKernel((const void*)mega_fwd, dim3(grid), dim3(NTHREADS), args, LDS_BYTES, stream);
    if (e != hipSuccess) fprintf(stderr, "cooperative launch failed: %s (grid %d)\n", hipGetErrorString(e), grid);
}

#ifdef PHASE_TEST
#define TK(name, ...) __global__ void __launch_bounds__(NTHREADS, 2) name(Params P) { extern __shared__ __attribute__((aligned(16))) unsigned char lds_raw[]; LAS unsigned char* lds = (LAS unsigned char*)lds_raw; unsigned char* ws = P.ws; const int wv = __builtin_amdgcn_readfirstlane(threadIdx.x >> 6); __VA_ARGS__ }
TK(t_jobs, run_jobs(wv, P.js[0].cj, P.js[0].ncj, P.js[0].zj, P.js[0].nzj, lds); p0_misc(wv, P, lds);)
TK(t_row, row_phase(wv, 1, P.out, (const bf16_t*)(ws + WS_Y), P.in[1], 0.5f, P.in[1] + DM, P.out, (bf16_t*)(ws + WS_A), 1);)
TK(t_swiglu, { EpiSwiglu e{(bf16_t*)(ws + WS_H)}; GEMM_RUN(EpiSwiglu, e, ws + WS_A, ws + WS_WGU, MTOK, 2 * DFF, DM, DM, 0, 0); })
TK(t_f32, { EpiF32 e{(float*)(ws + WS_Y), DM}; GEMM_RUN(EpiF32, e, ws + WS_H, ws + WS_WD, MTOK, DM, DFF, DFF, 0, 0); })
TK(t_win, { EpiWin e{ws, P.in[17]};
              GEMM_RUN(EpiWin, e, ws + WS_A, ws + WS_WIN, MTOK, 4096, DM, DM, 0, 0); })
TK(t_conv, conv_phase(wv, P);)
TK(t_cmpfin, cmp_finish_phase(wv, P);)
TK(t_sstates, ssd_states_phase(wv, P, lds);)
TK(t_sscan, ssd_scan_phase(wv, P);)
TK(t_sout, ssd_out_phase(wv, P, lds);)
TK(t_nsa, nsa_phase(wv, P, lds);)
TK(t_rw1, { EpiRwkv1 e{ws}; GEMM_RUN(EpiRwkv1, e, ws + WS_A, ws + WS_WG1, MTOK, 3584, 2048, DM, DM * 2, 0); })
TK(t_rw2, { EpiRwkv2 e{(_Float16*)(ws + WS_LD), (bf16_t*)(ws + WS_AA), P.in[27], P.in[30]}; GEMM_RUN(EpiRwkv2, e, ws + WS_LH, ws + WS_W2A, MTOK, 2048, 128, 512, 0, 0); })
TK(t_bf16, { EpiBf16 e{(bf16_t*)(ws + WS_G), DM}; GEMM_RUN(EpiBf16, e, (bf16_t*)(ws + WS_LH) + 128, ws + WS_W2B, MTOK, DM, 256, 512, 0, 0); })
TK(t_scan, rwkv_scan_phase(wv, P, lds);)
TK(t_rpost, rwkv_post_phase(wv, P);)
#endif
```

```cpp
#include <hip/hip_runtime.h>
#include <hip/hip_cooperative_groups.h>
#include <cstdio>
#include <cstdint>
#include <cstring>
namespace cg = cooperative_groups;

#define LAS __attribute__((address_space(3)))
typedef unsigned short bf16_t;
typedef short bf16x8 __attribute__((ext_vector_type(8)));
typedef short s16x4 __attribute__((ext_vector_type(4)));
typedef float f32x4 __attribute__((ext_vector_type(4)));
typedef float f32x2 __attribute__((ext_vector_type(2)));
typedef float f32x16 __attribute__((ext_vector_type(16)));
typedef unsigned u32x4 __attribute__((ext_vector_type(4)));
typedef unsigned u32x2 __attribute__((ext_vector_type(2)));
typedef __bf16 bf16x2_t __attribute__((ext_vector_type(2)));
typedef _Float16 h16x2 __attribute__((ext_vector_type(2)));
#define DI __device__ __forceinline__

constexpr int NB = 2, SEQ = 8192, MTOK = NB * SEQ, DM = 1024, DFF = 2816;
constexpr int NTHREADS = 512, NWAVES = 8;
constexpr int LDS_BYTES = 147456;
constexpr size_t MiB = 1u << 20;
constexpr size_t WS_WGU = 0, WS_WD = 11 * MiB;
constexpr size_t WS_MIX = 17 * MiB;
constexpr size_t WS_WIN = WS_MIX, WS_WOUT = WS_MIX + 8 * MiB, WS_W1K = WS_MIX + 11 * MiB, WS_W1V = WS_W1K + MiB / 2;
constexpr size_t WS_WG1 = WS_MIX, WS_WO = WS_MIX + 14 * MiB, WS_W2A = WS_MIX + 16 * MiB, WS_W2B = WS_W2A + MiB / 2;
constexpr size_t WS_ROPE = 35 * MiB;
constexpr size_t WS_GATES = 37 * MiB;
constexpr size_t WS_DT = WS_GATES + 3 * MiB / 2;
constexpr size_t WS_PK = 40 * MiB, WS_PV = 42 * MiB;
constexpr size_t WS_KCC = 44 * MiB, WS_VCCT = WS_KCC + MiB / 4;
constexpr size_t WS_CDEC = WS_KCC + MiB / 2;
constexpr size_t WS_PEB = WS_CDEC + 64 * 1024;
constexpr size_t WS_RK = 45 * MiB;
constexpr size_t WS_BAR = 46 * MiB;
constexpr size_t WS_A = 47 * MiB;
constexpr size_t WS_BIG = 80 * MiB;
constexpr size_t WS_H = WS_BIG, WS_Y = WS_BIG + 88 * MiB;
constexpr size_t WS_Q = WS_BIG, WS_KCN = WS_BIG + 16 * MiB, WS_VCN = WS_KCN + 4 * MiB, WS_KS = WS_VCN + 4 * MiB, WS_VST = WS_KS + 4 * MiB,
                 WS_KW = WS_VST + 4 * MiB, WS_VWT = WS_KW + 4 * MiB, WS_Z = WS_BIG + 40 * MiB, WS_XBC = WS_BIG + 72 * MiB, WS_OCAT = WS_XBC,
                 WS_BM = WS_BIG + 120 * MiB, WS_BMT = WS_BM + 8 * MiB, WS_CM = WS_BMT + 8 * MiB, WS_ST = WS_BIG + 144 * MiB;
constexpr size_t WS_XS = WS_A;
constexpr size_t WS_YMIX0 = WS_BIG;
constexpr size_t WS_R = WS_BIG, WS_K = WS_BIG + 32 * MiB, WS_V = WS_BIG + 64 * MiB, WS_LH = WS_BIG + 96 * MiB, WS_LD = WS_BIG + 112 * MiB,
                 WS_AA = WS_BIG + 144 * MiB, WS_YS = WS_A, WS_G = WS_LD, WS_A2 = WS_R, WS_YMIX1 = WS_K;
static_assert(WS_ST + 32 * MiB <= 256 * MiB && WS_AA + 32 * MiB <= 256 * MiB && WS_Y + 64 * MiB <= 256 * MiB, "ws map");

DI unsigned pk2(float lo, float hi) { f32x2 v = {lo, hi}; bf16x2_t b = __builtin_convertvector(v, bf16x2_t); return __builtin_bit_cast(unsigned, b); }
DI float bf2f(unsigned short u) { return __uint_as_float(((unsigned)u) << 16); }
DI float bflo(unsigned u) { return __uint_as_float(u << 16); }
DI float bfhi(unsigned u) { return __uint_as_float(u & 0xffff0000u); }
DI float sigmoidf_(float x) { return 1.f / (1.f + __expf(-x)); }
DI float siluf_(float x) { return x / (1.f + __expf(-x)); }
DI float softplusf_(float x) { return fmaxf(x, 0.f) + log1pf(expf(-fabsf(x))); }
DI float softplus_fast(float x) { return fmaxf(x, 0.f) + __logf(1.f + __expf(-fabsf(x))); }
DI float tanh_fast(float x) { const float e = __expf(2.f * x); return 1.f - 2.f / (e + 1.f); }
DI int tid_fresh(int wv) { int l; asm volatile("v_mbcnt_lo_u32_b32 %0, -1, 0\n\tv_mbcnt_hi_u32_b32 %0, -1, %0" : "=v"(l)); return wv * 64 + l; }
DI unsigned char* ws_fresh(unsigned char* w) { asm volatile("" : "+s"(w)); return w; }
DI int crow(int r, int hi) { return (r & 3) + 8 * (r >> 2) + 4 * hi; }
template <int CTRL> DI float dpp_f(float v) { return __builtin_bit_cast(float, __builtin_amdgcn_update_dpp(0, __builtin_bit_cast(int, v), CTRL, 0xf, 0xf, true)); }
DI float wave_sum(float v) {
    v += dpp_f<0xB1>(v); v += dpp_f<0x4E>(v); v += dpp_f<0x141>(v); v += dpp_f<0x140>(v);
    { auto r = __builtin_amdgcn_permlane16_swap(__float_as_uint(v), __float_as_uint(v), false, false); v = __uint_as_float(r[0]) + __uint_as_float(r[1]); }
    { auto r = __builtin_amdgcn_permlane32_swap(__float_as_uint(v), __float_as_uint(v), false, false); v = __uint_as_float(r[0]) + __uint_as_float(r[1]); }
    return v;
}
DI float quad_sum(float v) { v += dpp_f<0xB1>(v); v += dpp_f<0x4E>(v); return v; }
DI float xhalf(float v) { return __shfl_xor(v, 32); }
DI float xmax32(float v) { auto r = __builtin_amdgcn_permlane32_swap(__float_as_uint(v), __float_as_uint(v), false, false); return fmaxf(__uint_as_float(r[0]), __uint_as_float(r[1])); }
DI float xsum32(float v) { auto r = __builtin_amdgcn_permlane32_swap(__float_as_uint(v), __float_as_uint(v), false, false); return __uint_as_float(r[0]) + __uint_as_float(r[1]); }
DI float xother32(float v, int hh) { auto r = __builtin_amdgcn_permlane32_swap(__float_as_uint(v), __float_as_uint(v), false, false); return __uint_as_float(hh ? r[0] : r[1]); }
#define EXP2(x) __builtin_amdgcn_exp2f(x)
#define MFMA32(a, b, c) __builtin_amdgcn_mfma_f32_32x32x16_bf16((a), (b), (c), 0, 0, 0)

namespace pg8 {
constexpr int BM = 256, BK = 64, HALF = 128, HTB = HALF * BK * 2, STAGE_BYTES = 8 * HTB, NXCD = 8, WGM = 8;
DI int lds_byte(int r, int c) { const int st = (r >> 4) * 2 + (c >> 5), rr = r & 15, cc = c & 31, ob = rr * 64 + cc * 2; return st * 1024 + (ob ^ (((ob >> 9) & 1) << 5)); }
DI void stage_rc(int b, int& R, int& C) { const int st = b / 1024, sb = b % 1024, swz = sb ^ (((sb >> 9) & 1) << 5); R = (st >> 1) * 16 + swz / 64; C = (st & 1) * 32 + (swz % 64) / 2; }
DI int perm32(int rho) { const int n = rho >> 4, i = rho & 15; return 8 * (i >> 2) + 4 * n + (i & 3); }
struct Unit { int pm, pn; };
struct Gemm { const bf16_t* A; const bf16_t* Bt; int M, N, K; int lda; int padA; };
struct StaticOrder {
    int nM, nN, nwg, G, c;
    DI void init(int M, int N, int G_, int c_) { nM = M / BM; nN = N / BM; nwg = nM * nN; G = G_; c = c_; }
    DI bool next(int i, Unit& u) const {
        const long L = (long)i * G + c; if (L >= nwg) return false;
        int wgid = (int)L; { const int q = nwg / NXCD, r = nwg % NXCD, xcd = wgid % NXCD, off = wgid / NXCD; wgid = (xcd < r ? xcd * (q + 1) : r * (q + 1) + (xcd - r) * q) + off; }
        const int nig = WGM * nN, gid = wgid / nig, fm = gid * WGM, gsz = (nM - fm) < WGM ? (nM - fm) : WGM;
        u.pm = fm + ((wgid % nig) % gsz); u.pn = (wgid % nig) / gsz; return true;
    }
};
template <class Epi>
DI void gemm_phase(int wv, LAS unsigned char* lds, const Gemm g, const StaticOrder& S, const Epi& E) {
    const int tid = tid_fresh(wv), wid = __builtin_amdgcn_readfirstlane(tid >> 6), lane = tid & 63, wr = wid >> 2, wc = wid & 3, fr = lane & 15, fq = lane >> 4;
    const int K = g.K, nt = K / BK, lda = g.lda;
    unsigned voffA[2], voffB[2];
#pragma unroll
    for (int i = 0; i < 2; ++i) { int R, C; stage_rc(tid * 16 + i * 8192, R, C); const int Rb = (R & ~31) + perm32(R & 31);
        voffA[i] = (unsigned)(R * lda + C) * 2u; voffB[i] = (unsigned)(Rb * K + C) * 2u; }
    const size_t kstep = (size_t)(BK * 2);
    const size_t hA = (size_t)HALF * lda * 2, hB = (size_t)HALF * K * 2, tA = 2 * hA, tB = 2 * hB;
    const unsigned ldsw = (unsigned)wid * 1024u;
    const int aoff = lds_byte(wr * 64 + fr, fq * 8), boff = lds_byte(wc * 32 + fr, fq * 8);
#define PG8_SA(b, h) (((b) * 2 + (h)) * HTB)
#define PG8_SB(b, h) ((4 + (b) * 2 + (h)) * HTB)
#define PG8_STAGE(bufoff, gbase, voff) do { _Pragma("unroll") for (int _i = 0; _i < 2; ++_i) \
        __builtin_amdgcn_global_load_lds((const unsigned*)((const char*)(gbase) + (voff)[_i]), (LAS unsigned*)(lds + (bufoff) + ldsw + _i * 8192), 16, 0, 0); } while (0)
#define PG8_LDA(dst, b, h) do { _Pragma("unroll") for (int m = 0; m < 4; ++m) _Pragma("unroll") for (int k = 0; k < 2; ++k) dst[m][k] = *(const LAS bf16x8*)(lds + PG8_SA(b, h) + aoff + m * 2048 + k * 1024); } while (0)
#define PG8_LDB(dst, b, h) do { _Pragma("unroll") for (int n = 0; n < 2; ++n) _Pragma("unroll") for (int k = 0; k < 2; ++k) dst[n][k] = *(const LAS bf16x8*)(lds + PG8_SB(b, h) + boff + n * 2048 + k * 1024); } while (0)
#define PG8_MMA(ai, bj, At, Bt) do { __builtin_amdgcn_s_setprio(1); _Pragma("unroll") for (int m = 0; m < 4; ++m) _Pragma("unroll") for (int n = 0; n < 2; ++n) _Pragma("unroll") for (int k = 0; k < 2; ++k) \
        acc[ai][bj][m][n] = __builtin_amdgcn_mfma_f32_16x16x32_bf16(Bt[n][k], At[m][k], acc[ai][bj][m][n], 0, 0, 0); __builtin_amdgcn_s_setprio(0); } while (0)
#define PG8_WAIT_V(n) asm volatile("s_waitcnt vmcnt(" #n ")" ::: "memory")
#define PG8_WAIT_L(n) asm volatile("s_waitcnt lgkmcnt(" #n ")" ::: "memory")
#define PG8_BAR __builtin_amdgcn_s_barrier()
#define PG8_SCHED __builtin_amdgcn_sched_barrier(0)
#define PG8_ABASE(u) ((const char*)g.A + (size_t)(u).pm * tA + (size_t)((u).pm >> 5) * (size_t)g.padA)
    Unit cur, nxt; int ui = 0;
    if (!S.next(0, cur)) return;
    f32x4 acc[2][2][4][2];
#pragma unroll
    for (int a = 0; a < 2; ++a)
#pragma unroll
        for (int b = 0; b < 2; ++b)
#pragma unroll
            for (int m = 0; m < 4; ++m)
#pragma unroll
                for (int n = 0; n < 2; ++n) acc[a][b][m][n] = (f32x4){0.f, 0.f, 0.f, 0.f};
    bf16x8 At[4][2], B0[2][2], B1[2][2];
    const char* cA = PG8_ABASE(cur); const char* cB = (const char*)g.Bt + (size_t)cur.pn * tB;
    PG8_STAGE(PG8_SB(0, 0), cB, voffB); PG8_STAGE(PG8_SB(0, 1), cB + hB, voffB); PG8_STAGE(PG8_SA(0, 0), cA, voffA); PG8_STAGE(PG8_SA(0, 1), cA + hA, voffA);
    if (wr == 1) PG8_BAR;
    PG8_WAIT_V(2); PG8_BAR;
    PG8_STAGE(PG8_SB(1, 0), cB + kstep, voffB); PG8_STAGE(PG8_SA(1, 0), cA + kstep, voffA); PG8_STAGE(PG8_SB(1, 1), cB + hB + kstep, voffB);
    PG8_WAIT_V(6); PG8_BAR;
    for (;;) {
        const bool has_next = S.next(ui + 1, nxt);
        const char* nA = has_next ? PG8_ABASE(nxt) : cA; const char* nB = has_next ? (const char*)g.Bt + (size_t)nxt.pn * tB : cB;
#pragma unroll 1
        for (int t = 0; t < nt; t += 2) {
            const bool last = (t == nt - 2);
            const char* a1 = cA + (size_t)(t + 1) * kstep;
            const char* a2 = last ? nA : cA + (size_t)(t + 2) * kstep; const char* b2 = last ? nB : cB + (size_t)(t + 2) * kstep;
            const char* a3 = a2 + kstep; const char* b3 = b2 + kstep;
            PG8_LDB(B0, 0, 0); PG8_LDB(B1, 0, 1); PG8_SCHED; PG8_LDA(At, 0, 0); PG8_STAGE(PG8_SA(1, 1), a1 + hA, voffA);
            PG8_WAIT_V(8); PG8_WAIT_L(0); PG8_BAR; PG8_MMA(0, 0, At, B0); PG8_MMA(0, 1, At, B1); PG8_BAR; PG8_SCHED;
            PG8_LDA(At, 0, 1); PG8_STAGE(PG8_SB(0, 0), b2, voffB); PG8_STAGE(PG8_SB(0, 1), b2 + hB, voffB); PG8_STAGE(PG8_SA(0, 0), a2, voffA);
            PG8_WAIT_V(8); PG8_WAIT_L(0); PG8_BAR; PG8_MMA(1, 0, At, B0); PG8_MMA(1, 1, At, B1); PG8_BAR; PG8_SCHED;
            PG8_LDB(B0, 1, 0); PG8_LDB(B1, 1, 1); PG8_SCHED; PG8_LDA(At, 1, 0); PG8_STAGE(PG8_SA(0, 1), a2 + hA, voffA);
            PG8_WAIT_V(8); PG8_WAIT_L(0); PG8_BAR; PG8_MMA(0, 0, At, B0); PG8_MMA(0, 1, At, B1); PG8_BAR; PG8_SCHED;
            PG8_LDA(At, 1, 1); PG8_STAGE(PG8_SB(1, 0), b3, voffB); PG8_STAGE(PG8_SB(1, 1), b3 + hB, voffB); PG8_STAGE(PG8_SA(1, 0), a3, voffA);
            PG8_WAIT_V(8); PG8_WAIT_L(0); PG8_BAR; PG8_MMA(1, 0, At, B0); PG8_MMA(1, 1, At, B1); PG8_BAR; PG8_SCHED;
        }
        if (wr == 0) PG8_BAR;
        { int fr2 = fr, fq2 = fq; asm volatile("" : "+v"(fr2), "+v"(fq2)); E(acc, cur, wr, wc, fr2, fq2); }
        if (!has_next) break;
#pragma unroll
        for (int a = 0; a < 2; ++a)
#pragma unroll
            for (int b = 0; b < 2; ++b)
#pragma unroll
                for (int m = 0; m < 4; ++m)
#pragma unroll
                    for (int n = 0; n < 2; ++n) acc[a][b][m][n] = (f32x4){0.f, 0.f, 0.f, 0.f};
        cur = nxt; cA = nA; cB = nB; ++ui;
        if (wr == 1) PG8_BAR;
    }
    PG8_WAIT_V(0);
    PG8_BAR;
#undef PG8_SA
#undef PG8_SB
#undef PG8_STAGE
#undef PG8_LDA
#undef PG8_LDB
#undef PG8_MMA
#undef PG8_WAIT_V
#undef PG8_WAIT_L
#undef PG8_BAR
#undef PG8_SCHED
#undef PG8_ABASE
}
}
using pg8::Unit;
typedef f32x4 Acc[2][2][4][2];

#define EPI_ROWS(...) _Pragma("unroll") for (int ai = 0; ai < 2; ++ai) _Pragma("unroll") for (int m = 0; m < 4; ++m) { const int row = u.pm * 256 + ai * 128 + wr * 64 + m * 16 + fr; __VA_ARGS__ }
DI void st16_wt(void* p, u32x4 v) { asm volatile("global_store_dwordx4 %0, %1, off sc0 sc1\n\ts_nop 1" :: "v"(p), "v"(v) : "memory"); }
DI u32x4 pack8(f32x4 a, f32x4 b) { u32x4 w; w.x = pk2(a[0], a[1]); w.y = pk2(a[2], a[3]); w.z = pk2(b[0], b[1]); w.w = pk2(b[2], b[3]); return w; }

struct EpiF32 {
    float* O; int ldc;
    DI void operator()(const Acc& acc, const Unit& u, int wr, int wc, int fr, int fq) const {
        const int c0 = u.pn * 256 + wc * 32 + 8 * fq;
        EPI_ROWS( float* rp = O + (size_t)row * ldc + c0;
            _Pragma("unroll") for (int bj = 0; bj < 2; ++bj) { *(f32x4*)(rp + bj * 128) = acc[ai][bj][m][0]; *(f32x4*)(rp + bj * 128 + 4) = acc[ai][bj][m][1]; } )
    }
};
struct EpiBf16 {
    bf16_t* O; int ldc;
    DI void operator()(const Acc& acc, const Unit& u, int wr, int wc, int fr, int fq) const {
        const int c0 = u.pn * 256 + wc * 32 + 8 * fq;
        EPI_ROWS( bf16_t* rp = O + (size_t)row * ldc + c0;
            _Pragma("unroll") for (int bj = 0; bj < 2; ++bj) st16_wt(rp + bj * 128, pack8(acc[ai][bj][m][0], acc[ai][bj][m][1])); )
    }
};
struct EpiSwiglu {
    bf16_t* H;
    DI void operator()(const Acc& acc, const Unit& u, int wr, int wc, int fr, int fq) const {
        const int c0 = u.pn * 128 + wc * 32 + 8 * fq;
        EPI_ROWS( f32x4 a, b;
            _Pragma("unroll") for (int e = 0; e < 4; ++e) { a[e] = siluf_(acc[ai][0][m][0][e]) * acc[ai][1][m][0][e]; b[e] = siluf_(acc[ai][0][m][1][e]) * acc[ai][1][m][1][e]; }
            st16_wt(H + (size_t)row * DFF + c0, pack8(a, b)); )
    }
};
#define TS_(e) { const unsigned w0_ = pk2(ta0[e], ta1[e]); vt[(size_t)(e) * SEQ] = (bf16_t)(w0_ & 0xffff); vt[(size_t)((e) + 4) * SEQ] = (bf16_t)(w0_ >> 16); }
#define GV_(n, e) { const int c_ = cb + 4 * (n) + (e); const float v_ = (n) ? tb1[e] : tb0[e]; if (c_ < 24) GATES[(size_t)row * 24 + c_] = sigmoidf_(v_); else if (c_ < 40) DT[(size_t)row * 16 + c_ - 24] = softplus_fast(v_ + dt_bias[c_ - 24]); }
struct EpiWin {
    unsigned char* ws; const float* dt_bias;
    DI void operator()(const Acc& acc, const Unit& u, int wr, int wc, int fr, int fq) const {
        const int pn = u.pn;
        bf16_t* const Q = (bf16_t*)(ws + WS_Q); bf16_t* const VCN = (bf16_t*)(ws + WS_VCN); bf16_t* const VST = (bf16_t*)(ws + WS_VST); bf16_t* const VWT = (bf16_t*)(ws + WS_VWT);
        float* const GATES = (float*)(ws + WS_GATES); float* const DT = (float*)(ws + WS_DT); const float* const cosT = (const float*)(ws + WS_ROPE); const float* const sinT = cosT + SEQ * 32;
        if (pn <= 3) {
            if (pn == 3 && wc >= 2) return;
            const int d0 = 8 * fq;
            EPI_ROWS( const int t = row & (SEQ - 1), b = row >> 13;
                const f32x4 c0 = *(const f32x4*)(cosT + t * 32 + d0), c1 = *(const f32x4*)(cosT + t * 32 + d0 + 4);
                const f32x4 s0 = *(const f32x4*)(sinT + t * 32 + d0), s1 = *(const f32x4*)(sinT + t * 32 + d0 + 4);
                const f32x4 x10 = acc[ai][0][m][0], x11 = acc[ai][0][m][1], x20 = acc[ai][1][m][0], x21 = acc[ai][1][m][1];
                f32x4 o10 = x10 * c0 - x20 * s0, o11 = x11 * c1 - x21 * s1, o20 = x20 * c0 + x10 * s0, o21 = x21 * c1 + x11 * s1;
                bf16_t* dst;
                if (pn < 2) { const float qs = 0.125f * 1.4426950408889634f; o10 *= qs; o11 *= qs; o20 *= qs; o21 *= qs; dst = Q + (size_t)row * 512 + (pn * 4 + wc) * 64; }
                else { const size_t boff = (pn == 2) ? (wc < 2 ? WS_KCN : WS_KS) : WS_KW; dst = (bf16_t*)(ws + boff) + ((size_t)(b * 2 + (wc & 1)) * SEQ + t) * 64; }
                *(u32x4*)(dst + d0) = pack8(o10, o11); *(u32x4*)(dst + 32 + d0) = pack8(o20, o21); asm volatile("" ::: "memory"); )
        } else if (pn == 4 || pn == 5) {
            const int h = wc >> 1, d0 = (wc & 1) * 32 + 8 * fq;
            EPI_ROWS( const int t = row & (SEQ - 1), b = row >> 13;
                if (pn == 4) *(u32x4*)(VCN + ((size_t)(b * 2 + h) * SEQ + t) * 64 + d0) = pack8(acc[ai][0][m][0], acc[ai][0][m][1]);
                if (pn == 4) { bf16_t* vt = VST + ((size_t)(b * 2 + h) * 64 + d0) * SEQ + t; const f32x4 ta0 = acc[ai][1][m][0], ta1 = acc[ai][1][m][1]; TS_(0) TS_(1) TS_(2) TS_(3) }
                else { bf16_t* vt = VWT + ((size_t)(b * 2 + h) * 64 + d0) * SEQ + t; const f32x4 ta0 = acc[ai][0][m][0], ta1 = acc[ai][0][m][1]; TS_(0) TS_(1) TS_(2) TS_(3)
                  const int cb = wc * 32 + 8 * fq; const f32x4 tb0 = acc[ai][1][m][0], tb1 = acc[ai][1][m][1];
                  if (cb < 40) { GV_(0, 0) GV_(0, 1) GV_(0, 2) GV_(0, 3) GV_(1, 0) GV_(1, 1) GV_(1, 2) GV_(1, 3) } } )
        } else {
            bf16_t* O = (bf16_t*)(ws + ((pn < 10) ? WS_Z : WS_XBC)); const int ldc = (pn < 10) ? 1024 : 1536; const int c0 = (pn < 10 ? (pn - 6) : (pn - 10)) * 256 + wc * 32 + 8 * fq;
            EPI_ROWS( bf16_t* rp = O + (size_t)row * ldc + c0;
                _Pragma("unroll") for (int bj = 0; bj < 2; ++bj) st16_wt(rp + bj * 128, pack8(acc[ai][bj][m][0], acc[ai][bj][m][1])); )
        }
    }
};
struct EpiRwkv1 {
    unsigned char* ws;
    DI void operator()(const Acc& acc, const Unit& u, int wr, int wc, int fr, int fq) const {
        const int pn = u.pn; bf16_t* const LH = (bf16_t*)(ws + WS_LH);
        if (pn < 12) { bf16_t* O = (bf16_t*)(ws + (pn < 4 ? WS_R : (pn < 8 ? WS_K : WS_V))); const int c0 = (pn & 3) * 256 + wc * 32 + 8 * fq;
            EPI_ROWS( bf16_t* rp = O + (size_t)row * 1024 + c0;
                _Pragma("unroll") for (int bj = 0; bj < 2; ++bj) st16_wt(rp + bj * 128, pack8(acc[ai][bj][m][0], acc[ai][bj][m][1])); )
        } else {
            EPI_ROWS( _Pragma("unroll") for (int bj = 0; bj < 2; ++bj) { const int c0 = (pn - 12) * 256 + bj * 128 + wc * 32 + 8 * fq; f32x4 a = acc[ai][bj][m][0], b = acc[ai][bj][m][1];
                    if (c0 < 64) { _Pragma("unroll") for (int e = 0; e < 4; ++e) { a[e] = tanh_fast(a[e]); b[e] = tanh_fast(b[e]); } }
                    else if (c0 >= 128) { _Pragma("unroll") for (int e = 0; e < 4; ++e) { a[e] = sigmoidf_(a[e]); b[e] = sigmoidf_(b[e]); } }
                    *(u32x4*)(LH + (size_t)row * 512 + c0) = pack8(a, b); } )
        }
    }
};
struct EpiRwkv2 {
    _Float16* LD; bf16_t* AA; const float *w0, *a0;
    DI void operator()(const Acc& acc, const Unit& u, int wr, int wc, int fr, int fq) const {
        const int pn = u.pn;
        EPI_ROWS( _Pragma("unroll") for (int bj = 0; bj < 2; ++bj) { const int c0 = (pn & 3) * 256 + bj * 128 + wc * 32 + 8 * fq;
                if (pn < 4) { u32x4 o;
                    _Pragma("unroll") for (int n = 0; n < 2; ++n) _Pragma("unroll") for (int e2 = 0; e2 < 2; ++e2) {
                        const float wa = -softplus_fast(-(w0[c0 + 4 * n + 2 * e2] + acc[ai][bj][m][n][2 * e2])) - 0.5f, wb = -softplus_fast(-(w0[c0 + 4 * n + 2 * e2 + 1] + acc[ai][bj][m][n][2 * e2 + 1])) - 0.5f;
                        h16x2 hv = {(_Float16)(-__expf(wa)), (_Float16)(-__expf(wb))}; o[2 * n + e2] = __builtin_bit_cast(unsigned, hv); }
                    *(u32x4*)(LD + (size_t)row * 1024 + c0) = o;
                } else { f32x4 a, b;
                    _Pragma("unroll") for (int e = 0; e < 4; ++e) { a[e] = sigmoidf_(a0[c0 + e] + acc[ai][bj][m][0][e]); b[e] = sigmoidf_(a0[c0 + 4 + e] + acc[ai][bj][m][1][e]); }
                    *(u32x4*)(AA + (size_t)row * 1024 + c0) = pack8(a, b); } } )
    }
};

struct CvtJob { const float* src; const float* scale; bf16_t* dst; int ldw, K, N, ldk, koff, mode, rowoff, smode; };
struct ZeroJob { bf16_t* dst; int rows, ldk, c0, nc; int pad; };
constexpr int MAXJ = 20, MAXZ = 8;
struct JobSet { CvtJob cj[MAXJ]; ZeroJob zj[MAXZ]; int ncj, nzj; };
struct Params {
    const float* in[40]; float* out; unsigned char* ws;
    JobSet js[2];
    CvtJob ffn2[2][3];
};

DI int win_rowmap(int c) {
    if (c < 512) { const int hq = c >> 6, d = c & 63; return (hq >> 2) * 256 + (d < 32 ? 0 : 128) + (hq & 3) * 32 + (d & 31); }
    if (c < 1280) { const int seg = (c - 512) >> 7, cc = (c - 512) & 127, h = cc >> 6, d = cc & 63;
        if (seg == 0 || seg == 2 || seg == 4) { const int tile = (seg == 4) ? 3 : 2, hl = (seg == 2 ? 2 : 0) + h; return tile * 256 + (d < 32 ? 0 : 128) + hl * 32 + (d & 31); }
        if (seg == 1) return 1024 + cc; if (seg == 3) return 1024 + 128 + cc; return 1280 + cc; }
    if (c < 1304) return 1280 + 128 + (c - 1280);
    if (c < 2328) return 1536 + (c - 1304);
    if (c < 3864) return 2560 + (c - 2328);
    return 1280 + 128 + 24 + (c - 3864);
}
DI void cvt_item(const CvtJob& J, int item, LAS float* scr, int lane) {
    const int nblk = (J.N + 31) >> 5, kb = item / nblk, nb = item % nblk, k0 = 64 * kb, n0 = 32 * nb;
#pragma unroll 8
    for (int i = 0; i < 32; ++i) { const int kk = 2 * i + (lane >> 5), k = k0 + kk, n = n0 + (lane & 31);
        float v = 0.f; if (k < J.K && n < J.N) { v = J.src[(size_t)k * J.ldw + n]; if (J.smode == 1) v *= J.scale[k]; else if (J.smode == 2) v *= (1.f - J.scale[k]); }
        scr[kk * 33 + (lane & 31)] = v; }
    asm volatile("s_waitcnt lgkmcnt(0)" ::: "memory");
    const int c = lane & 7;
#pragma unroll
    for (int j = 0; j < 4; ++j) { const int nl = (lane >> 3) + 8 * j, n = n0 + nl; const LAS float* s = scr + (8 * c) * 33 + nl;
        if (n < J.N) { u32x4 o; o.x = pk2(s[0], s[33]); o.y = pk2(s[2 * 33], s[3 * 33]); o.z = pk2(s[4 * 33], s[5 * 33]); o.w = pk2(s[6 * 33], s[7 * 33]);
            int row; if (J.mode == 0) row = J.rowoff + n; else if (J.mode == 1) row = (n >> 7) * 256 + (n & 127) + J.rowoff; else row = win_rowmap(n);
            *(u32x4*)(J.dst + (size_t)row * J.ldk + J.koff + k0 + 8 * c) = o; } }
    asm volatile("s_waitcnt lgkmcnt(0)" ::: "memory");
}
DI void run_jobs(int wv, const CvtJob* cjs, int ncj, const ZeroJob* zjs, int nzj, LAS unsigned char* lds) {
    const int tid_ = tid_fresh(wv);
    const int lane = tid_ & 63, wave = tid_ >> 6, gw = blockIdx.x * NWAVES + wave, NGW = gridDim.x * NWAVES;
    LAS float* scr = (LAS float*)(lds + wave * 16384);
    int base = 0;
    for (int j = 0; j < ncj; ++j) { const CvtJob& J = cjs[j]; const int nit = ((J.K + 63) >> 6) * ((J.N + 31) >> 5);
        int first = (gw - base) % NGW; if (first < 0) first += NGW;
        for (int it = first; it < nit; it += NGW) cvt_item(J, it, scr, lane);
        base = (base + nit) % NGW; }
    const int gt = blockIdx.x * NTHREADS + tid_, NGT = gridDim.x * NTHREADS;
    for (int j = 0; j < nzj; ++j) { const ZeroJob& Z = zjs[j]; const int per = Z.nc >> 3, tot = Z.rows * per;
        for (int i = gt; i < tot; i += NGT) { const int r = i / per, c = (i % per) * 8; *(u32x4*)(Z.dst + (size_t)r * Z.ldk + Z.c0 + c) = (u32x4){0u, 0u, 0u, 0u}; } }
}

DI void row_phase(int wv, int mode, const float* X, const bf16_t* Y, const float* ga, float coef, const float* gb, float* Xout, bf16_t* A, int a_pad) {
    const int tid_ = tid_fresh(wv);
    const int lane = tid_ & 63, gw = blockIdx.x * NWAVES + (tid_ >> 6), NGW = gridDim.x * NWAVES;
    for (int r = gw; r < MTOK; r += NGW) {
        f32x4 v[4];
#pragma unroll
        for (int j = 0; j < 4; ++j) v[j] = *(const f32x4*)(X + (size_t)r * DM + 4 * lane + 256 * j);
        if (mode == 1) { f32x4 y[4]; float s = 0.f;
#pragma unroll
            for (int j = 0; j < 4; ++j) { const u32x2 yv = *(const u32x2*)(Y + (size_t)r * DM + 4 * lane + 256 * j); y[j] = (f32x4){bflo(yv.x), bfhi(yv.x), bflo(yv.y), bfhi(yv.y)}; s += y[j][0] * y[j][0] + y[j][1] * y[j][1] + y[j][2] * y[j][2] + y[j][3] * y[j][3]; }
            const float rs = coef * rsqrtf(wave_sum(s) * (1.f / DM) + 1e-6f);
#pragma unroll
            for (int j = 0; j < 4; ++j) { const f32x4 gg = *(const f32x4*)(ga + 4 * lane + 256 * j); v[j] += y[j] * gg * rs; } }
        if (Xout) {
#pragma unroll
            for (int j = 0; j < 4; ++j) st16_wt(Xout + (size_t)r * DM + 4 * lane + 256 * j, __builtin_bit_cast(u32x4, v[j])); }
        if (gb) { float s = 0.f;
#pragma unroll
            for (int j = 0; j < 4; ++j) s += v[j][0] * v[j][0] + v[j][1] * v[j][1] + v[j][2] * v[j][2] + v[j][3] * v[j][3];
            const float rs = rsqrtf(wave_sum(s) * (1.f / DM) + 1e-6f);
            const size_t ar = a_pad ? (size_t)(r + (r >> 13) + 1) : (size_t)r;
#pragma unroll
            for (int j = 0; j < 4; ++j) { const f32x4 gg = *(const f32x4*)(gb + 4 * lane + 256 * j); const f32x4 o = v[j] * gg * rs;
                u32x2 w; w.x = pk2(o[0], o[1]); w.y = pk2(o[2], o[3]); *(u32x2*)(A + ar * DM + 4 * lane + 256 * j) = w; } }
    }
    if (a_pad && gb) { const int gt = blockIdx.x * NTHREADS + tid_; if (gt < 256) { const int b = gt >> 7, c = (gt & 127) * 8; *(u32x4*)(A + (size_t)b * (SEQ + 1) * DM + c) = (u32x4){0u, 0u, 0u, 0u}; } }
}

DI void p0_misc(int wv, const Params& P, LAS unsigned char* lds) {
    unsigned char* const ws_ = ws_fresh(P.ws);
    const int tid_ = tid_fresh(wv);
    float* cosT = (float*)(ws_ + WS_ROPE); float* sinT = cosT + SEQ * 32;
    const int gt = blockIdx.x * NTHREADS + tid_, NGT = gridDim.x * NTHREADS;
    for (int i = gt; i < SEQ * 32; i += NGT) { const int t = i >> 5, k = i & 31; const float inv = powf(10000.f, -(float)(2 * k) / 64.f); const float ang = (float)t * inv; cosT[i] = cosf(ang); sinT[i] = sinf(ang); }
    if (blockIdx.x < 2) {
        const float* pe = P.in[blockIdx.x == 0 ? 9 : 12]; const float* w1 = P.in[blockIdx.x == 0 ? 10 : 13];
        LAS float* red = (LAS float*)lds; const int j = tid_ & 63, part = tid_ >> 6; float s = 0.f;
        for (int k = part; k < 2048; k += 8) s += pe[k] * w1[k * 64 + j];
        red[part * 64 + j] = s; __syncthreads();
        if (tid_ < 64) { float t = 0.f; for (int p = 0; p < 8; ++p) t += red[p * 64 + j]; ((float*)(ws_ + WS_PEB))[blockIdx.x * 64 + j] = t; }
        __syncthreads();
    }
}

DI void conv_phase(int wv, const Params& P) {
    unsigned char* const ws_ = ws_fresh(P.ws);
    const int tid_ = tid_fresh(wv);
    const bf16_t* XBC = (const bf16_t*)(ws_ + WS_XBC); bf16_t* XS = (bf16_t*)(ws_ + WS_XS); bf16_t* BM = (bf16_t*)(ws_ + WS_BM); bf16_t* BMT = (bf16_t*)(ws_ + WS_BMT); bf16_t* CM = (bf16_t*)(ws_ + WS_CM);
    const float* cw = P.in[15]; const float* cb = P.in[16];
    const int gt = blockIdx.x * NTHREADS + tid_, NGT = gridDim.x * NTHREADS;
    for (int it = gt; it < (MTOK / 8) * 192; it += NGT) {
        const int tt = it / 192, cg8 = it % 192, c0 = cg8 * 8, r0 = tt * 8, t0 = r0 & (SEQ - 1), b = r0 >> 13;
        float w[4][8], bias[8];
#pragma unroll
        for (int k = 0; k < 4; ++k) { const f32x4 a = *(const f32x4*)(cw + k * 1536 + c0), bq = *(const f32x4*)(cw + k * 1536 + c0 + 4);
#pragma unroll
            for (int e = 0; e < 4; ++e) { w[k][e] = a[e]; w[k][4 + e] = bq[e]; } }
        { const f32x4 a = *(const f32x4*)(cb + c0), bq = *(const f32x4*)(cb + c0 + 4);
#pragma unroll
          for (int e = 0; e < 4; ++e) { bias[e] = a[e]; bias[4 + e] = bq[e]; } }
        float x[11][8];
#pragma unroll
        for (int i = 0; i < 11; ++i) { u32x4 q = (u32x4){0u, 0u, 0u, 0u}; if (i >= 3 || t0 != 0) q = *(const u32x4*)(XBC + (size_t)(r0 + i - 3) * 1536 + c0);
#pragma unroll
            for (int e = 0; e < 4; ++e) { x[i][2 * e] = bflo(q[e]); x[i][2 * e + 1] = bfhi(q[e]); } }
        unsigned o[8][4];
#pragma unroll
        for (int i = 0; i < 8; ++i) { float y[8];
#pragma unroll
            for (int e = 0; e < 8; ++e) { float s = bias[e];
#pragma unroll
                for (int k = 0; k < 4; ++k) s += w[k][e] * x[i + k][e];
                y[e] = siluf_(s); }
#pragma unroll
            for (int e = 0; e < 4; ++e) o[i][e] = pk2(y[2 * e], y[2 * e + 1]); }
        if (c0 < 1024) {
#pragma unroll
            for (int i = 0; i < 8; ++i) *(u32x4*)(XS + (size_t)(r0 + i) * 1024 + c0) = (u32x4){o[i][0], o[i][1], o[i][2], o[i][3]};
        } else if (c0 < 1280) { const int cc = c0 - 1024, g = cc >> 7, n0 = cc & 127;
#pragma unroll
            for (int i = 0; i < 8; ++i) *(u32x4*)(BM + (size_t)(r0 + i) * 256 + cc) = (u32x4){o[i][0], o[i][1], o[i][2], o[i][3]};
#pragma unroll
            for (int e = 0; e < 8; ++e) { u32x4 q;
#pragma unroll
                for (int i2 = 0; i2 < 4; ++i2) { const unsigned lo = (o[2 * i2][e >> 1] >> ((e & 1) * 16)) & 0xffffu, hi = (o[2 * i2 + 1][e >> 1] >> ((e & 1) * 16)) & 0xffffu; q[i2] = lo | (hi << 16); }
                *(u32x4*)(BMT + ((size_t)(b * 2 + g) * 128 + n0 + e) * SEQ + t0) = q; }
        } else { const int cc = c0 - 1280;
#pragma unroll
            for (int i = 0; i < 8; ++i) *(u32x4*)(CM + (size_t)(r0 + i) * 256 + cc) = (u32x4){o[i][0], o[i][1], o[i][2], o[i][3]};
        }
    }
}

DI void cmp_finish_phase(int wv, const Params& P) {
    unsigned char* const ws_ = ws_fresh(P.ws);
    const int tid_ = tid_fresh(wv);
    const int lane = tid_ & 63, gw = blockIdx.x * NWAVES + (tid_ >> 6), NGW = gridDim.x * NWAVES;
    bf16_t* KCC = (bf16_t*)(ws_ + WS_KCC); bf16_t* VCCT = (bf16_t*)(ws_ + WS_VCCT); const float* peb = (const float*)(ws_ + WS_PEB);
    for (int r = gw; r < 4096; r += NGW) {
        const int kv = r >> 11, bh = (r >> 9) & 3, n = r & 511;
        const float* PP = (const float*)(ws_ + (kv ? WS_PV : WS_PK)); const float* w2 = P.in[kv ? 14 : 11];
        float out = 0.f;
        if (n < 511) {
            const float pre = PP[(size_t)(bh * 512 + n) * 256 + lane] + PP[(size_t)(bh * 512 + n + 1) * 256 + 64 + lane] + peb[kv * 64 + lane];
            const float hid = siluf_(pre);
#pragma unroll 8
            for (int i = 0; i < 64; ++i) out += __shfl(hid, i) * w2[i * 64 + lane];
        }
        const bf16_t ob = (bf16_t)(pk2(out, 0.f) & 0xffff);
        if (kv == 0) KCC[(size_t)(bh * 512 + n) * 64 + lane] = ob; else VCCT[(size_t)(bh * 64 + lane) * 512 + n] = ob;
    }
}

DI void ssd_acs(const float* DT, int row0, int h, float a, LAS float* acs, int lane) {
    float v0 = DT[(size_t)(row0 + lane) * 16 + h] * a, v1 = DT[(size_t)(row0 + 64 + lane) * 16 + h] * a;
#pragma unroll
    for (int o = 1; o < 64; o <<= 1) { const float t0 = __shfl_up(v0, o), t1 = __shfl_up(v1, o); if (lane >= o) { v0 += t0; v1 += t1; } }
    const float tot0 = __shfl(v0, 63);
    acs[lane] = v0; acs[64 + lane] = v1 + tot0;
    asm volatile("s_waitcnt lgkmcnt(0)" ::: "memory");
}
constexpr int XT_LD = 136;
DI void ssd_states_phase(int wv, const Params& P, LAS unsigned char* lds) {
    unsigned char* const ws_ = ws_fresh(P.ws);
    const int tid_ = tid_fresh(wv);
    const int lane = tid_ & 63, wave = tid_ >> 6, q = lane & 31, hh = lane >> 5;
    const float* DT = (const float*)(ws_ + WS_DT); const bf16_t* XS = (const bf16_t*)(ws_ + WS_XS); const bf16_t* BMT = (const bf16_t*)(ws_ + WS_BMT);
    bf16_t* ST = (bf16_t*)(ws_ + WS_ST); float* CDEC = (float*)(ws_ + WS_CDEC);
    LAS bf16_t* xt = (LAS bf16_t*)(lds + wave * (64 * XT_LD * 2));
    LAS float* acs = (LAS float*)(lds + 8 * 64 * XT_LD * 2 + wave * 512);
    for (int u = blockIdx.x; u < 256; u += gridDim.x) {
        const int b = u >> 7, c = (u >> 1) & 63, g = u & 1, h = g * 8 + wave, row0 = b * SEQ + c * 128;
        const float a = -expf(P.in[18][h]);
        ssd_acs(DT, row0, h, a, acs, lane);
        const float alast = acs[127];
        if (lane == 0) CDEC[(b * 64 + c) * 16 + h] = expf(alast);
        for (int it = lane; it < 1024; it += 64) { const int l = it >> 3, pg = (it & 7) * 8; const float sc = DT[(size_t)(row0 + l) * 16 + h] * expf(alast - acs[l]);
            const u32x4 v = *(const u32x4*)(XS + (size_t)(row0 + l) * 1024 + h * 64 + pg);
#pragma unroll
            for (int e = 0; e < 4; ++e) { const unsigned w = pk2(bflo(v[e]) * sc, bfhi(v[e]) * sc); xt[(pg + 2 * e) * XT_LD + l] = (bf16_t)(w & 0xffff); xt[(pg + 2 * e + 1) * XT_LD + l] = (bf16_t)(w >> 16); } }
        asm volatile("s_waitcnt lgkmcnt(0)" ::: "memory");
        f32x16 acc[4][2];
#pragma unroll
        for (int i = 0; i < 4; ++i) { acc[i][0] = f32x16{}; acc[i][1] = f32x16{}; }
        const bf16_t* bt = BMT + ((size_t)(b * 2 + g) * 128 + q) * SEQ + c * 128 + 8 * hh;
#pragma unroll 2
        for (int ks = 0; ks < 8; ++ks) {
            bf16x8 bf[2];
#pragma unroll
            for (int pt = 0; pt < 2; ++pt) bf[pt] = *(const LAS bf16x8*)(xt + (pt * 32 + q) * XT_LD + ks * 16 + 8 * hh);
#pragma unroll
            for (int nt = 0; nt < 4; ++nt) { const bf16x8 af = *(const bf16x8*)(bt + (size_t)nt * 32 * SEQ + ks * 16);
                acc[nt][0] = MFMA32(af, bf[0], acc[nt][0]); acc[nt][1] = MFMA32(af, bf[1], acc[nt][1]); }
        }
        bf16_t* st = ST + ((size_t)((b * 64 + c) * 16 + h) * 64) * 128;
#pragma unroll
        for (int nt = 0; nt < 4; ++nt)
#pragma unroll
            for (int pt = 0; pt < 2; ++pt)
#pragma unroll
                for (int i4 = 0; i4 < 4; ++i4) { u32x2 w; w.x = pk2(acc[nt][pt][4 * i4], acc[nt][pt][4 * i4 + 1]); w.y = pk2(acc[nt][pt][4 * i4 + 2], acc[nt][pt][4 * i4 + 3]);
                    *(u32x2*)(st + (size_t)(pt * 32 + q) * 128 + nt * 32 + 8 * i4 + 4 * hh) = w; }
        asm volatile("s_waitcnt lgkmcnt(0)" ::: "memory");
    }
}
DI void ssd_scan_phase(int wv, const Params& P) {
    unsigned char* const ws_ = ws_fresh(P.ws);
    const int tid_ = tid_fresh(wv);
    bf16_t* ST = (bf16_t*)(ws_ + WS_ST); const float* CDEC = (const float*)(ws_ + WS_CDEC);
    const int gt = blockIdx.x * NTHREADS + tid_, NGT = gridDim.x * NTHREADS;
    for (int e = gt; e < 2 * 16 * 64 * 64; e += NGT) {
        const int b = e >> 16, h = (e >> 12) & 15, pn2 = e & 4095; float c0 = 0.f, c1 = 0.f;
#pragma unroll 8
        for (int c = 0; c < 64; ++c) { unsigned* p = (unsigned*)(ST + ((size_t)((b * 64 + c) * 16 + h) * 64) * 128) + pn2; const unsigned s = *p; const float d = CDEC[(b * 64 + c) * 16 + h];
            *p = pk2(c0, c1); c0 = c0 * d + bflo(s); c1 = c1 * d + bfhi(s); }
    }
}
DI void ssd_out_phase(int wv, const Params& P, LAS unsigned char* lds) {
    unsigned char* const ws_ = ws_fresh(P.ws);
    const int tid_ = tid_fresh(wv);
    const int lane = tid_ & 63, wave = tid_ >> 6, q = lane & 31, hh = lane >> 5;
    const float* DT = (const float*)(ws_ + WS_DT); const bf16_t* XS = (const bf16_t*)(ws_ + WS_XS); const bf16_t* BM = (const bf16_t*)(ws_ + WS_BM); const bf16_t* CM = (const bf16_t*)(ws_ + WS_CM);
    const bf16_t* ST = (const bf16_t*)(ws_ + WS_ST); const bf16_t* Z = (const bf16_t*)(ws_ + WS_Z); bf16_t* OCAT = (bf16_t*)(ws_ + WS_OCAT);
    constexpr int XH_LD = 72;
    LAS bf16_t* cbl = (LAS bf16_t*)lds;
    LAS bf16_t* xt = (LAS bf16_t*)(lds + 128 * XT_LD * 2 + wave * (64 * XH_LD * 2));
    LAS float* acs = (LAS float*)(lds + 128 * XT_LD * 2 + 8 * 64 * XH_LD * 2 + wave * 512);
    LAS float* ssq = (LAS float*)(lds + 128 * XT_LD * 2 + 8 * 64 * XH_LD * 2 + 4096);
    for (int u = blockIdx.x; u < 256; u += gridDim.x) {
        const int b = u >> 7, c = (u >> 1) & 63, g = u & 1, h = g * 8 + wave, row0 = b * SEQ + c * 128;
        __syncthreads();
        { const int st_ = wave >> 1;
#pragma unroll
          for (int li = 0; li < 2; ++li) { const int lt = 2 * (wave & 1) + li; f32x16 d = f32x16{};
#pragma unroll
            for (int ks = 0; ks < 8; ++ks) { const bf16x8 af = *(const bf16x8*)(BM + (size_t)(row0 + st_ * 32 + q) * 256 + g * 128 + ks * 16 + 8 * hh);
                const bf16x8 bfr = *(const bf16x8*)(CM + (size_t)(row0 + lt * 32 + q) * 256 + g * 128 + ks * 16 + 8 * hh); d = MFMA32(af, bfr, d); }
#pragma unroll
            for (int i4 = 0; i4 < 4; ++i4) { u32x2 w; w.x = pk2(d[4 * i4], d[4 * i4 + 1]); w.y = pk2(d[4 * i4 + 2], d[4 * i4 + 3]);
                *(LAS u32x2*)(cbl + (lt * 32 + q) * XT_LD + st_ * 32 + 8 * i4 + 4 * hh) = w; } } }
        const float a = -expf(P.in[18][h]);
        ssd_acs(DT, row0, h, a, acs, lane);
        __syncthreads();
        f32x16 acc[2][4];
#pragma unroll
        for (int i = 0; i < 2; ++i)
#pragma unroll
            for (int j = 0; j < 4; ++j) acc[i][j] = f32x16{};
        { const bf16_t* st = ST + ((size_t)((b * 64 + c) * 16 + h) * 64) * 128;
#pragma unroll 2
          for (int ks = 0; ks < 8; ++ks) { bf16x8 af[2];
#pragma unroll
            for (int pt = 0; pt < 2; ++pt) af[pt] = *(const bf16x8*)(st + (size_t)(pt * 32 + q) * 128 + ks * 16 + 8 * hh);
#pragma unroll
            for (int lt = 0; lt < 4; ++lt) { const bf16x8 bfr = *(const bf16x8*)(CM + (size_t)(row0 + lt * 32 + q) * 256 + g * 128 + ks * 16 + 8 * hh);
                acc[0][lt] = MFMA32(af[0], bfr, acc[0][lt]); acc[1][lt] = MFMA32(af[1], bfr, acc[1][lt]); } } }
        float acl[4];
#pragma unroll
        for (int lt = 0; lt < 4; ++lt) { acl[lt] = acs[lt * 32 + q]; const float e = expf(acl[lt]);
#pragma unroll
            for (int i = 0; i < 16; ++i) { acc[0][lt][i] *= e; acc[1][lt][i] *= e; } }
#pragma unroll 1
        for (int sh = 0; sh < 2; ++sh) {
            for (int it = lane; it < 512; it += 64) { const int s = it >> 3, pg = (it & 7) * 8; const int sg = sh * 64 + s; const float sc = DT[(size_t)(row0 + sg) * 16 + h];
                const u32x4 v = *(const u32x4*)(XS + (size_t)(row0 + sg) * 1024 + h * 64 + pg);
#pragma unroll
                for (int e = 0; e < 4; ++e) { const unsigned w = pk2(bflo(v[e]) * sc, bfhi(v[e]) * sc); xt[(pg + 2 * e) * XH_LD + s] = (bf16_t)(w & 0xffff); xt[(pg + 2 * e + 1) * XH_LD + s] = (bf16_t)(w >> 16); } }
            asm volatile("s_waitcnt lgkmcnt(0)" ::: "memory");
#pragma unroll 1
            for (int ks = 0; ks < 4; ++ks) { const int s0 = sh * 64 + ks * 16 + 8 * hh;
                bf16x8 af[2];
#pragma unroll
                for (int pt = 0; pt < 2; ++pt) af[pt] = *(const LAS bf16x8*)(xt + (pt * 32 + q) * XH_LD + ks * 16 + 8 * hh);
                float as8[8];
#pragma unroll
                for (int j = 0; j < 8; ++j) as8[j] = acs[s0 + j];
#pragma unroll
                for (int lt = 0; lt < 4; ++lt) { if (lt * 32 + 31 < sh * 64 + ks * 16) continue;
                    const int l = lt * 32 + q; const u32x4 cv = *(const LAS u32x4*)(cbl + l * XT_LD + s0); float mv[8];
#pragma unroll
                    for (int j = 0; j < 4; ++j) { mv[2 * j] = bflo(cv[j]); mv[2 * j + 1] = bfhi(cv[j]); }
#pragma unroll
                    for (int j = 0; j < 8; ++j) mv[j] = (s0 + j <= l) ? mv[j] * __expf(acl[lt] - as8[j]) : 0.f;
                    u32x4 pw; pw.x = pk2(mv[0], mv[1]); pw.y = pk2(mv[2], mv[3]); pw.z = pk2(mv[4], mv[5]); pw.w = pk2(mv[6], mv[7]);
                    const bf16x8 bfr = __builtin_bit_cast(bf16x8, pw);
                    acc[0][lt] = MFMA32(af[0], bfr, acc[0][lt]); acc[1][lt] = MFMA32(af[1], bfr, acc[1][lt]); } }
            asm volatile("s_waitcnt lgkmcnt(0)" ::: "memory");
        }
        const float dsk = P.in[19][h];
#pragma unroll
        for (int lt = 0; lt < 4; ++lt) { const size_t rr = (size_t)(row0 + lt * 32 + q); float ss = 0.f;
#pragma unroll
            for (int pt = 0; pt < 2; ++pt)
#pragma unroll
                for (int i4 = 0; i4 < 4; ++i4) { const int p0 = h * 64 + pt * 32 + 8 * i4 + 4 * hh; const u32x2 xv = *(const u32x2*)(XS + rr * 1024 + p0), zv = *(const u32x2*)(Z + rr * 1024 + p0);
                    const float xs4[4] = {bflo(xv.x), bfhi(xv.x), bflo(xv.y), bfhi(xv.y)}, zs4[4] = {bflo(zv.x), bfhi(zv.x), bflo(zv.y), bfhi(zv.y)};
#pragma unroll
                    for (int e = 0; e < 4; ++e) { const float y = (acc[pt][lt][4 * i4 + e] + xs4[e] * dsk) * siluf_(zs4[e]); acc[pt][lt][4 * i4 + e] = y; ss += y * y; } }
            ss += xhalf(ss); if (hh == 0) ssq[wave * 128 + lt * 32 + q] = ss; }
        __syncthreads();
        const float* nw = P.in[20];
#pragma unroll
        for (int lt = 0; lt < 4; ++lt) { float tot = 0.f;
#pragma unroll
            for (int w = 0; w < 8; ++w) tot += ssq[w * 128 + lt * 32 + q];
            const float rs = rsqrtf(tot * (1.f / 512.f) + 1e-5f); const size_t rr = (size_t)(row0 + lt * 32 + q);
#pragma unroll
            for (int pt = 0; pt < 2; ++pt)
#pragma unroll
                for (int i4 = 0; i4 < 4; ++i4) { const int p0 = h * 64 + pt * 32 + 8 * i4 + 4 * hh; const f32x4 nv = *(const f32x4*)(nw + p0);
                    u32x2 w; w.x = pk2(acc[pt][lt][4 * i4] * rs * nv[0], acc[pt][lt][4 * i4 + 1] * rs * nv[1]); w.y = pk2(acc[pt][lt][4 * i4 + 2] * rs * nv[2], acc[pt][lt][4 * i4 + 3] * rs * nv[3]);
                    *(u32x2*)(OCAT + rr * 1536 + 512 + p0) = w; } }
    }
    __syncthreads();
}

struct AttnState { float m, l; f32x16 o[2]; };
DI void qk_tile(f32x16& s, const bf16_t* K, int key0, const bf16x8* qf, int q, int hh) {
    const bf16_t* kp = K + (size_t)(key0 + q) * 64 + 8 * hh; s = f32x16{};
#pragma unroll
    for (int ks = 0; ks < 4; ++ks) { const bf16x8 af = *(const bf16x8*)(kp + 16 * ks); s = MFMA32(af, qf[ks], s); }
}
DI void pv_tile(f32x16* o, const float* p, const bf16_t* VT, int ldv, int key0, int q, int hh) {
#pragma unroll
    for (int s = 0; s < 2; ++s) { u32x4 pw; pw.x = pk2(p[8 * s], p[8 * s + 1]); pw.y = pk2(p[8 * s + 2], p[8 * s + 3]); pw.z = pk2(p[8 * s + 4], p[8 * s + 5]); pw.w = pk2(p[8 * s + 6], p[8 * s + 7]);
        const bf16x8 pf = __builtin_bit_cast(bf16x8, pw);
#pragma unroll
        for (int dt = 0; dt < 2; ++dt) { const bf16_t* vp = VT + (size_t)(dt * 32 + q) * ldv + key0 + 16 * s + 4 * hh; const u32x2 lo = *(const u32x2*)vp, hi = *(const u32x2*)(vp + 8);
            const u32x4 av = (u32x4){lo.x, lo.y, hi.x, hi.y}; o[dt] = MFMA32(__builtin_bit_cast(bf16x8, av), pf, o[dt]); } }
}
DI void attn_step(AttnState& st, const f32x16& s, unsigned vmask, const bf16_t* VT, int ldv, int key0, int q, int hh) {
    float mx = -1e30f;
#pragma unroll
    for (int i = 0; i < 16; ++i) if ((vmask >> i) & 1u) mx = fmaxf(mx, s[i]);
    mx = fmaxf(mx, xhalf(mx));
    const float mn = fmaxf(st.m, mx), al = __expf(st.m - mn); st.m = mn; st.l *= al;
#pragma unroll
    for (int i = 0; i < 16; ++i) { st.o[0][i] *= al; st.o[1][i] *= al; }
    float p[16]; float sum = 0.f;
#pragma unroll
    for (int i = 0; i < 16; ++i) { p[i] = ((vmask >> i) & 1u) ? __expf(s[i] - mn) : 0.f; sum += p[i]; }
    st.l += sum;
    pv_tile(st.o, p, VT, ldv, key0, q, hh);
}
constexpr int KT_LD = 72, VT_LD = 136, STG_KEYS = 128, STG_K_BYTES = STG_KEYS * KT_LD * 2, STAGE_BYTES_A = STG_K_BYTES + 64 * VT_LD * 2;
template <bool MASKED>
DI void attn_step_l(AttnState& st, const LAS bf16_t* Kt, const LAS bf16_t* Vt, const bf16x8* qf, unsigned vmask, bool mine, int q, int hh) {
    f32x16 s = f32x16{};
#pragma unroll
    for (int ks = 0; ks < 4; ++ks) { const bf16x8 af = *(const LAS bf16x8*)(Kt + q * KT_LD + 16 * ks + 8 * hh); s = MFMA32(af, qf[ks], s); }
    if (MASKED) {
#pragma unroll
        for (int i = 0; i < 16; ++i) s[i] = ((vmask >> i) & 1u) ? s[i] : -1e30f; }
    float mx = fmaxf(fmaxf(s[0], s[1]), fmaxf(s[2], s[3]));
#pragma unroll
    for (int i = 4; i < 16; i += 4) mx = fmaxf(mx, fmaxf(fmaxf(s[i], s[i + 1]), fmaxf(s[i + 2], s[i + 3])));
    if (!MASKED) mx = mine ? mx : -1e30f;
    mx = xmax32(mx);
    if (__builtin_amdgcn_ballot_w64(mx > st.m) != 0ull) { const float mn = fmaxf(st.m, mx), al = EXP2(st.m - mn); st.m = mn; st.l *= al;
#pragma unroll
        for (int i = 0; i < 16; ++i) { st.o[0][i] *= al; st.o[1][i] *= al; } }
    const float c = (MASKED || mine) ? fmaxf(st.m, -1e29f) : 1e30f;
    float p[16]; float sum = 0.f;
#pragma unroll
    for (int i = 0; i < 16; ++i) { p[i] = EXP2(s[i] - c); sum += p[i]; }
    st.l += sum;
#pragma unroll
    for (int s2 = 0; s2 < 2; ++s2) { u32x4 pw; pw.x = pk2(p[8 * s2], p[8 * s2 + 1]); pw.y = pk2(p[8 * s2 + 2], p[8 * s2 + 3]); pw.z = pk2(p[8 * s2 + 4], p[8 * s2 + 5]); pw.w = pk2(p[8 * s2 + 6], p[8 * s2 + 7]);
        const bf16x8 pf = __builtin_bit_cast(bf16x8, pw);
#pragma unroll
        for (int dt = 0; dt < 2; ++dt) { const LAS bf16_t* vp = Vt + (dt * 32 + q) * VT_LD + 16 * s2 + 4 * hh; const u32x2 lo = *(const LAS u32x2*)vp, hi = *(const LAS u32x2*)(vp + 8);
            const u32x4 av = (u32x4){lo.x, lo.y, hi.x, hi.y}; st.o[dt] = MFMA32(__builtin_bit_cast(bf16x8, av), pf, st.o[dt]); } }
}
DI void nsa_phase(int wv, const Params& P, LAS unsigned char* lds) {
    const int tid_ = tid_fresh(wv);
    unsigned char* const ws_ = ws_fresh(P.ws);
    const int lane = tid_ & 63, wave = tid_ >> 6, q = lane & 31, hh = lane >> 5, tok = q >> 2, g = q & 3;
    const bf16_t* Q = (const bf16_t*)(ws_ + WS_Q); const bf16_t* KCC = (const bf16_t*)(ws_ + WS_KCC); const bf16_t* VCCT = (const bf16_t*)(ws_ + WS_VCCT);
    const bf16_t* KS = (const bf16_t*)(ws_ + WS_KS); const bf16_t* VST = (const bf16_t*)(ws_ + WS_VST); const bf16_t* KW = (const bf16_t*)(ws_ + WS_KW); const bf16_t* VWT = (const bf16_t*)(ws_ + WS_VWT);
    const float* GATES = (const float*)(ws_ + WS_GATES); bf16_t* OCAT = (bf16_t*)(ws_ + WS_OCAT);
    LAS float* imp = (LAS float*)(lds + wave * 4096);
    LAS unsigned long long* selm = (LAS unsigned long long*)(lds + 32768 + wave * 128);
    LAS unsigned char* tiles = lds + 36864;
    const int ldr = tid_ & 255, isV = tid_ >> 8;
    const int nunits = 512, NG = gridDim.x;
    for (int uu = blockIdx.x; uu < nunits; uu += NG) {
        const int pass = uu / NG, idx = uu - pass * NG; int gi = uu; if ((nunits % (2 * NG)) == 0 && (pass & 1)) gi = pass * NG + (NG - 1 - idx);
        int bh = gi >> 7, tg = gi & 127;
        if (NG == 256) { const int xq = blockIdx.x & 7, jq = (xq & 1) * 32 + (blockIdx.x >> 3); bh = xq >> 1; tg = pass ? 127 - jq : jq; }
        const int b = bh >> 1, hkv = bh & 1, t0b = tg * 64, t0 = t0b + 8 * wave, t = t0 + tok, head = hkv * 4 + g;
        const size_t row = (size_t)b * SEQ + t;
        bf16x8 qf[4];
#pragma unroll
        for (int ks = 0; ks < 4; ++ks) qf[ks] = *(const bf16x8*)(Q + row * 512 + head * 64 + 16 * ks + 8 * hh);
        const float g0 = GATES[row * 24 + head * 3 + 0], g1 = GATES[row * 24 + head * 3 + 1], g2 = GATES[row * 24 + head * 3 + 2];
        f32x16 out[2]; out[0] = f32x16{}; out[1] = f32x16{};
        for (int i = lane; i < 1024; i += 64) imp[i] = 0.f;
        const int nvmax = (t0 + 7 >= 31) ? ((t0 + 7 - 31) >> 4) + 1 : 0, nvt = (t >= 31) ? ((t - 31) >> 4) + 1 : 0, ntile = (nvmax + 31) >> 5;
        const bf16_t* Kc = KCC + (size_t)bh * 512 * 64; const bf16_t* VcT = VCCT + (size_t)bh * 64 * 512;
        float m = -1e30f, l = 0.f;
        bf16x8 kf[4], kn[4];
#define CMP_KLOAD(dst_, kt_) _Pragma("unroll") for (int ks = 0; ks < 4; ++ks) dst_[ks] = *(const bf16x8*)(Kc + (size_t)((kt_) * 32 + q) * 64 + 8 * hh + 16 * ks)
#define CMP_QK(s_) do { s_ = f32x16{}; _Pragma("unroll") for (int ks = 0; ks < 4; ++ks) s_ = MFMA32(kf[ks], qf[ks], s_); } while (0)
        if (ntile > 0) { CMP_KLOAD(kf, 0); }
        for (int kt = 0; kt < ntile; ++kt) { if (kt + 1 < ntile) { CMP_KLOAD(kn, kt + 1); }
            f32x16 s; CMP_QK(s); float mx = -1e30f;
#pragma unroll
            for (int i = 0; i < 16; ++i) if (kt * 32 + crow(i, hh) < nvt) mx = fmaxf(mx, s[i]);
            mx = xmax32(mx); const float mn = fmaxf(m, mx); l *= EXP2(m - mn); m = mn;
#pragma unroll
            for (int i = 0; i < 16; ++i) if (kt * 32 + crow(i, hh) < nvt) l += EXP2(s[i] - mn);
#pragma unroll
            for (int ks = 0; ks < 4; ++ks) kf[ks] = kn[ks]; }
        l = xsum32(l);
        const float invl = l > 0.f ? 1.f / l : 0.f;
        { f32x16 o[2]; o[0] = f32x16{}; o[1] = f32x16{}; float carry = 0.f;
          if (ntile > 0) { CMP_KLOAD(kf, 0); }
          for (int kt = 0; kt < ntile; ++kt) { if (kt + 1 < ntile) { CMP_KLOAD(kn, kt + 1); }
            f32x16 s; CMP_QK(s); float p[16];
#pragma unroll
            for (int i = 0; i < 16; ++i) p[i] = (kt * 32 + crow(i, hh) < nvt) ? EXP2(s[i] - m) * invl : 0.f;
            pv_tile(o, p, VcT, 512, kt * 32, q, hh);
            float G4[4], oL[4];
#pragma unroll
            for (int rr = 0; rr < 4; ++rr) { G4[rr] = (p[4 * rr] + p[4 * rr + 1]) + (p[4 * rr + 2] + p[4 * rr + 3]); oL[rr] = xother32(p[4 * rr + 3], hh); }
#pragma unroll
            for (int rr = 0; rr < 4; ++rr) { const float prev = hh ? oL[rr] : (rr ? oL[rr > 0 ? rr - 1 : 0] : carry); const float v = quad_sum(G4[rr] + prev);
                if (g == 0) imp[tok * 128 + kt * 8 + 2 * rr + hh] = v; }
            carry = oL[3];
#pragma unroll
            for (int ks = 0; ks < 4; ++ks) kf[ks] = kn[ks]; }
#undef CMP_KLOAD
#undef CMP_QK
#pragma unroll
          for (int i = 0; i < 16; ++i) { out[0][i] += g0 * o[0][i]; out[1][i] += g0 * o[1][i]; } }
        asm volatile("s_waitcnt lgkmcnt(0)" ::: "memory");
        for (int tk = 0; tk < 8; ++tk) { const int tt = t0 + tk, cur = tt >> 6; unsigned long long mlo, mhi;
            if (cur + 1 <= 16) { mlo = (1ull << (cur + 1)) - 1ull; mhi = 0ull; }
            else { const int j0 = lane, j1 = lane + 64;
                const float s0 = imp[tk * 128 + j0], s1 = imp[tk * 128 + j1];
                const unsigned k0 = (j0 > cur) ? 0u : ((j0 == 0 || j0 == cur || j0 == cur - 1) ? 0x7f000000u : __float_as_uint(s0) + 1u);
                const unsigned k1 = (j1 > cur) ? 0u : ((j1 == cur || j1 == cur - 1) ? 0x7f000000u : __float_as_uint(s1) + 1u);
                unsigned T = 0u;
#pragma unroll 1
                for (int bit = 30; bit >= 0; --bit) { const unsigned cand = T | (1u << bit);
                    const int cnt = __builtin_popcountll(__builtin_amdgcn_ballot_w64(k0 >= cand)) + __builtin_popcountll(__builtin_amdgcn_ballot_w64(k1 >= cand)); if (cnt >= 16) T = cand; }
                mlo = __builtin_amdgcn_ballot_w64(k0 > T); mhi = __builtin_amdgcn_ballot_w64(k1 > T);
                int need = 16 - __builtin_popcountll(mlo) - __builtin_popcountll(mhi);
                unsigned long long elo = __builtin_amdgcn_ballot_w64(k0 == T), ehi = __builtin_amdgcn_ballot_w64(k1 == T);
                while (need > 0 && elo) { const unsigned long long bb = elo & (0ull - elo); mlo |= bb; elo ^= bb; --need; }
                while (need > 0 && ehi) { const unsigned long long bb = ehi & (0ull - ehi); mhi |= bb; ehi ^= bb; --need; } }
            if (lane == 0) { selm[tk * 2] = mlo; selm[tk * 2 + 1] = mhi; } }
        asm volatile("s_waitcnt lgkmcnt(0)" ::: "memory");
        const unsigned long long mylo = selm[tok * 2], myhi = selm[tok * 2 + 1];
#pragma unroll 1
        for (int br = 0; br < 2; ++br) {
            const bf16_t* Kb = (br ? KW : KS) + (size_t)bh * SEQ * 64; const bf16_t* Vb = (br ? VWT : VST) + (size_t)bh * 64 * SEQ;
            const int ktb = br ? (((t0b - 511 > 0) ? (t0b - 511) : 0) >> 5) : 0, kte = ((t0b + 63) >> 5) + 1, nt = kte - ktb;
            const int nst = (nt + 3) >> 2;
            const bf16_t* gsrc = (isV ? (Vb + (size_t)(ldr >> 4) * SEQ + (ldr & 15) * 8) : (Kb + (size_t)(ldr >> 3) * 64 + (ldr & 7) * 8)) + (size_t)ktb * (isV ? 32 : 32 * 64);
            const size_t gj = isV ? (size_t)16 * SEQ : (size_t)32 * 64, gstage = isV ? 128 : 128 * 64;
            const int loff = isV ? (STG_K_BYTES + (ldr >> 4) * VT_LD * 2 + (ldr & 15) * 16) : ((ldr >> 3) * KT_LD * 2 + (ldr & 7) * 16), lj = isV ? 16 * VT_LD * 2 : 32 * KT_LD * 2;
            AttnState st; st.m = -1e30f; st.l = 0.f; st.o[0] = f32x16{}; st.o[1] = f32x16{};
            u32x4 pre[4];
#define NSA_LOAD(si_) _Pragma("unroll") for (int j_ = 0; j_ < 4; ++j_) pre[j_] = *(const u32x4*)(gsrc + (size_t)(si_) * gstage + j_ * gj)
#define NSA_STORE(buf_) _Pragma("unroll") for (int j_ = 0; j_ < 4; ++j_) *(LAS u32x4*)(tiles + (buf_) * STAGE_BYTES_A + loff + j_ * lj) = pre[j_]
            NSA_LOAD(0); NSA_STORE(0);
            if (nst > 1) { NSA_LOAD(1); }
            __syncthreads();
#pragma unroll 1
            for (int si = 0; si < nst; ++si) { const int cur = si & 1;
                if (si + 1 < nst) { NSA_STORE(cur ^ 1); if (si + 2 < nst) { NSA_LOAD(si + 2); } }
#pragma unroll 1
                for (int sub = 0; sub < 4; ++sub) { const int ti = si * 4 + sub; if (ti >= nt) break; const int key0 = (ktb + ti) * 32;
                    const bool rel = br ? (key0 <= t0 + 7 && key0 + 31 + 512 > t0) : (key0 <= t0 + 7);
                    if (rel) {
                        const LAS bf16_t* Kt = (const LAS bf16_t*)(tiles + cur * STAGE_BYTES_A) + sub * 32 * KT_LD; const LAS bf16_t* Vt = (const LAS bf16_t*)(tiles + cur * STAGE_BYTES_A + STG_K_BYTES) + sub * 32;
                        const int jb = key0 >> 6; const bool mine = br ? true : ((jb < 64) ? ((mylo >> jb) & 1ull) : ((myhi >> (jb - 64)) & 1ull));
                        const bool full = br ? (key0 + 31 <= t0 && key0 + 512 > t0 + 7) : (key0 + 31 <= t0);
                        if (__builtin_amdgcn_ballot_w64(mine) == 0ull) {   }
                        else if (full) attn_step_l<false>(st, Kt, Vt, qf, 0u, mine, q, hh);
                        else { unsigned vm = 0u;
                            if (br == 0) {
#pragma unroll
                                for (int e = 0; e < 16; ++e) vm |= (mine && (key0 + crow(e, hh) <= t)) ? (1u << e) : 0u; }
                            else {
#pragma unroll
                                for (int e = 0; e < 16; ++e) { const int key = key0 + crow(e, hh); vm |= (key <= t && key + 512 > t) ? (1u << e) : 0u; } }
                            attn_step_l<true>(st, Kt, Vt, qf, vm, true, q, hh); } } }
                __syncthreads(); }
#undef NSA_LOAD
#undef NSA_STORE
            const float lt = xsum32(st.l), gg = br ? g2 : g1, sc = lt > 0.f ? gg / lt : 0.f;
#pragma unroll
            for (int i = 0; i < 16; ++i) { out[0][i] += sc * st.o[0][i]; out[1][i] += sc * st.o[1][i]; }
        }
#pragma unroll
        for (int dt = 0; dt < 2; ++dt)
#pragma unroll
            for (int i4 = 0; i4 < 4; ++i4) { u32x2 w; w.x = pk2(out[dt][4 * i4], out[dt][4 * i4 + 1]); w.y = pk2(out[dt][4 * i4 + 2], out[dt][4 * i4 + 3]);
                *(u32x2*)(OCAT + row * 1536 + head * 64 + dt * 32 + 8 * i4 + 4 * hh) = w; }
    }
}

constexpr int RW_T = 32;
DI float multi4_sum(float q0, float q1, float q2, float q3, int lane) {
    const bool b0 = lane & 1, b1 = lane & 2;
    const float r01 = (b0 ? q1 : q0) + dpp_f<0xB1>(b0 ? q0 : q1);
    const float r23 = (b0 ? q3 : q2) + dpp_f<0xB1>(b0 ? q2 : q3);
    float r = (b1 ? r23 : r01) + dpp_f<0x4E>(b1 ? r01 : r23);
    r += dpp_f<0x124>(r); r += dpp_f<0x128>(r);
    { auto x = __builtin_amdgcn_permlane16_swap(__float_as_uint(r), __float_as_uint(r), false, false); r = __uint_as_float(x[0]) + __uint_as_float(x[1]); }
    { auto x = __builtin_amdgcn_permlane32_swap(__float_as_uint(r), __float_as_uint(r), false, false); r = __uint_as_float(x[0]) + __uint_as_float(x[1]); }
    return r;
}
DI float rdlane(float v, int l) { return __builtin_bit_cast(float, __builtin_amdgcn_readlane(__builtin_bit_cast(int, v), l)); }
DI float row16_sum(float v) { v += dpp_f<0xB1>(v); v += dpp_f<0x4E>(v); v += dpp_f<0x141>(v); v += dpp_f<0x140>(v); return v; }
DI void rwkv_scan_phase(int wv, const Params& P, LAS unsigned char* lds) {
    const int tid_ = tid_fresh(wv);
    unsigned char* const ws_ = ws_fresh(P.ws);
    const int lane = tid_ & 63, wave = tid_ >> 6;
    const bf16_t* R = (const bf16_t*)(ws_ + WS_R); const bf16_t* K = (const bf16_t*)(ws_ + WS_K); const bf16_t* V = (const bf16_t*)(ws_ + WS_V); const bf16_t* AA = (const bf16_t*)(ws_ + WS_AA);
    const _Float16* LD = (const _Float16*)(ws_ + WS_LD); bf16_t* YS = (bf16_t*)(ws_ + WS_YS); float* RK = (float*)(ws_ + WS_RK);
    LAS float* stg = (LAS float*)lds;
    LAS float* vst = (LAS float*)(lds + 2 * RW_T * 5 * 64 * 4);
    LAS float* ybuf = vst + 2 * RW_T * 8;
    const int nck = SEQ / RW_T;
    const int pw = wave - 2;
    for (int u = blockIdx.x; u < 256; u += gridDim.x) {
        const int ux = (gridDim.x == 256) ? (((u & 7) * 4 + (u >> 6)) * 8 + ((u >> 3) & 7)) : u;
        const int bh = ux >> 3, rg = ux & 7, b = bh >> 4, h = bh & 15;
        __syncthreads();
        if (wave >= 2) {
            const int ch = h * 64 + lane;
            const float kkw = P.in[35][ch], kaw = P.in[36][ch], rkw = P.in[37][ch];
            const int hf = lane >> 5, c2 = lane & 31, chp = h * 64 + 2 * c2;
            const f32x2 kkw2 = *(const f32x2*)(P.in[35] + chp), kaw2 = *(const f32x2*)(P.in[36] + chp), rkw2 = *(const f32x2*)(P.in[37] + chp);
            unsigned gk[3], ga[3], gr[3], gl[3]; float gv[3];
#define RW_LOADG(cn_) _Pragma("unroll") for (int i = 0; i < 3; ++i) { const int pp = pw + 6 * i; const size_t row = (size_t)b * SEQ + (cn_) * RW_T + 2 * (pp < 16 ? pp : 0) + hf; \
                gk[i] = *(const unsigned*)(K + row * 1024 + chp); ga[i] = *(const unsigned*)(AA + row * 1024 + chp); gr[i] = *(const unsigned*)(R + row * 1024 + chp); gl[i] = *(const unsigned*)(LD + row * 1024 + chp); \
                gv[i] = bf2f(V[row * 1024 + h * 64 + rg * 8 + (c2 & 7)]); }
            RW_LOADG(0)
#pragma unroll 1
            for (int ck = -1; ck <= nck; ++ck) {
                {
                    if (ck >= 1) { const LAS float* yb = ybuf + ((ck - 1) & 1) * RW_T * 128;
#pragma unroll 2
                        for (int it = pw; it < 64; it += 6) { const float y = row16_sum(yb[it * 64 + lane]);
                            const float y0 = __builtin_bit_cast(float, __builtin_amdgcn_readlane(__builtin_bit_cast(int, y), 0)), y1 = __builtin_bit_cast(float, __builtin_amdgcn_readlane(__builtin_bit_cast(int, y), 16)),
                                        y2 = __builtin_bit_cast(float, __builtin_amdgcn_readlane(__builtin_bit_cast(int, y), 32)), y3 = __builtin_bit_cast(float, __builtin_amdgcn_readlane(__builtin_bit_cast(int, y), 48));
                            if (lane == 0) { u32x2 w; w.x = pk2(y0, y1); w.y = pk2(y2, y3); *(u32x2*)(YS + ((size_t)b * SEQ + (ck - 1) * RW_T + (it >> 1)) * 1024 + h * 64 + rg * 8 + (it & 1) * 4) = w; } } }
                    if (ck + 1 < nck) { const int cn = ck + 1, buf = cn & 1;
#pragma unroll
                        for (int i = 0; i < 3; ++i) { const int pp = pw + 6 * i; if (pp < 16) { const int tt = 2 * pp + hf; const size_t row = (size_t)b * SEQ + cn * RW_T + tt;
                            const f32x2 k = {bflo(gk[i]), bfhi(gk[i])}, a = {bflo(ga[i]), bfhi(ga[i])}, r = {bflo(gr[i]), bfhi(gr[i])};
                            const h16x2 lh = __builtin_bit_cast(h16x2, gl[i]);
                            const f32x2 kr = k * kkw2, kp = k * ((a - 1.f) * kaw2 + 1.f);
                            const float sp = kr[0] * kr[0] + kr[1] * kr[1], rp = r[0] * kp[0] * rkw2[0] + r[1] * kp[1] * rkw2[1];
                            const bool odd = lane & 1;
                            float red = (odd ? rp : sp) + dpp_f<0xB1>(odd ? sp : rp);
                            red += dpp_f<0x4E>(red); red += dpp_f<0x124>(red); red += dpp_f<0x128>(red);
                            { auto x = __builtin_amdgcn_permlane16_swap(__float_as_uint(red), __float_as_uint(red), false, false); red = __uint_as_float(x[0]) + __uint_as_float(x[1]); }
                            const float oth = dpp_f<0xB1>(red); const float ss = odd ? oth : red, rks = odd ? red : oth;
                            const f32x2 kk = kr * __builtin_amdgcn_rsqf(fmaxf(ss, 1e-24f));
                            LAS float* d = stg + ((buf * RW_T + tt) * 5) * 64 + 2 * c2;
                            *(LAS f32x2*)(d) = -kk; *(LAS f32x2*)(d + 64) = (f32x2){__expf((float)lh[0]), __expf((float)lh[1])}; *(LAS f32x2*)(d + 128) = kk * a; *(LAS f32x2*)(d + 192) = kp; *(LAS f32x2*)(d + 256) = r;
                            if (rg == 0 && c2 == 0) RK[row * 16 + h] = rks;
                            if (c2 < 8) vst[(buf * RW_T + tt) * 8 + c2] = gv[i]; } }
                        if (ck + 2 < nck) { RW_LOADG(ck + 2) } }
                }
                if (ck < nck) __syncthreads();
            }
        } else {
            const int cg = lane & 15, rloc = wave * 4 + (lane >> 4);
            f32x4 S = (f32x4){0.f, 0.f, 0.f, 0.f};
            __syncthreads();
            __builtin_amdgcn_s_setprio(3);
#pragma unroll 1
            for (int ck = 0; ck < nck; ++ck) { const int buf = ck & 1;
                const LAS float* sb = stg + buf * RW_T * 5 * 64 + 4 * cg; const LAS float* vb = vst + buf * RW_T * 8 + rloc; LAS float* yb = ybuf + buf * RW_T * 128 + wave * 64 + lane;
                const unsigned sba = (unsigned)(size_t)sb, vba = (unsigned)(size_t)vb;
                f32x4 nkA, ddA, bbA, kpA, rrA, nkB, ddB, bbB, kpB, rrB; float vvA, vvB;
#define RW_LDS_LOAD(X, j_) asm volatile("ds_read_b128 %0, %6 offset:%c8\n\tds_read_b128 %1, %6 offset:%c9\n\tds_read_b128 %2, %6 offset:%c10\n\tds_read_b128 %3, %6 offset:%c11\n\tds_read_b128 %4, %6 offset:%c12\n\tds_read_b32 %5, %7 offset:%c13" \
                    : "=&v"(nk##X), "=&v"(dd##X), "=&v"(bb##X), "=&v"(kp##X), "=&v"(rr##X), "=&v"(vv##X) : "v"(sbt), "v"(vbt), "i"((j_) * 1280), "i"((j_) * 1280 + 256), "i"((j_) * 1280 + 512), "i"((j_) * 1280 + 768), "i"((j_) * 1280 + 1024), "i"((j_) * 32) : "memory")
#define RW_LDS_WAIT(X) asm volatile("s_waitcnt lgkmcnt(0)" : "+v"(nk##X), "+v"(dd##X), "+v"(bb##X), "+v"(kp##X), "+v"(rr##X), "+v"(vv##X) :: "memory")
#define SB_() __builtin_amdgcn_sched_barrier(0)
#define LO2(v_) __builtin_shufflevector(v_, v_, 0, 1)
#define HI2(v_) __builtin_shufflevector(v_, v_, 2, 3)
#define RW_STEP(X, tt_) do { \
                    f32x2 pa_ = LO2(S) * LO2(nk##X); pa_ = HI2(S) * HI2(nk##X) + pa_; float q_ = pa_[0] + pa_[1]; SB_(); \
                    q_ += dpp_f<0xB1>(q_); const f32x2 kvl_ = LO2(kp##X) * vv##X; SB_(); \
                    q_ += dpp_f<0x4E>(q_); const f32x2 kvh_ = HI2(kp##X) * vv##X; SB_(); \
                    q_ += dpp_f<0x141>(q_); const float yp_ = yacc[0] + yacc[1]; SB_(); \
                    q_ += dpp_f<0x140>(q_); if ((tt_) > 0 || tt > 0) ybt[((tt_) - 1) * 128] = yp_; SB_(); \
                    const f32x2 sl_ = LO2(S) * LO2(dd##X) + (LO2(bb##X) * q_ + kvl_), sh_ = HI2(S) * HI2(dd##X) + (HI2(bb##X) * q_ + kvh_); SB_(); \
                    yacc = sl_ * LO2(rr##X); yacc = sh_ * HI2(rr##X) + yacc; S = __builtin_shufflevector(sl_, sh_, 0, 1, 2, 3); SB_(); } while (0)
                f32x2 yacc = (f32x2){0.f, 0.f};
                unsigned sbt = sba, vbt = vba; LAS float* ybt = yb;
                RW_LDS_LOAD(A, 0); RW_LDS_WAIT(A);
#pragma unroll 1
                for (int tt = 0; tt < RW_T; tt += 8) { sbt = sba + (unsigned)tt * 1280u; vbt = vba + (unsigned)tt * 32u; ybt = yb + tt * 128;
                    RW_LDS_LOAD(B, 1); RW_STEP(A, 0); RW_LDS_WAIT(B);
                    RW_LDS_LOAD(A, 2); RW_STEP(B, 1); RW_LDS_WAIT(A);
                    RW_LDS_LOAD(B, 3); RW_STEP(A, 2); RW_LDS_WAIT(B);
                    RW_LDS_LOAD(A, 4); RW_STEP(B, 3); RW_LDS_WAIT(A);
                    RW_LDS_LOAD(B, 5); RW_STEP(A, 4); RW_LDS_WAIT(B);
                    RW_LDS_LOAD(A, 6); RW_STEP(B, 5); RW_LDS_WAIT(A);
                    RW_LDS_LOAD(B, 7); RW_STEP(A, 6); RW_LDS_WAIT(B);
                    RW_LDS_LOAD(A, 8); RW_STEP(B, 7); RW_LDS_WAIT(A);
                }
                yb[(RW_T - 1) * 128] = yacc[0] + yacc[1];
#undef SB_
#undef LO2
#undef HI2
#undef RW_LDS_LOAD
#undef RW_LDS_WAIT
#undef RW_STEP
                __syncthreads();
            }
            __builtin_amdgcn_s_setprio(0);
        }
    }
}
DI void rwkv_post_phase(int wv, const Params& P) {
    const int tid_ = tid_fresh(wv);
    unsigned char* const ws_ = ws_fresh(P.ws);
    const int lane = tid_ & 63, gw = blockIdx.x * NWAVES + (tid_ >> 6), NGW = gridDim.x * NWAVES;
    const bf16_t* YS = (const bf16_t*)(ws_ + WS_YS); const bf16_t* V = (const bf16_t*)(ws_ + WS_V); const bf16_t* G = (const bf16_t*)(ws_ + WS_G); const float* RK = (const float*)(ws_ + WS_RK);
    bf16_t* A2 = (bf16_t*)(ws_ + WS_A2); const float* lng = P.in[38]; const float* lnb = P.in[39];
    for (int r = gw; r < MTOK; r += NGW) {
#pragma unroll
        for (int it = 0; it < 2; ++it) { const int head = it * 8 + (lane >> 3), ch = head * 64 + (lane & 7) * 8; const size_t off = (size_t)r * 1024 + ch;
            const u32x4 yv = *(const u32x4*)(YS + off), vv = *(const u32x4*)(V + off), gv = *(const u32x4*)(G + off);
            float y[8], v8[8], g8[8];
#pragma unroll
            for (int e = 0; e < 4; ++e) { y[2 * e] = bflo(yv[e]); y[2 * e + 1] = bfhi(yv[e]); v8[2 * e] = bflo(vv[e]); v8[2 * e + 1] = bfhi(vv[e]); g8[2 * e] = bflo(gv[e]); g8[2 * e + 1] = bfhi(gv[e]); }
            float s = 0.f;
#pragma unroll
            for (int e = 0; e < 8; ++e) s += y[e];
            s += dpp_f<0xB1>(s); s += dpp_f<0x4E>(s); s += dpp_f<0x141>(s);
            const float mean = s * (1.f / 64.f); float q = 0.f;
#pragma unroll
            for (int e = 0; e < 8; ++e) { y[e] -= mean; q += y[e] * y[e]; }
            q += dpp_f<0xB1>(q); q += dpp_f<0x4E>(q); q += dpp_f<0x141>(q);
            const float rstd = rsqrtf(q * (1.f / 64.f) + 64e-5f), rk = RK[(size_t)r * 16 + head];
            const f32x4 l0 = *(const f32x4*)(lng + ch), l1 = *(const f32x4*)(lng + ch + 4), b0 = *(const f32x4*)(lnb + ch), b1 = *(const f32x4*)(lnb + ch + 4);
            float o[8];
#pragma unroll
            for (int e = 0; e < 8; ++e) { const float lg = e < 4 ? l0[e & 3] : l1[e & 3], lb = e < 4 ? b0[e & 3] : b1[e & 3]; o[e] = (y[e] * rstd * lg + lb + rk * v8[e]) * g8[e]; }
            u32x4 w; w.x = pk2(o[0], o[1]); w.y = pk2(o[2], o[3]); w.z = pk2(o[4], o[5]); w.w = pk2(o[6], o[7]);
            *(u32x4*)(A2 + off) = w; }
    }
}


#define XB_TMO      128
#define XB_XCNT(j)  (256  + 64 * (j))
#define XB_XSUB(j)  (1280 + 64 * (j))
#define XB_XGEN(j)  (2304 + 64 * (j))
#define XB_TOP      3328
#define XB_TOPGEN   3392
#define XCD_BAR_WORDS 3456
#define XB_SPIN_CAP (1u << 22)
DI unsigned xb_ld(unsigned* p)              { return __hip_atomic_load(p, __ATOMIC_RELAXED, __HIP_MEMORY_SCOPE_AGENT); }
DI unsigned xb_add(unsigned* p, unsigned v) { return __hip_atomic_fetch_add(p, v, __ATOMIC_RELAXED, __HIP_MEMORY_SCOPE_AGENT); }
DI unsigned xb_xcc_id() { return (unsigned)__builtin_amdgcn_s_getreg((3 << 11) | 20) & 0xFu; }
#define XB_SPIN(cond, bar) do { unsigned _sp = 0; while (cond) { __builtin_amdgcn_s_sleep(1); \
    if ((++_sp & 255u) == 0u) { if (xb_ld(&(bar)[XB_TMO])) break; if (_sp > XB_SPIN_CAP) { atomicAdd(&(bar)[XB_TMO], 1u); break; } } } } while (0)
DI void xcd_barrier_complete(unsigned* bar, unsigned x, unsigned& nloc, unsigned& nx) {
    const unsigned G = gridDim.x * gridDim.y * gridDim.z;
    unsigned sum, cnt, mine, sp = 0u;
    for (;;) {
        sum = 0u; cnt = 0u; mine = 0u;
#pragma unroll
        for (unsigned j = 0; j < 16; ++j) { const unsigned c = xb_ld(&bar[XB_XCNT(j)]); sum += c; cnt += (c > 0u) ? 1u : 0u; mine = (j == x) ? c : mine; }
        if (sum == G) break;
        __builtin_amdgcn_s_sleep(1);
        if ((++sp & 255u) == 0u) { if (xb_ld(&bar[XB_TMO])) break; if (sp > XB_SPIN_CAP) { atomicAdd(&bar[XB_TMO], 1u); break; } }
    }
    nloc = mine > 0u ? mine : 1u; nx = cnt > 0u ? cnt : 1u;
}
DI void xcd_barrier(unsigned* bar, volatile LAS unsigned* st, bool leader) {
    asm volatile("s_waitcnt vmcnt(0)" ::: "memory");
    __syncthreads();
    if (leader) {
        const unsigned x = xb_xcc_id();
        __builtin_amdgcn_s_waitcnt(0);
        unsigned nloc = st[0], nx = st[1];
        if (nloc == 0u) { xcd_barrier_complete(bar, x, nloc, nx); st[0] = nloc; st[1] = nx; }
        const unsigned old = xb_add(&bar[XB_XSUB(x)], 1u);
        const unsigned gen = old / nloc;
        if (old + 1u == (gen + 1u) * nloc) {
            __builtin_amdgcn_fence(__ATOMIC_RELEASE, "agent");
            asm volatile("s_waitcnt vmcnt(0)" ::: "memory");
            const unsigned og = xb_add(&bar[XB_TOP], 1u);
            const unsigned tg = og / nx;
            if (og + 1u == (tg + 1u) * nx) xb_add(&bar[XB_TOPGEN], 1u);
            else XB_SPIN(xb_ld(&bar[XB_TOPGEN]) == tg, bar);
            __builtin_amdgcn_fence(__ATOMIC_ACQUIRE, "agent");
            xb_add(&bar[XB_XGEN(x)], 1u);
            asm volatile("s_waitcnt vmcnt(0)" ::: "memory");
        } else {
            XB_SPIN(xb_ld(&bar[XB_XGEN(x)]) == gen, bar);
            __builtin_amdgcn_fence(__ATOMIC_ACQUIRE, "agent");
            asm volatile("s_waitcnt vmcnt(0)" ::: "memory");
        }
    }
    __syncthreads();
}

#ifndef REP_GEMM
#define REP_GEMM 1
#endif
#ifndef REP_NSA
#define REP_NSA 1
#endif
#ifndef REP_SCAN
#define REP_SCAN 1
#endif
#ifndef REP_SSD
#define REP_SSD 1
#endif
#define GEMM_RUN(EpiT, epi, Aptr, Bptr, M_, N_, K_, lda_, padA_, cshift) for (int rep_ = 0; rep_ < REP_GEMM; ++rep_) do { pg8::Gemm g_{(const bf16_t*)(Aptr), (const bf16_t*)(Bptr), (M_), (N_), (K_), (lda_), (padA_)}; pg8::StaticOrder S_; \
    S_.init((M_), (N_), (int)gridDim.x, (int)((blockIdx.x + gridDim.x - (cshift)) % gridDim.x)); pg8::gemm_phase<EpiT>(wv, lds, g_, S_, (epi)); } while (0)

DI unsigned* bar_ptr(const Params& P) { return (unsigned*)(P.ws + WS_BAR); }
#define ws ws_fresh(P.ws)
#define A ((bf16_t*)(ws + WS_A))
#define H ((bf16_t*)(ws + WS_H))
#define Y ((bf16_t*)(ws + WS_Y))
#define GSYNC() do { unsigned* const barp_ = bar_ptr(P); const bool lead_ = (tid_fresh(wv) == 0); xcd_barrier(barp_, (volatile LAS unsigned*)(lds + LDS_BYTES - 64), lead_); } while (0)
template <int layer> DI void layer_body(const Params& P, cg::grid_group& grid, const int wv, LAS unsigned char* lds) {
    float* X = P.out; const float* ng = P.in[1];
        const float* gl = ng + layer * 6 * DM;
        { EpiSwiglu e{H}; GEMM_RUN(EpiSwiglu, e, A, ws + WS_WGU, MTOK, 2 * DFF, DM, DM, 0, 0); }
        GSYNC();
        { EpiBf16 e{Y, DM}; GEMM_RUN(EpiBf16, e, H, ws + WS_WD, MTOK, DM, DFF, DFF, 0, 0); }
        GSYNC();
        row_phase(wv, 1, layer == 0 ? P.in[0] : X, Y, gl + 1 * DM, 0.5f, gl + 2 * DM, X, A, layer);
        run_jobs(wv, P.ffn2[layer], 3, nullptr, 0, lds);
        GSYNC();
        if (layer == 0) {
            { EpiWin e{ws, P.in[17]};
              GEMM_RUN(EpiWin, e, A, ws + WS_WIN, MTOK, 4096, DM, DM, 0, 0); }
            GSYNC();
            { EpiF32 e{(float*)(ws + WS_PK), 256}; GEMM_RUN(EpiF32, e, ws + WS_KCN, ws + WS_W1K, 2048, 256, 1024, 1024, 0, 0); }
            { EpiF32 e{(float*)(ws + WS_PV), 256}; GEMM_RUN(EpiF32, e, ws + WS_VCN, ws + WS_W1V, 2048, 256, 1024, 1024, 0, 8); }
            for (int r_ = 0; r_ < REP_SSD; ++r_) conv_phase(wv, P);
            GSYNC();
            cmp_finish_phase(wv, P); for (int r_ = 0; r_ < REP_SSD; ++r_) ssd_states_phase(wv, P, lds);
            GSYNC();
            ssd_scan_phase(wv, P); for (int r_ = 0; r_ < REP_NSA; ++r_) nsa_phase(wv, P, lds);
            GSYNC();
            for (int r_ = 0; r_ < REP_SSD; ++r_) ssd_out_phase(wv, P, lds);
            GSYNC();
            { EpiBf16 e{(bf16_t*)(ws + WS_YMIX0), DM}; GEMM_RUN(EpiBf16, e, ws + WS_OCAT, ws + WS_WOUT, MTOK, DM, 1536, 1536, 0, 0); }
            GSYNC();
            row_phase(wv, 1, X, (const bf16_t*)(ws + WS_YMIX0), gl + 3 * DM, 1.f, gl + 4 * DM, X, A, 0);
            GSYNC();
        } else {
            { EpiRwkv1 e{ws}; GEMM_RUN(EpiRwkv1, e, A, ws + WS_WG1, MTOK, 3584, 2048, DM, DM * 2, 0); }
            GSYNC();
            { EpiRwkv2 e{(_Float16*)(ws + WS_LD), (bf16_t*)(ws + WS_AA), P.in[27], P.in[30]}; GEMM_RUN(EpiRwkv2, e, ws + WS_LH, ws + WS_W2A, MTOK, 2048, 128, 512, 0, 0); }
            GSYNC();
            for (int r_ = 0; r_ < REP_SCAN; ++r_) rwkv_scan_phase(wv, P, lds);
            GSYNC();
            { EpiBf16 e{(bf16_t*)(ws + WS_G), DM}; GEMM_RUN(EpiBf16, e, (bf16_t*)(ws + WS_LH) + 128, ws + WS_W2B, MTOK, DM, 256, 512, 0, 0); }
            GSYNC();
            rwkv_post_phase(wv, P);
            GSYNC();
            { EpiBf16 e{(bf16_t*)(ws + WS_YMIX1), DM}; GEMM_RUN(EpiBf16, e, ws + WS_A2, ws + WS_WO, MTOK, DM, DM, DM, 0, 0); }
            GSYNC();
            row_phase(wv, 1, X, (const bf16_t*)(ws + WS_YMIX1), gl + 3 * DM, 1.f, gl + 4 * DM, X, A, 0);
            GSYNC();
        }
        { EpiSwiglu e{H}; GEMM_RUN(EpiSwiglu, e, A, ws + WS_WGU, MTOK, 2 * DFF, DM, DM, 0, 0); }
        GSYNC();
        { EpiBf16 e{Y, DM}; GEMM_RUN(EpiBf16, e, H, ws + WS_WD, MTOK, DM, DFF, DFF, 0, 0); }
        GSYNC();
        if (layer == 0) { row_phase(wv, 1, X, Y, gl + 5 * DM, 0.5f, ng + 6 * DM, X, A, 0); run_jobs(wv, P.js[1].cj, P.js[1].ncj, P.js[1].zj, P.js[1].nzj, lds); GSYNC(); }
        else row_phase(wv, 1, X, Y, gl + 5 * DM, 0.5f, nullptr, X, nullptr, 0);
}

__global__ void __launch_bounds__(NTHREADS, 2) mega_fwd(Params P) {
    extern __shared__ __attribute__((aligned(16))) unsigned char lds_raw[];
    LAS unsigned char* lds = (LAS unsigned char*)lds_raw;
    cg::grid_group grid = cg::this_grid();
    const int wv = __builtin_amdgcn_readfirstlane(threadIdx.x >> 6);
    { unsigned* const barp = bar_ptr(P); const unsigned xid = xb_xcc_id();
      if (threadIdx.x == 0) { ((volatile LAS unsigned*)(lds + LDS_BYTES - 64))[0] = 0u; ((volatile LAS unsigned*)(lds + LDS_BYTES - 64))[1] = 0u; (void)xb_add(barp + XB_XCNT(xid), 1u); } }
    __syncthreads();
    float* X = P.out;
    const float* ng = P.in[1];
    grid.sync();
    run_jobs(wv, P.js[0].cj, P.js[0].ncj, P.js[0].zj, P.js[0].nzj, lds); p0_misc(wv, P, lds);
    row_phase(wv, 0, P.in[0], nullptr, nullptr, 0.f, ng + 0 * DM, nullptr, A, 0);
    GSYNC();
    layer_body<0>(P, grid, wv, lds);
    layer_body<1>(P, grid, wv, lds);
}
#undef ws
#undef A
#undef H
#undef Y
static void add_cvt(JobSet& js, const float* src, int ldw, int K, int N, bf16_t* dst, int ldk, int koff, int mode, int rowoff, const float* scale = nullptr, int smode = 0) {
    CvtJob& j = js.cj[js.ncj++]; j.src = src; j.scale = scale; j.dst = dst; j.ldw = ldw; j.K = K; j.N = N; j.ldk = ldk; j.koff = koff; j.mode = mode; j.rowoff = rowoff; j.smode = smode;
}
static void add_zero(JobSet& js, bf16_t* dst, int rows, int ldk, int c0, int nc) { ZeroJob& z = js.zj[js.nzj++]; z.dst = dst; z.rows = rows; z.ldk = ldk; z.c0 = c0; z.nc = nc; z.pad = 0; }
static void set_cvt(CvtJob& j, const float* src, int ldw, int K, int N, bf16_t* dst, int ldk, int koff, int mode, int rowoff) {
    j.src = src; j.scale = nullptr; j.dst = dst; j.ldw = ldw; j.K = K; j.N = N; j.ldk = ldk; j.koff = koff; j.mode = mode; j.rowoff = rowoff; j.smode = 0;
}
static void set_ffn(CvtJob* j, unsigned char* ws, const float* wg, const float* wu, const float* wd) {
    set_cvt(j[0], wg, DFF, DM, DFF, (bf16_t*)(ws + WS_WGU), DM, 0, 1, 0); set_cvt(j[1], wu, DFF, DM, DFF, (bf16_t*)(ws + WS_WGU), DM, 0, 1, 128); set_cvt(j[2], wd, DM, DFF, DM, (bf16_t*)(ws + WS_WD), DFF, 0, 0, 0);
}
static void add_ffn(JobSet& js, unsigned char* ws, const float* wg, const float* wu, const float* wd) {
    add_cvt(js, wg, DFF, DM, DFF, (bf16_t*)(ws + WS_WGU), DM, 0, 1, 0);
    add_cvt(js, wu, DFF, DM, DFF, (bf16_t*)(ws + WS_WGU), DM, 0, 1, 128);
    add_cvt(js, wd, DM, DFF, DM, (bf16_t*)(ws + WS_WD), DFF, 0, 0, 0);
}

extern "C" void kernel_launch(void* const* d_in, const int* in_sizes, int n_in, void* d_out, int out_size, void* d_ws, size_t ws_size, hipStream_t stream) {
    static int grid = 0;
    if (grid == 0) {
        int dev = 0, cus = 0, per_cu = 0;
        hipGetDevice(&dev); hipDeviceGetAttribute(&cus, hipDeviceAttributeMultiprocessorCount, dev);
        hipFuncSetAttribute((const void*)mega_fwd, hipFuncAttributeMaxDynamicSharedMemorySize, LDS_BYTES);
        hipOccupancyMaxActiveBlocksPerMultiprocessor(&per_cu, (const void*)mega_fwd, NTHREADS, LDS_BYTES);
        if (per_cu < 1) { fprintf(stderr, "occupancy query returned %d\n", per_cu); per_cu = 1; }
        grid = cus * 1;
        if (n_in != 40 || ws_size < 256 * MiB) fprintf(stderr, "unexpected n_in %d / ws %zu\n", n_in, ws_size);
    }
    static Params P;
    memset(&P, 0, sizeof(P));
    for (int i = 0; i < 40; ++i) P.in[i] = (const float*)d_in[i];
    P.out = (float*)d_out; P.ws = (unsigned char*)d_ws;
    unsigned char* ws = P.ws;
    const float* const* in = P.in;
    const size_t FW = (size_t)DM * DFF;
    { JobSet& js = P.js[0]; add_ffn(js, ws, in[2], in[3], in[4]);
      add_cvt(js, in[8], 3880, DM, 3880, (bf16_t*)(ws + WS_WIN), DM, 0, 2, 0);
      add_cvt(js, in[21], DM, 1536, DM, (bf16_t*)(ws + WS_WOUT), 1536, 0, 0, 0);
      add_cvt(js, in[10], 64, 1024, 64, (bf16_t*)(ws + WS_W1K), 1024, 0, 0, 0); add_cvt(js, in[10] + 1024 * 64, 64, 1024, 64, (bf16_t*)(ws + WS_W1K), 1024, 0, 0, 64);
      add_cvt(js, in[13], 64, 1024, 64, (bf16_t*)(ws + WS_W1V), 1024, 0, 0, 0); add_cvt(js, in[13] + 1024 * 64, 64, 1024, 64, (bf16_t*)(ws + WS_W1V), 1024, 0, 0, 64);
      add_zero(js, (bf16_t*)(ws + WS_W1K) + 128 * 1024, 128, 1024, 0, 1024); add_zero(js, (bf16_t*)(ws + WS_W1V) + 128 * 1024, 128, 1024, 0, 1024);
      add_zero(js, (bf16_t*)(ws + WS_WIN) + (size_t)(768 + 64) * DM, 64, DM, 0, DM); add_zero(js, (bf16_t*)(ws + WS_WIN) + (size_t)(768 + 128 + 64) * DM, 64, DM, 0, DM);
      add_zero(js, (bf16_t*)(ws + WS_WIN) + (size_t)(1280 + 128 + 40) * DM, 88, DM, 0, DM); }
    set_ffn(P.ffn2[0], ws, in[5], in[6], in[7]);
    { JobSet& js = P.js[1]; add_ffn(js, ws, in[2] + FW, in[3] + FW, in[4] + FW);
      bf16_t* wg1 = (bf16_t*)(ws + WS_WG1); const float* mu = in[22];
      const float* srcs[6] = {in[23], in[24], in[25], in[28], in[31], in[33]}; const int ncol[6] = {1024, 1024, 1024, 64, 64, 160}; const int roff[6] = {0, 1024, 2048, 3072, 3072 + 64, 3072 + 128}; const int mui[6] = {0, 2, 3, 1, 4, 5};
      for (int i = 0; i < 6; ++i) { add_cvt(js, srcs[i], ncol[i], DM, ncol[i], wg1, 2048, 0, 0, roff[i], mu + mui[i] * DM, 1); add_cvt(js, srcs[i], ncol[i], DM, ncol[i], wg1, 2048, 1024, 0, roff[i], mu + mui[i] * DM, 2); }
      add_zero(js, wg1 + (size_t)(3072 + 288) * 2048, 224, 2048, 0, 2048);
      add_cvt(js, in[26], DM, DM, DM, (bf16_t*)(ws + WS_WO), DM, 0, 0, 0);
      bf16_t* w2a = (bf16_t*)(ws + WS_W2A); add_cvt(js, in[29], DM, 64, DM, w2a, 128, 0, 0, 0); add_cvt(js, in[32], DM, 64, DM, w2a, 128, 64, 0, 1024);
      add_zero(js, w2a, 1024, 128, 64, 64); add_zero(js, w2a + 1024 * 128, 1024, 128, 0, 64);
      bf16_t* w2b = (bf16_t*)(ws + WS_W2B); add_cvt(js, in[34], DM, 160, DM, w2b, 256, 0, 0, 0); add_zero(js, w2b, 1024, 256, 192, 64); }
    set_ffn(P.ffn2[1], ws, in[5] + FW, in[6] + FW, in[7] + FW);
    hipMemsetAsync((char*)d_ws + WS_BAR, 0, 16384, stream);
    void* args[] = {&P};
    hipError_t e = hipLaunchCooperativeKernel((const void*)mega_fwd, dim3(grid), dim3(NTHREADS), args, LDS_BYTES, stream);
    if (e != hipSuccess) fprintf(stderr, "cooperative launch failed: %s (grid %d)\n", hipGetErrorString(e), grid);
}

#ifdef PHASE_TEST
#define TK(name, ...) __global__ void __launch_bounds__(NTHREADS, 2) name(Params P) { extern __shared__ __attribute__((aligned(16))) unsigned char lds_raw[]; LAS unsigned char* lds = (LAS unsigned char*)lds_raw; unsigned char* ws = P.ws; const int wv = __builtin_amdgcn_readfirstlane(threadIdx.x >> 6); __VA_ARGS__ }
TK(t_jobs, run_jobs(wv, P.js[0].cj, P.js[0].ncj, P.js[0].zj, P.js[0].nzj, lds); p0_misc(wv, P, lds);)
TK(t_row, row_phase(wv, 1, P.out, (const bf16_t*)(ws + WS_Y), P.in[1], 0.5f, P.in[1] + DM, P.out, (bf16_t*)(ws + WS_A), 1);)
TK(t_swiglu, { EpiSwiglu e{(bf16_t*)(ws + WS_H)}; GEMM_RUN(EpiSwiglu, e, ws + WS_A, ws + WS_WGU, MTOK, 2 * DFF, DM, DM, 0, 0); })
TK(t_f32, { EpiF32 e{(float*)(ws + WS_Y), DM}; GEMM_RUN(EpiF32, e, ws + WS_H, ws + WS_WD, MTOK, DM, DFF, DFF, 0, 0); })
TK(t_win, { EpiWin e{ws, P.in[17]};
              GEMM_RUN(EpiWin, e, ws + WS_A, ws + WS_WIN, MTOK, 4096, DM, DM, 0, 0); })
TK(t_conv, conv_phase(wv, P);)
TK(t_cmpfin, cmp_finish_phase(wv, P);)
TK(t_sstates, ssd_states_phase(wv, P, lds);)
TK(t_sscan, ssd_scan_phase(wv, P);)
TK(t_sout, ssd_out_phase(wv, P, lds);)
TK(t_nsa, nsa_phase(wv, P, lds);)
TK(t_rw1, { EpiRwkv1 e{ws}; GEMM_RUN(EpiRwkv1, e, ws + WS_A, ws + WS_WG1, MTOK, 3584, 2048, DM, DM * 2, 0); })
TK(t_rw2, { EpiRwkv2 e{(_Float16*)(ws + WS_LD), (bf16_t*)(ws + WS_AA), P.in[27], P.in[30]}; GEMM_RUN(EpiRwkv2, e, ws + WS_LH, ws + WS_W2A, MTOK, 2048, 128, 512, 0, 0); })
TK(t_bf16, { EpiBf16 e{(bf16_t*)(ws + WS_G), DM}; GEMM_RUN(EpiBf16, e, (bf16_t*)(ws + WS_LH) + 128, ws + WS_W2B, MTOK, DM, 256, 512, 0, 0); })
TK(t_scan, rwkv_scan_phase(wv, P, lds);)
TK(t_rpost, rwkv_post_phase(wv, P);)
#endif
```

```cpp
#include <hip/hip_runtime.h>
#include <hip/hip_cooperative_groups.h>
#include <cstdio>
#include <cstdint>
#include <cstring>
namespace cg = cooperative_groups;

#define LAS __attribute__((address_space(3)))
typedef unsigned short bf16_t;
typedef short bf16x8 __attribute__((ext_vector_type(8)));
typedef short s16x4 __attribute__((ext_vector_type(4)));
typedef float f32x4 __attribute__((ext_vector_type(4)));
typedef float f32x2 __attribute__((ext_vector_type(2)));
typedef float f32x16 __attribute__((ext_vector_type(16)));
typedef unsigned u32x4 __attribute__((ext_vector_type(4)));
typedef unsigned u32x2 __attribute__((ext_vector_type(2)));
typedef __bf16 bf16x2_t __attribute__((ext_vector_type(2)));
typedef _Float16 h16x2 __attribute__((ext_vector_type(2)));
#define DI __device__ __forceinline__

constexpr int NB = 2, SEQ = 8192, MTOK = NB * SEQ, DM = 1024, DFF = 2816;
constexpr int NTHREADS = 512, NWAVES = 8;
constexpr int LDS_BYTES = 147456;
constexpr size_t MiB = 1u << 20;
constexpr size_t WS_WGU = 0, WS_WD = 11 * MiB;
constexpr size_t WS_MIX = 17 * MiB;
constexpr size_t WS_WIN = WS_MIX, WS_WOUT = WS_MIX + 8 * MiB, WS_W1K = WS_MIX + 11 * MiB, WS_W1V = WS_W1K + MiB / 2;
constexpr size_t WS_WG1 = WS_MIX, WS_WO = WS_MIX + 14 * MiB, WS_W2A = WS_MIX + 16 * MiB, WS_W2B = WS_W2A + MiB / 2;
constexpr size_t WS_ROPE = 35 * MiB;
constexpr size_t WS_GATES = 37 * MiB;
constexpr size_t WS_DT = WS_GATES + 3 * MiB / 2;
constexpr size_t WS_PK = 40 * MiB, WS_PV = 42 * MiB;
constexpr size_t WS_KCC = 44 * MiB, WS_VCCT = WS_KCC + MiB / 4;
constexpr size_t WS_CDEC = WS_KCC + MiB / 2;
constexpr size_t WS_PEB = WS_CDEC + 64 * 1024;
constexpr size_t WS_RK = 45 * MiB;
constexpr size_t WS_BAR = 46 * MiB;
constexpr size_t WS_A = 47 * MiB;
constexpr size_t WS_BIG = 80 * MiB;
constexpr size_t WS_H = WS_BIG, WS_Y = WS_BIG + 88 * MiB;
constexpr size_t WS_Q = WS_BIG, WS_KCN = WS_BIG + 16 * MiB, WS_VCN = WS_KCN + 4 * MiB, WS_KS = WS_VCN + 4 * MiB, WS_VST = WS_KS + 4 * MiB,
                 WS_KW = WS_VST + 4 * MiB, WS_VWT = WS_KW + 4 * MiB, WS_Z = WS_BIG + 40 * MiB, WS_XBC = WS_BIG + 72 * MiB, WS_OCAT = WS_XBC,
                 WS_BM = WS_BIG + 120 * MiB, WS_BMT = WS_BM + 8 * MiB, WS_CM = WS_BMT + 8 * MiB, WS_ST = WS_BIG + 144 * MiB;
constexpr size_t WS_XS = WS_A;
constexpr size_t WS_YMIX0 = WS_BIG;
constexpr size_t WS_R = WS_BIG, WS_K = WS_BIG + 32 * MiB, WS_V = WS_BIG + 64 * MiB, WS_LH = WS_BIG + 96 * MiB, WS_LD = WS_BIG + 112 * MiB,
                 WS_AA = WS_BIG + 144 * MiB, WS_YS = WS_A, WS_G = WS_LD, WS_A2 = WS_R, WS_YMIX1 = WS_K;
static_assert(WS_ST + 32 * MiB <= 256 * MiB && WS_AA + 32 * MiB <= 256 * MiB && WS_Y + 64 * MiB <= 256 * MiB, "ws map");

DI unsigned pk2(float lo, float hi) { f32x2 v = {lo, hi}; bf16x2_t b = __builtin_convertvector(v, bf16x2_t); return __builtin_bit_cast(unsigned, b); }
DI float bf2f(unsigned short u) { return __uint_as_float(((unsigned)u) << 16); }
DI float bflo(unsigned u) { return __uint_as_float(u << 16); }
DI float bfhi(unsigned u) { return __uint_as_float(u & 0xffff0000u); }
DI float sigmoidf_(float x) { return 1.f / (1.f + __expf(-x)); }
DI float siluf_(float x) { return x / (1.f + __expf(-x)); }
DI float softplusf_(float x) { return fmaxf(x, 0.f) + log1pf(expf(-fabsf(x))); }
DI float softplus_fast(float x) { return fmaxf(x, 0.f) + __logf(1.f + __expf(-fabsf(x))); }
DI float tanh_fast(float x) { const float e = __expf(2.f * x); return 1.f - 2.f / (e + 1.f); }
DI int tid_fresh(int wv) { int l; asm volatile("v_mbcnt_lo_u32_b32 %0, -1, 0\n\tv_mbcnt_hi_u32_b32 %0, -1, %0" : "=v"(l)); return wv * 64 + l; }
DI unsigned char* ws_fresh(unsigned char* w) { asm volatile("" : "+s"(w)); return w; }
DI int crow(int r, int hi) { return (r & 3) + 8 * (r >> 2) + 4 * hi; }
template <int CTRL> DI float dpp_f(float v) { return __builtin_bit_cast(float, __builtin_amdgcn_update_dpp(0, __builtin_bit_cast(int, v), CTRL, 0xf, 0xf, true)); }
DI float wave_sum(float v) {
    v += dpp_f<0xB1>(v); v += dpp_f<0x4E>(v); v += dpp_f<0x141>(v); v += dpp_f<0x140>(v);
    { auto r = __builtin_amdgcn_permlane16_swap(__float_as_uint(v), __float_as_uint(v), false, false); v = __uint_as_float(r[0]) + __uint_as_float(r[1]); }
    { auto r = __builtin_amdgcn_permlane32_swap(__float_as_uint(v), __float_as_uint(v), false, false); v = __uint_as_float(r[0]) + __uint_as_float(r[1]); }
    return v;
}
DI float quad_sum(float v) { v += dpp_f<0xB1>(v); v += dpp_f<0x4E>(v); return v; }
DI float xhalf(float v) { return __shfl_xor(v, 32); }
DI float xmax32(float v) { auto r = __builtin_amdgcn_permlane32_swap(__float_as_uint(v), __float_as_uint(v), false, false); return fmaxf(__uint_as_float(r[0]), __uint_as_float(r[1])); }
DI float xsum32(float v) { auto r = __builtin_amdgcn_permlane32_swap(__float_as_uint(v), __float_as_uint(v), false, false); return __uint_as_float(r[0]) + __uint_as_float(r[1]); }
DI float xother32(float v, int hh) { auto r = __builtin_amdgcn_permlane32_swap(__float_as_uint(v), __float_as_uint(v), false, false); return __uint_as_float(hh ? r[0] : r[1]); }
#define EXP2(x) __builtin_amdgcn_exp2f(x)
#define MFMA32(a, b, c) __builtin_amdgcn_mfma_f32_32x32x16_bf16((a), (b), (c), 0, 0, 0)

namespace pg8 {
constexpr int BM = 256, BK = 64, HALF = 128, HTB = HALF * BK * 2, STAGE_BYTES = 8 * HTB, NXCD = 8, WGM = 8;
DI int lds_byte(int r, int c) { const int st = (r >> 4) * 2 + (c >> 5), rr = r & 15, cc = c & 31, ob = rr * 64 + cc * 2; return st * 1024 + (ob ^ (((ob >> 9) & 1) << 5)); }
DI void stage_rc(int b, int& R, int& C) { const int st = b / 1024, sb = b % 1024, swz = sb ^ (((sb >> 9) & 1) << 5); R = (st >> 1) * 16 + swz / 64; C = (st & 1) * 32 + (swz % 64) / 2; }
DI int perm32(int rho) { const int n = rho >> 4, i = rho & 15; return 8 * (i >> 2) + 4 * n + (i & 3); }
struct Unit { int pm, pn; };
struct Gemm { const bf16_t* A; const bf16_t* Bt; int M, N, K; int lda; int padA; };
struct StaticOrder {
    int nM, nN, nwg, G, c;
    DI void init(int M, int N, int G_, int c_) { nM = M / BM; nN = N / BM; nwg = nM * nN; G = G_; c = c_; }
    DI bool next(int i, Unit& u) const {
        const long L = (long)i * G + c; if (L >= nwg) return false;
        int wgid = (int)L; { const int q = nwg / NXCD, r = nwg % NXCD, xcd = wgid % NXCD, off = wgid / NXCD; wgid = (xcd < r ? xcd * (q + 1) : r * (q + 1) + (xcd - r) * q) + off; }
        const int nig = WGM * nN, gid = wgid / nig, fm = gid * WGM, gsz = (nM - fm) < WGM ? (nM - fm) : WGM;
        u.pm = fm + ((wgid % nig) % gsz); u.pn = (wgid % nig) / gsz; return true;
    }
};
template <class Epi>
DI void gemm_phase(int wv, LAS unsigned char* lds, const Gemm g, const StaticOrder& S, const Epi& E) {
    const int tid = tid_fresh(wv), wid = __builtin_amdgcn_readfirstlane(tid >> 6), lane = tid & 63, wr = wid >> 2, wc = wid & 3, fr = lane & 15, fq = lane >> 4;
    const int K = g.K, nt = K / BK, lda = g.lda;
    unsigned voffA[2], voffB[2];
#pragma unroll
    for (int i = 0; i < 2; ++i) { int R, C; stage_rc(tid * 16 + i * 8192, R, C); const int Rb = (R & ~31) + perm32(R & 31);
        voffA[i] = (unsigned)(R * lda + C) * 2u; voffB[i] = (unsigned)(Rb * K + C) * 2u; }
    const size_t kstep = (size_t)(BK * 2);
    const size_t hA = (size_t)HALF * lda * 2, hB = (size_t)HALF * K * 2, tA = 2 * hA, tB = 2 * hB;
    const unsigned ldsw = (unsigned)wid * 1024u;
    const int aoff = lds_byte(wr * 64 + fr, fq * 8), boff = lds_byte(wc * 32 + fr, fq * 8);
#define PG8_SA(b, h) (((b) * 2 + (h)) * HTB)
#define PG8_SB(b, h) ((4 + (b) * 2 + (h)) * HTB)
#define PG8_STAGE(bufoff, gbase, voff) do { _Pragma("unroll") for (int _i = 0; _i < 2; ++_i) \
        __builtin_amdgcn_global_load_lds((const unsigned*)((const char*)(gbase) + (voff)[_i]), (LAS unsigned*)(lds + (bufoff) + ldsw + _i * 8192), 16, 0, 0); } while (0)
#define PG8_LDA(dst, b, h) do { _Pragma("unroll") for (int m = 0; m < 4; ++m) _Pragma("unroll") for (int k = 0; k < 2; ++k) dst[m][k] = *(const LAS bf16x8*)(lds + PG8_SA(b, h) + aoff + m * 2048 + k * 1024); } while (0)
#define PG8_LDB(dst, b, h) do { _Pragma("unroll") for (int n = 0; n < 2; ++n) _Pragma("unroll") for (int k = 0; k < 2; ++k) dst[n][k] = *(const LAS bf16x8*)(lds + PG8_SB(b, h) + boff + n * 2048 + k * 1024); } while (0)
#define PG8_MMA(ai, bj, At, Bt) do { __builtin_amdgcn_s_setprio(1); _Pragma("unroll") for (int m = 0; m < 4; ++m) _Pragma("unroll") for (int n = 0; n < 2; ++n) _Pragma("unroll") for (int k = 0; k < 2; ++k) \
        acc[ai][bj][m][n] = __builtin_amdgcn_mfma_f32_16x16x32_bf16(Bt[n][k], At[m][k], acc[ai][bj][m][n], 0, 0, 0); __builtin_amdgcn_s_setprio(0); } while (0)
#define PG8_WAIT_V(n) asm volatile("s_waitcnt vmcnt(" #n ")" ::: "memory")
#define PG8_WAIT_L(n) asm volatile("s_waitcnt lgkmcnt(" #n ")" ::: "memory")
#define PG8_BAR __builtin_amdgcn_s_barrier()
#define PG8_SCHED __builtin_amdgcn_sched_barrier(0)
#define PG8_ABASE(u) ((const char*)g.A + (size_t)(u).pm * tA + (size_t)((u).pm >> 5) * (size_t)g.padA)
    Unit cur, nxt; int ui = 0;
    if (!S.next(0, cur)) return;
    f32x4 acc[2][2][4][2];
#pragma unroll
    for (int a = 0; a < 2; ++a)
#pragma unroll
        for (int b = 0; b < 2; ++b)
#pragma unroll
            for (int m = 0; m < 4; ++m)
#pragma unroll
                for (int n = 0; n < 2; ++n) acc[a][b][m][n] = (f32x4){0.f, 0.f, 0.f, 0.f};
    bf16x8 At[4][2], B0[2][2], B1[2][2];
    const char* cA = PG8_ABASE(cur); const char* cB = (const char*)g.Bt + (size_t)cur.pn * tB;
    PG8_STAGE(PG8_SB(0, 0), cB, voffB); PG8_STAGE(PG8_SB(0, 1), cB + hB, voffB); PG8_STAGE(PG8_SA(0, 0), cA, voffA); PG8_STAGE(PG8_SA(0, 1), cA + hA, voffA);
    if (wr == 1) PG8_BAR;
    PG8_WAIT_V(2); PG8_BAR;
    PG8_STAGE(PG8_SB(1, 0), cB + kstep, voffB); PG8_STAGE(PG8_SA(1, 0), cA + kstep, voffA); PG8_STAGE(PG8_SB(1, 1), cB + hB + kstep, voffB);
    PG8_WAIT_V(6); PG8_BAR;
    for (;;) {
        const bool has_next = S.next(ui + 1, nxt);
        const char* nA = has_next ? PG8_ABASE(nxt) : cA; const char* nB = has_next ? (const char*)g.Bt + (size_t)nxt.pn * tB : cB;
#pragma unroll 1
        for (int t = 0; t < nt; t += 2) {
            const bool last = (t == nt - 2);
            const char* a1 = cA + (size_t)(t + 1) * kstep;
            const char* a2 = last ? nA : cA + (size_t)(t + 2) * kstep; const char* b2 = last ? nB : cB + (size_t)(t + 2) * kstep;
            const char* a3 = a2 + kstep; const char* b3 = b2 + kstep;
            PG8_LDB(B0, 0, 0); PG8_LDB(B1, 0, 1); PG8_SCHED; PG8_LDA(At, 0, 0); PG8_STAGE(PG8_SA(1, 1), a1 + hA, voffA);
            PG8_WAIT_V(8); PG8_WAIT_L(0); PG8_BAR; PG8_MMA(0, 0, At, B0); PG8_MMA(0, 1, At, B1); PG8_BAR; PG8_SCHED;
            PG8_LDA(At, 0, 1); PG8_STAGE(PG8_SB(0, 0), b2, voffB); PG8_STAGE(PG8_SB(0, 1), b2 + hB, voffB); PG8_STAGE(PG8_SA(0, 0), a2, voffA);
            PG8_WAIT_V(8); PG8_WAIT_L(0); PG8_BAR; PG8_MMA(1, 0, At, B0); PG8_MMA(1, 1, At, B1); PG8_BAR; PG8_SCHED;
            PG8_LDB(B0, 1, 0); PG8_LDB(B1, 1, 1); PG8_SCHED; PG8_LDA(At, 1, 0); PG8_STAGE(PG8_SA(0, 1), a2 + hA, voffA);
            PG8_WAIT_V(8); PG8_WAIT_L(0); PG8_BAR; PG8_MMA(0, 0, At, B0); PG8_MMA(0, 1, At, B1); PG8_BAR; PG8_SCHED;
            PG8_LDA(At, 1, 1); PG8_STAGE(PG8_SB(1, 0), b3, voffB); PG8_STAGE(PG8_SB(1, 1), b3 + hB, voffB); PG8_STAGE(PG8_SA(1, 0), a3, voffA);
            PG8_WAIT_V(8); PG8_WAIT_L(0); PG8_BAR; PG8_MMA(1, 0, At, B0); PG8_MMA(1, 1, At, B1); PG8_BAR; PG8_SCHED;
        }
        if (wr == 0) PG8_BAR;
        { int fr2 = fr, fq2 = fq; asm volatile("" : "+v"(fr2), "+v"(fq2)); E(acc, cur, wr, wc, fr2, fq2); }
        if (!has_next) break;
#pragma unroll
        for (int a = 0; a < 2; ++a)
#pragma unroll
            for (int b = 0; b < 2; ++b)
#pragma unroll
                for (int m = 0; m < 4; ++m)
#pragma unroll
                    for (int n = 0; n < 2; ++n) acc[a][b][m][n] = (f32x4){0.f, 0.f, 0.f, 0.f};
        cur = nxt; cA = nA; cB = nB; ++ui;
        if (wr == 1) PG8_BAR;
    }
    PG8_WAIT_V(0);
    PG8_BAR;
#undef PG8_SA
#undef PG8_SB
#undef PG8_STAGE
#undef PG8_LDA
#undef PG8_LDB
#undef PG8_MMA
#undef PG8_WAIT_V
#undef PG8_WAIT_L
#undef PG8_BAR
#undef PG8_SCHED
#undef PG8_ABASE
}
}
using pg8::Unit;
typedef f32x4 Acc[2][2][4][2];

#define EPI_ROWS(...) _Pragma("unroll") for (int ai = 0; ai < 2; ++ai) _Pragma("unroll") for (int m = 0; m < 4; ++m) { const int row = u.pm * 256 + ai * 128 + wr * 64 + m * 16 + fr; __VA_ARGS__ }
DI void st16_wt(void* p, u32x4 v) { asm volatile("global_store_dwordx4 %0, %1, off sc0 sc1\n\ts_nop 1" :: "v"(p), "v"(v) : "memory"); }
DI u32x4 pack8(f32x4 a, f32x4 b) { u32x4 w; w.x = pk2(a[0], a[1]); w.y = pk2(a[2], a[3]); w.z = pk2(b[0], b[1]); w.w = pk2(b[2], b[3]); return w; }

struct EpiF32 {
    float* O; int ldc;
    DI void operator()(const Acc& acc, const Unit& u, int wr, int wc, int fr, int fq) const {
        const int c0 = u.pn * 256 + wc * 32 + 8 * fq;
        EPI_ROWS( float* rp = O + (size_t)row * ldc + c0;
            _Pragma("unroll") for (int bj = 0; bj < 2; ++bj) { *(f32x4*)(rp + bj * 128) = acc[ai][bj][m][0]; *(f32x4*)(rp + bj * 128 + 4) = acc[ai][bj][m][1]; } )
    }
};
struct EpiBf16 {
    bf16_t* O; int ldc;
    DI void operator()(const Acc& acc, const Unit& u, int wr, int wc, int fr, int fq) const {
        const int c0 = u.pn * 256 + wc * 32 + 8 * fq;
        EPI_ROWS( bf16_t* rp = O + (size_t)row * ldc + c0;
            _Pragma("unroll") for (int bj = 0; bj < 2; ++bj) st16_wt(rp + bj * 128, pack8(acc[ai][bj][m][0], acc[ai][bj][m][1])); )
    }
};
struct EpiSwiglu {
    bf16_t* H;
    DI void operator()(const Acc& acc, const Unit& u, int wr, int wc, int fr, int fq) const {
        const int c0 = u.pn * 128 + wc * 32 + 8 * fq;
        EPI_ROWS( f32x4 a, b;
            _Pragma("unroll") for (int e = 0; e < 4; ++e) { a[e] = siluf_(acc[ai][0][m][0][e]) * acc[ai][1][m][0][e]; b[e] = siluf_(acc[ai][0][m][1][e]) * acc[ai][1][m][1][e]; }
            st16_wt(H + (size_t)row * DFF + c0, pack8(a, b)); )
    }
};
#define TS_(e) { const unsigned w0_ = pk2(ta0[e], ta1[e]); vt[(size_t)(e) * SEQ] = (bf16_t)(w0_ & 0xffff); vt[(size_t)((e) + 4) * SEQ] = (bf16_t)(w0_ >> 16); }
#define GV_(n, e) { const int c_ = cb + 4 * (n) + (e); const float v_ = (n) ? tb1[e] : tb0[e]; if (c_ < 24) GATES[(size_t)row * 24 + c_] = sigmoidf_(v_); else if (c_ < 40) DT[(size_t)row * 16 + c_ - 24] = softplus_fast(v_ + dt_bias[c_ - 24]); }
struct EpiWin {
    unsigned char* ws; const float* dt_bias;
    DI void operator()(const Acc& acc, const Unit& u, int wr, int wc, int fr, int fq) const {
        const int pn = u.pn;
        bf16_t* const Q = (bf16_t*)(ws + WS_Q); bf16_t* const VCN = (bf16_t*)(ws + WS_VCN); bf16_t* const VST = (bf16_t*)(ws + WS_VST); bf16_t* const VWT = (bf16_t*)(ws + WS_VWT);
        float* const GATES = (float*)(ws + WS_GATES); float* const DT = (float*)(ws + WS_DT); const float* const cosT = (const float*)(ws + WS_ROPE); const float* const sinT = cosT + SEQ * 32;
        if (pn <= 3) {
            if (pn == 3 && wc >= 2) return;
            const int d0 = 8 * fq;
            EPI_ROWS( const int t = row & (SEQ - 1), b = row >> 13;
                const f32x4 c0 = *(const f32x4*)(cosT + t * 32 + d0), c1 = *(const f32x4*)(cosT + t * 32 + d0 + 4);
                const f32x4 s0 = *(const f32x4*)(sinT + t * 32 + d0), s1 = *(const f32x4*)(sinT + t * 32 + d0 + 4);
                const f32x4 x10 = acc[ai][0][m][0], x11 = acc[ai][0][m][1], x20 = acc[ai][1][m][0], x21 = acc[ai][1][m][1];
                f32x4 o10 = x10 * c0 - x20 * s0, o11 = x11 * c1 - x21 * s1, o20 = x20 * c0 + x10 * s0, o21 = x21 * c1 + x11 * s1;
                bf16_t* dst;
                if (pn < 2) { const float qs = 0.125f * 1.4426950408889634f; o10 *= qs; o11 *= qs; o20 *= qs; o21 *= qs; dst = Q + (size_t)row * 512 + (pn * 4 + wc) * 64; }
                else { const size_t boff = (pn == 2) ? (wc < 2 ? WS_KCN : WS_KS) : WS_KW; dst = (bf16_t*)(ws + boff) + ((size_t)(b * 2 + (wc & 1)) * SEQ + t) * 64; }
                *(u32x4*)(dst + d0) = pack8(o10, o11); *(u32x4*)(dst + 32 + d0) = pack8(o20, o21); asm volatile("" ::: "memory"); )
        } else if (pn == 4 || pn == 5) {
            const int h = wc >> 1, d0 = (wc & 1) * 32 + 8 * fq;
            EPI_ROWS( const int t = row & (SEQ - 1), b = row >> 13;
                if (pn == 4) *(u32x4*)(VCN + ((size_t)(b * 2 + h) * SEQ + t) * 64 + d0) = pack8(acc[ai][0][m][0], acc[ai][0][m][1]);
                if (pn == 4) { bf16_t* vt = VST + ((size_t)(b * 2 + h) * 64 + d0) * SEQ + t; const f32x4 ta0 = acc[ai][1][m][0], ta1 = acc[ai][1][m][1]; TS_(0) TS_(1) TS_(2) TS_(3) }
                else { bf16_t* vt = VWT + ((size_t)(b * 2 + h) * 64 + d0) * SEQ + t; const f32x4 ta0 = acc[ai][0][m][0], ta1 = acc[ai][0][m][1]; TS_(0) TS_(1) TS_(2) TS_(3)
                  const int cb = wc * 32 + 8 * fq; const f32x4 tb0 = acc[ai][1][m][0], tb1 = acc[ai][1][m][1];
                  if (cb < 40) { GV_(0, 0) GV_(0, 1) GV_(0, 2) GV_(0, 3) GV_(1, 0) GV_(1, 1) GV_(1, 2) GV_(1, 3) } } )
        } else {
            bf16_t* O = (bf16_t*)(ws + ((pn < 10) ? WS_Z : WS_XBC)); const int ldc = (pn < 10) ? 1024 : 1536; const int c0 = (pn < 10 ? (pn - 6) : (pn - 10)) * 256 + wc * 32 + 8 * fq;
            EPI_ROWS( bf16_t* rp = O + (size_t)row * ldc + c0;
                _Pragma("unroll") for (int bj = 0; bj < 2; ++bj) st16_wt(rp + bj * 128, pack8(acc[ai][bj][m][0], acc[ai][bj][m][1])); )
        }
    }
};
struct EpiRwkv1 {
    unsigned char* ws;
    DI void operator()(const Acc& acc, const Unit& u, int wr, int wc, int fr, int fq) const {
        const int pn = u.pn; bf16_t* const LH = (bf16_t*)(ws + WS_LH);
        if (pn < 12) { bf16_t* O = (bf16_t*)(ws + (pn < 4 ? WS_R : (pn < 8 ? WS_K : WS_V))); const int c0 = (pn & 3) * 256 + wc * 32 + 8 * fq;
            EPI_ROWS( bf16_t* rp = O + (size_t)row * 1024 + c0;
                _Pragma("unroll") for (int bj = 0; bj < 2; ++bj) st16_wt(rp + bj * 128, pack8(acc[ai][bj][m][0], acc[ai][bj][m][1])); )
        } else {
            EPI_ROWS( _Pragma("unroll") for (int bj = 0; bj < 2; ++bj) { const int c0 = (pn - 12) * 256 + bj * 128 + wc * 32 + 8 * fq; f32x4 a = acc[ai][bj][m][0], b = acc[ai][bj][m][1];
                    if (c0 < 64) { _Pragma("unroll") for (int e = 0; e < 4; ++e) { a[e] = tanh_fast(a[e]); b[e] = tanh_fast(b[e]); } }
                    else if (c0 >= 128) { _Pragma("unroll") for (int e = 0; e < 4; ++e) { a[e] = sigmoidf_(a[e]); b[e] = sigmoidf_(b[e]); } }
                    *(u32x4*)(LH + (size_t)row * 512 + c0) = pack8(a, b); } )
        }
    }
};
struct EpiRwkv2 {
    _Float16* LD; bf16_t* AA; const float *w0, *a0;
    DI void operator()(const Acc& acc, const Unit& u, int wr, int wc, int fr, int fq) const {
        const int pn = u.pn;
        EPI_ROWS( _Pragma("unroll") for (int bj = 0; bj < 2; ++bj) { const int c0 = (pn & 3) * 256 + bj * 128 + wc * 32 + 8 * fq;
                if (pn < 4) { u32x4 o;
                    _Pragma("unroll") for (int n = 0; n < 2; ++n) _Pragma("unroll") for (int e2 = 0; e2 < 2; ++e2) {
                        const float wa = -softplus_fast(-(w0[c0 + 4 * n + 2 * e2] + acc[ai][bj][m][n][2 * e2])) - 0.5f, wb = -softplus_fast(-(w0[c0 + 4 * n + 2 * e2 + 1] + acc[ai][bj][m][n][2 * e2 + 1])) - 0.5f;
                        h16x2 hv = {(_Float16)(-__expf(wa)), (_Float16)(-__expf(wb))}; o[2 * n + e2] = __builtin_bit_cast(unsigned, hv); }
                    *(u32x4*)(LD + (size_t)row * 1024 + c0) = o;
                } else { f32x4 a, b;
                    _Pragma("unroll") for (int e = 0; e < 4; ++e) { a[e] = sigmoidf_(a0[c0 + e] + acc[ai][bj][m][0][e]); b[e] = sigmoidf_(a0[c0 + 4 + e] + acc[ai][bj][m][1][e]); }
                    *(u32x4*)(AA + (size_t)row * 1024 + c0) = pack8(a, b); } } )
    }
};

struct CvtJob { const float* src; const float* scale; bf16_t* dst; int ldw, K, N, ldk, koff, mode, rowoff, smode; };
struct ZeroJob { bf16_t* dst; int rows, ldk, c0, nc; int pad; };
constexpr int MAXJ = 20, MAXZ = 8;
struct JobSet { CvtJob cj[MAXJ]; ZeroJob zj[MAXZ]; int ncj, nzj; };
struct Params {
    const float* in[40]; float* out; unsigned char* ws;
    JobSet js[2];
    CvtJob ffn2[2][3];
};

DI int win_rowmap(int c) {
    if (c < 512) { const int hq = c >> 6, d = c & 63; return (hq >> 2) * 256 + (d < 32 ? 0 : 128) + (hq & 3) * 32 + (d & 31); }
    if (c < 1280) { const int seg = (c - 512) >> 7, cc = (c - 512) & 127, h = cc >> 6, d = cc & 63;
        if (seg == 0 || seg == 2 || seg == 4) { const int tile = (seg == 4) ? 3 : 2, hl = (seg == 2 ? 2 : 0) + h; return tile * 256 + (d < 32 ? 0 : 128) + hl * 32 + (d & 31); }
        if (seg == 1) return 1024 + cc; if (seg == 3) return 1024 + 128 + cc; return 1280 + cc; }
    if (c < 1304) return 1280 + 128 + (c - 1280);
    if (c < 2328) return 1536 + (c - 1304);
    if (c < 3864) return 2560 + (c - 2328);
    return 1280 + 128 + 24 + (c - 3864);
}
DI void cvt_item(const CvtJob& J, int item, LAS float* scr, int lane) {
    const int nblk = (J.N + 31) >> 5, kb = item / nblk, nb = item % nblk, k0 = 64 * kb, n0 = 32 * nb;
#pragma unroll 8
    for (int i = 0; i < 32; ++i) { const int kk = 2 * i + (lane >> 5), k = k0 + kk, n = n0 + (lane & 31);
        float v = 0.f; if (k < J.K && n < J.N) { v = J.src[(size_t)k * J.ldw + n]; if (J.smode == 1) v *= J.scale[k]; else if (J.smode == 2) v *= (1.f - J.scale[k]); }
        scr[kk * 33 + (lane & 31)] = v; }
    asm volatile("s_waitcnt lgkmcnt(0)" ::: "memory");
    const int c = lane & 7;
#pragma unroll
    for (int j = 0; j < 4; ++j) { const int nl = (lane >> 3) + 8 * j, n = n0 + nl; const LAS float* s = scr + (8 * c) * 33 + nl;
        if (n < J.N) { u32x4 o; o.x = pk2(s[0], s[33]); o.y = pk2(s[2 * 33], s[3 * 33]); o.z = pk2(s[4 * 33], s[5 * 33]); o.w = pk2(s[6 * 33], s[7 * 33]);
            int row; if (J.mode == 0) row = J.rowoff + n; else if (J.mode == 1) row = (n >> 7) * 256 + (n & 127) + J.rowoff; else row = win_rowmap(n);
            *(u32x4*)(J.dst + (size_t)row * J.ldk + J.koff + k0 + 8 * c) = o; } }
    asm volatile("s_waitcnt lgkmcnt(0)" ::: "memory");
}
DI void run_jobs(int wv, const CvtJob* cjs, int ncj, const ZeroJob* zjs, int nzj, LAS unsigned char* lds) {
    const int tid_ = tid_fresh(wv);
    const int lane = tid_ & 63, wave = tid_ >> 6, gw = blockIdx.x * NWAVES + wave, NGW = gridDim.x * NWAVES;
    LAS float* scr = (LAS float*)(lds + wave * 16384);
    int base = 0;
    for (int j = 0; j < ncj; ++j) { const CvtJob& J = cjs[j]; const int nit = ((J.K + 63) >> 6) * ((J.N + 31) >> 5);
        int first = (gw - base) % NGW; if (first < 0) first += NGW;
        for (int it = first; it < nit; it += NGW) cvt_item(J, it, scr, lane);
        base = (base + nit) % NGW; }
    const int gt = blockIdx.x * NTHREADS + tid_, NGT = gridDim.x * NTHREADS;
    for (int j = 0; j < nzj; ++j) { const ZeroJob& Z = zjs[j]; const int per = Z.nc >> 3, tot = Z.rows * per;
        for (int i = gt; i < tot; i += NGT) { const int r = i / per, c = (i % per) * 8; *(u32x4*)(Z.dst + (size_t)r * Z.ldk + Z.c0 + c) = (u32x4){0u, 0u, 0u, 0u}; } }
}

DI void row_phase(int wv, int mode, const float* X, const bf16_t* Y, const float* ga, float coef, const float* gb, float* Xout, bf16_t* A, int a_pad) {
    const int tid_ = tid_fresh(wv);
    const int lane = tid_ & 63, gw = blockIdx.x * NWAVES + (tid_ >> 6), NGW = gridDim.x * NWAVES;
    for (int r = gw; r < MTOK; r += NGW) {
        f32x4 v[4];
#pragma unroll
        for (int j = 0; j < 4; ++j) v[j] = *(const f32x4*)(X + (size_t)r * DM + 4 * lane + 256 * j);
        if (mode == 1) { f32x4 y[4]; float s = 0.f;
#pragma unroll
            for (int j = 0; j < 4; ++j) { const u32x2 yv = *(const u32x2*)(Y + (size_t)r * DM + 4 * lane + 256 * j); y[j] = (f32x4){bflo(yv.x), bfhi(yv.x), bflo(yv.y), bfhi(yv.y)}; s += y[j][0] * y[j][0] + y[j][1] * y[j][1] + y[j][2] * y[j][2] + y[j][3] * y[j][3]; }
            const float rs = coef * rsqrtf(wave_sum(s) * (1.f / DM) + 1e-6f);
#pragma unroll
            for (int j = 0; j < 4; ++j) { const f32x4 gg = *(const f32x4*)(ga + 4 * lane + 256 * j); v[j] += y[j] * gg * rs; } }
        if (Xout) {
#pragma unroll
            for (int j = 0; j < 4; ++j) st16_wt(Xout + (size_t)r * DM + 4 * lane + 256 * j, __builtin_bit_cast(u32x4, v[j])); }
        if (gb) { float s = 0.f;
#pragma unroll
            for (int j = 0; j < 4; ++j) s += v[j][0] * v[j][0] + v[j][1] * v[j][1] + v[j][2] * v[j][2] + v[j][3] * v[j][3];
            const float rs = rsqrtf(wave_sum(s) * (1.f / DM) + 1e-6f);
            const size_t ar = a_pad ? (size_t)(r + (r >> 13) + 1) : (size_t)r;
#pragma unroll
            for (int j = 0; j < 4; ++j) { const f32x4 gg = *(const f32x4*)(gb + 4 * lane + 256 * j); const f32x4 o = v[j] * gg * rs;
                u32x2 w; w.x = pk2(o[0], o[1]); w.y = pk2(o[2], o[3]); *(u32x2*)(A + ar * DM + 4 * lane + 256 * j) = w; } }
    }
    if (a_pad && gb) { const int gt = blockIdx.x * NTHREADS + tid_; if (gt < 256) { const int b = gt >> 7, c = (gt & 127) * 8; *(u32x4*)(A + (size_t)b * (SEQ + 1) * DM + c) = (u32x4){0u, 0u, 0u, 0u}; } }
}

DI void p0_misc(int wv, const Params& P, LAS unsigned char* lds) {
    unsigned char* const ws_ = ws_fresh(P.ws);
    const int tid_ = tid_fresh(wv);
    float* cosT = (float*)(ws_ + WS_ROPE); float* sinT = cosT + SEQ * 32;
    const int gt = blockIdx.x * NTHREADS + tid_, NGT = gridDim.x * NTHREADS;
    for (int i = gt; i < SEQ * 32; i += NGT) { const int t = i >> 5, k = i & 31; const float inv = powf(10000.f, -(float)(2 * k) / 64.f); const float ang = (float)t * inv; cosT[i] = cosf(ang); sinT[i] = sinf(ang); }
    if (blockIdx.x < 2) {
        const float* pe = P.in[blockIdx.x == 0 ? 9 : 12]; const float* w1 = P.in[blockIdx.x == 0 ? 10 : 13];
        LAS float* red = (LAS float*)lds; const int j = tid_ & 63, part = tid_ >> 6; float s = 0.f;
        for (int k = part; k < 2048; k += 8) s += pe[k] * w1[k * 64 + j];
        red[part * 64 + j] = s; __syncthreads();
        if (tid_ < 64) { float t = 0.f; for (int p = 0; p < 8; ++p) t += red[p * 64 + j]; ((float*)(ws_ + WS_PEB))[blockIdx.x * 64 + j] = t; }
        __syncthreads();
    }
}

DI void conv_phase(int wv, const Params& P) {
    unsigned char* const ws_ = ws_fresh(P.ws);
    const int tid_ = tid_fresh(wv);
    const bf16_t* XBC = (const bf16_t*)(ws_ + WS_XBC); bf16_t* XS = (bf16_t*)(ws_ + WS_XS); bf16_t* BM = (bf16_t*)(ws_ + WS_BM); bf16_t* BMT = (bf16_t*)(ws_ + WS_BMT); bf16_t* CM = (bf16_t*)(ws_ + WS_CM);
    const float* cw = P.in[15]; const float* cb = P.in[16];
    const int skipb = (gridDim.x > 32) ? 16 : 0;
    if ((int)blockIdx.x < skipb) return;
    const int gt = ((int)blockIdx.x - skipb) * NTHREADS + tid_, NGT = ((int)gridDim.x - skipb) * NTHREADS;
    for (int it = gt; it < (MTOK / 8) * 192; it += NGT) {
        const int tt = it / 192, cg8 = it % 192, c0 = cg8 * 8, r0 = tt * 8, t0 = r0 & (SEQ - 1), b = r0 >> 13;
        float w[4][8], bias[8];
#pragma unroll
        for (int k = 0; k < 4; ++k) { const f32x4 a = *(const f32x4*)(cw + k * 1536 + c0), bq = *(const f32x4*)(cw + k * 1536 + c0 + 4);
#pragma unroll
            for (int e = 0; e < 4; ++e) { w[k][e] = a[e]; w[k][4 + e] = bq[e]; } }
        { const f32x4 a = *(const f32x4*)(cb + c0), bq = *(const f32x4*)(cb + c0 + 4);
#pragma unroll
          for (int e = 0; e < 4; ++e) { bias[e] = a[e]; bias[4 + e] = bq[e]; } }
        float x[11][8];
#pragma unroll
        for (int i = 0; i < 11; ++i) { u32x4 q = (u32x4){0u, 0u, 0u, 0u}; if (i >= 3 || t0 != 0) q = *(const u32x4*)(XBC + (size_t)(r0 + i - 3) * 1536 + c0);
#pragma unroll
            for (int e = 0; e < 4; ++e) { x[i][2 * e] = bflo(q[e]); x[i][2 * e + 1] = bfhi(q[e]); } }
        unsigned o[8][4];
#pragma unroll
        for (int i = 0; i < 8; ++i) { float y[8];
#pragma unroll
            for (int e = 0; e < 8; ++e) { float s = bias[e];
#pragma unroll
                for (int k = 0; k < 4; ++k) s += w[k][e] * x[i + k][e];
                y[e] = siluf_(s); }
#pragma unroll
            for (int e = 0; e < 4; ++e) o[i][e] = pk2(y[2 * e], y[2 * e + 1]); }
        if (c0 < 1024) {
#pragma unroll
            for (int i = 0; i < 8; ++i) *(u32x4*)(XS + (size_t)(r0 + i) * 1024 + c0) = (u32x4){o[i][0], o[i][1], o[i][2], o[i][3]};
        } else if (c0 < 1280) { const int cc = c0 - 1024, g = cc >> 7, n0 = cc & 127;
#pragma unroll
            for (int i = 0; i < 8; ++i) *(u32x4*)(BM + (size_t)(r0 + i) * 256 + cc) = (u32x4){o[i][0], o[i][1], o[i][2], o[i][3]};
#pragma unroll
            for (int e = 0; e < 8; ++e) { u32x4 q;
#pragma unroll
                for (int i2 = 0; i2 < 4; ++i2) { const unsigned lo = (o[2 * i2][e >> 1] >> ((e & 1) * 16)) & 0xffffu, hi = (o[2 * i2 + 1][e >> 1] >> ((e & 1) * 16)) & 0xffffu; q[i2] = lo | (hi << 16); }
                *(u32x4*)(BMT + ((size_t)(b * 2 + g) * 128 + n0 + e) * SEQ + t0) = q; }
        } else { const int cc = c0 - 1280;
#pragma unroll
            for (int i = 0; i < 8; ++i) *(u32x4*)(CM + (size_t)(r0 + i) * 256 + cc) = (u32x4){o[i][0], o[i][1], o[i][2], o[i][3]};
        }
    }
}

DI void cmp_finish_phase(int wv, const Params& P) {
    unsigned char* const ws_ = ws_fresh(P.ws);
    const int tid_ = tid_fresh(wv);
    const int lane = tid_ & 63, gw = blockIdx.x * NWAVES + (tid_ >> 6), NGW = gridDim.x * NWAVES;
    bf16_t* KCC = (bf16_t*)(ws_ + WS_KCC); bf16_t* VCCT = (bf16_t*)(ws_ + WS_VCCT); const float* peb = (const float*)(ws_ + WS_PEB);
    for (int r = gw; r < 4096; r += NGW) {
        const int kv = r >> 11, bh = (r >> 9) & 3, n = r & 511;
        const float* PP = (const float*)(ws_ + (kv ? WS_PV : WS_PK)); const float* w2 = P.in[kv ? 14 : 11];
        float out = 0.f;
        if (n < 511) {
            const float pre = PP[(size_t)(bh * 512 + n) * 256 + lane] + PP[(size_t)(bh * 512 + n + 1) * 256 + 64 + lane] + peb[kv * 64 + lane];
            const float hid = siluf_(pre);
#pragma unroll 8
            for (int i = 0; i < 64; ++i) out += __shfl(hid, i) * w2[i * 64 + lane];
        }
        const bf16_t ob = (bf16_t)(pk2(out, 0.f) & 0xffff);
        if (kv == 0) KCC[(size_t)(bh * 512 + n) * 64 + lane] = ob; else VCCT[(size_t)(bh * 64 + lane) * 512 + n] = ob;
    }
}

DI void ssd_acs(const float* DT, int row0, int h, float a, LAS float* acs, int lane) {
    float v0 = DT[(size_t)(row0 + lane) * 16 + h] * a, v1 = DT[(size_t)(row0 + 64 + lane) * 16 + h] * a;
#pragma unroll
    for (int o = 1; o < 64; o <<= 1) { const float t0 = __shfl_up(v0, o), t1 = __shfl_up(v1, o); if (lane >= o) { v0 += t0; v1 += t1; } }
    const float tot0 = __shfl(v0, 63);
    acs[lane] = v0; acs[64 + lane] = v1 + tot0;
    asm volatile("s_waitcnt lgkmcnt(0)" ::: "memory");
}
constexpr int XT_LD = 136;
DI void ssd_states_phase(int wv, const Params& P, LAS unsigned char* lds) {
    unsigned char* const ws_ = ws_fresh(P.ws);
    const int tid_ = tid_fresh(wv);
    const int lane = tid_ & 63, wave = tid_ >> 6, q = lane & 31, hh = lane >> 5;
    const float* DT = (const float*)(ws_ + WS_DT); const bf16_t* XS = (const bf16_t*)(ws_ + WS_XS); const bf16_t* BMT = (const bf16_t*)(ws_ + WS_BMT);
    bf16_t* ST = (bf16_t*)(ws_ + WS_ST); float* CDEC = (float*)(ws_ + WS_CDEC);
    LAS bf16_t* xt = (LAS bf16_t*)(lds + wave * (64 * XT_LD * 2));
    LAS float* acs = (LAS float*)(lds + 8 * 64 * XT_LD * 2 + wave * 512);
    for (int u = blockIdx.x; u < 256; u += gridDim.x) {
        const int b = u >> 7, c = (u >> 1) & 63, g = u & 1, h = g * 8 + wave, row0 = b * SEQ + c * 128;
        const float a = -expf(P.in[18][h]);
        ssd_acs(DT, row0, h, a, acs, lane);
        const float alast = acs[127];
        if (lane == 0) CDEC[(b * 64 + c) * 16 + h] = expf(alast);
        for (int it = lane; it < 1024; it += 64) { const int l = it >> 3, pg = (it & 7) * 8; const float sc = DT[(size_t)(row0 + l) * 16 + h] * expf(alast - acs[l]);
            const u32x4 v = *(const u32x4*)(XS + (size_t)(row0 + l) * 1024 + h * 64 + pg);
#pragma unroll
            for (int e = 0; e < 4; ++e) { const unsigned w = pk2(bflo(v[e]) * sc, bfhi(v[e]) * sc); xt[(pg + 2 * e) * XT_LD + l] = (bf16_t)(w & 0xffff); xt[(pg + 2 * e + 1) * XT_LD + l] = (bf16_t)(w >> 16); } }
        asm volatile("s_waitcnt lgkmcnt(0)" ::: "memory");
        f32x16 acc[4][2];
#pragma unroll
        for (int i = 0; i < 4; ++i) { acc[i][0] = f32x16{}; acc[i][1] = f32x16{}; }
        const bf16_t* bt = BMT + ((size_t)(b * 2 + g) * 128 + q) * SEQ + c * 128 + 8 * hh;
#pragma unroll 2
        for (int ks = 0; ks < 8; ++ks) {
            bf16x8 bf[2];
#pragma unroll
            for (int pt = 0; pt < 2; ++pt) bf[pt] = *(const LAS bf16x8*)(xt + (pt * 32 + q) * XT_LD + ks * 16 + 8 * hh);
#pragma unroll
            for (int nt = 0; nt < 4; ++nt) { const bf16x8 af = *(const bf16x8*)(bt + (size_t)nt * 32 * SEQ + ks * 16);
                acc[nt][0] = MFMA32(af, bf[0], acc[nt][0]); acc[nt][1] = MFMA32(af, bf[1], acc[nt][1]); }
        }
        bf16_t* st = ST + ((size_t)((b * 64 + c) * 16 + h) * 64) * 128;
#pragma unroll
        for (int nt = 0; nt < 4; ++nt)
#pragma unroll
            for (int pt = 0; pt < 2; ++pt)
#pragma unroll
                for (int i4 = 0; i4 < 4; ++i4) { u32x2 w; w.x = pk2(acc[nt][pt][4 * i4], acc[nt][pt][4 * i4 + 1]); w.y = pk2(acc[nt][pt][4 * i4 + 2], acc[nt][pt][4 * i4 + 3]);
                    *(u32x2*)(st + (size_t)(pt * 32 + q) * 128 + nt * 32 + 8 * i4 + 4 * hh) = w; }
        asm volatile("s_waitcnt lgkmcnt(0)" ::: "memory");
    }
}
DI void ssd_scan_phase(int wv, const Params& P) {
    unsigned char* const ws_ = ws_fresh(P.ws);
    const int tid_ = tid_fresh(wv);
    bf16_t* ST = (bf16_t*)(ws_ + WS_ST); const float* CDEC = (const float*)(ws_ + WS_CDEC);
    const int gt = blockIdx.x * NTHREADS + tid_, NGT = gridDim.x * NTHREADS;
    for (int e = gt; e < 2 * 16 * 64 * 64; e += NGT) {
        const int b = e >> 16, h = (e >> 12) & 15, pn2 = e & 4095; float c0 = 0.f, c1 = 0.f;
#pragma unroll 8
        for (int c = 0; c < 64; ++c) { unsigned* p = (unsigned*)(ST + ((size_t)((b * 64 + c) * 16 + h) * 64) * 128) + pn2; const unsigned s = *p; const float d = CDEC[(b * 64 + c) * 16 + h];
            *p = pk2(c0, c1); c0 = c0 * d + bflo(s); c1 = c1 * d + bfhi(s); }
    }
}
DI void ssd_out_phase(int wv, const Params& P, LAS unsigned char* lds) {
    unsigned char* const ws_ = ws_fresh(P.ws);
    const int tid_ = tid_fresh(wv);
    const int lane = tid_ & 63, wave = tid_ >> 6, q = lane & 31, hh = lane >> 5;
    const float* DT = (const float*)(ws_ + WS_DT); const bf16_t* XS = (const bf16_t*)(ws_ + WS_XS); const bf16_t* BM = (const bf16_t*)(ws_ + WS_BM); const bf16_t* CM = (const bf16_t*)(ws_ + WS_CM);
    const bf16_t* ST = (const bf16_t*)(ws_ + WS_ST); const bf16_t* Z = (const bf16_t*)(ws_ + WS_Z); bf16_t* OCAT = (bf16_t*)(ws_ + WS_OCAT);
    constexpr int XH_LD = 72;
    LAS bf16_t* cbl = (LAS bf16_t*)lds;
    LAS bf16_t* xt = (LAS bf16_t*)(lds + 128 * XT_LD * 2 + wave * (64 * XH_LD * 2));
    LAS float* acs = (LAS float*)(lds + 128 * XT_LD * 2 + 8 * 64 * XH_LD * 2 + wave * 512);
    LAS float* ssq = (LAS float*)(lds + 128 * XT_LD * 2 + 8 * 64 * XH_LD * 2 + 4096);
    for (int u = blockIdx.x; u < 256; u += gridDim.x) {
        const int b = u >> 7, c = (u >> 1) & 63, g = u & 1, h = g * 8 + wave, row0 = b * SEQ + c * 128;
        __syncthreads();
        { const int st_ = wave >> 1;
#pragma unroll
          for (int li = 0; li < 2; ++li) { const int lt = 2 * (wave & 1) + li; f32x16 d = f32x16{};
#pragma unroll
            for (int ks = 0; ks < 8; ++ks) { const bf16x8 af = *(const bf16x8*)(BM + (size_t)(row0 + st_ * 32 + q) * 256 + g * 128 + ks * 16 + 8 * hh);
                const bf16x8 bfr = *(const bf16x8*)(CM + (size_t)(row0 + lt * 32 + q) * 256 + g * 128 + ks * 16 + 8 * hh); d = MFMA32(af, bfr, d); }
#pragma unroll
            for (int i4 = 0; i4 < 4; ++i4) { u32x2 w; w.x = pk2(d[4 * i4], d[4 * i4 + 1]); w.y = pk2(d[4 * i4 + 2], d[4 * i4 + 3]);
                *(LAS u32x2*)(cbl + (lt * 32 + q) * XT_LD + st_ * 32 + 8 * i4 + 4 * hh) = w; } } }
        const float a = -expf(P.in[18][h]);
        ssd_acs(DT, row0, h, a, acs, lane);
        __syncthreads();
        f32x16 acc[2][4];
#pragma unroll
        for (int i = 0; i < 2; ++i)
#pragma unroll
            for (int j = 0; j < 4; ++j) acc[i][j] = f32x16{};
        { const bf16_t* st = ST + ((size_t)((b * 64 + c) * 16 + h) * 64) * 128;
#pragma unroll 2
          for (int ks = 0; ks < 8; ++ks) { bf16x8 af[2];
#pragma unroll
            for (int pt = 0; pt < 2; ++pt) af[pt] = *(const bf16x8*)(st + (size_t)(pt * 32 + q) * 128 + ks * 16 + 8 * hh);
#pragma unroll
            for (int lt = 0; lt < 4; ++lt) { const bf16x8 bfr = *(const bf16x8*)(CM + (size_t)(row0 + lt * 32 + q) * 256 + g * 128 + ks * 16 + 8 * hh);
                acc[0][lt] = MFMA32(af[0], bfr, acc[0][lt]); acc[1][lt] = MFMA32(af[1], bfr, acc[1][lt]); } } }
        float acl[4];
#pragma unroll
        for (int lt = 0; lt < 4; ++lt) { acl[lt] = acs[lt * 32 + q]; const float e = expf(acl[lt]);
#pragma unroll
            for (int i = 0; i < 16; ++i) { acc[0][lt][i] *= e; acc[1][lt][i] *= e; } }
#pragma unroll 1
        for (int sh = 0; sh < 2; ++sh) {
            for (int it = lane; it < 512; it += 64) { const int s = it >> 3, pg = (it & 7) * 8; const int sg = sh * 64 + s; const float sc = DT[(size_t)(row0 + sg) * 16 + h];
                const u32x4 v = *(const u32x4*)(XS + (size_t)(row0 + sg) * 1024 + h * 64 + pg);
#pragma unroll
                for (int e = 0; e < 4; ++e) { const unsigned w = pk2(bflo(v[e]) * sc, bfhi(v[e]) * sc); xt[(pg + 2 * e) * XH_LD + s] = (bf16_t)(w & 0xffff); xt[(pg + 2 * e + 1) * XH_LD + s] = (bf16_t)(w >> 16); } }
            asm volatile("s_waitcnt lgkmcnt(0)" ::: "memory");
#pragma unroll 1
            for (int ks = 0; ks < 4; ++ks) { const int s0 = sh * 64 + ks * 16 + 8 * hh;
                bf16x8 af[2];
#pragma unroll
                for (int pt = 0; pt < 2; ++pt) af[pt] = *(const LAS bf16x8*)(xt + (pt * 32 + q) * XH_LD + ks * 16 + 8 * hh);
                float as8[8];
#pragma unroll
                for (int j = 0; j < 8; ++j) as8[j] = acs[s0 + j];
#pragma unroll
                for (int lt = 0; lt < 4; ++lt) { if (lt * 32 + 31 < sh * 64 + ks * 16) continue;
                    const int l = lt * 32 + q; const u32x4 cv = *(const LAS u32x4*)(cbl + l * XT_LD + s0); float mv[8];
#pragma unroll
                    for (int j = 0; j < 4; ++j) { mv[2 * j] = bflo(cv[j]); mv[2 * j + 1] = bfhi(cv[j]); }
#pragma unroll
                    for (int j = 0; j < 8; ++j) mv[j] = (s0 + j <= l) ? mv[j] * __expf(acl[lt] - as8[j]) : 0.f;
                    u32x4 pw; pw.x = pk2(mv[0], mv[1]); pw.y = pk2(mv[2], mv[3]); pw.z = pk2(mv[4], mv[5]); pw.w = pk2(mv[6], mv[7]);
                    const bf16x8 bfr = __builtin_bit_cast(bf16x8, pw);
                    acc[0][lt] = MFMA32(af[0], bfr, acc[0][lt]); acc[1][lt] = MFMA32(af[1], bfr, acc[1][lt]); } }
            asm volatile("s_waitcnt lgkmcnt(0)" ::: "memory");
        }
        const float dsk = P.in[19][h];
#pragma unroll
        for (int lt = 0; lt < 4; ++lt) { const size_t rr = (size_t)(row0 + lt * 32 + q); float ss = 0.f;
#pragma unroll
            for (int pt = 0; pt < 2; ++pt)
#pragma unroll
                for (int i4 = 0; i4 < 4; ++i4) { const int p0 = h * 64 + pt * 32 + 8 * i4 + 4 * hh; const u32x2 xv = *(const u32x2*)(XS + rr * 1024 + p0), zv = *(const u32x2*)(Z + rr * 1024 + p0);
                    const float xs4[4] = {bflo(xv.x), bfhi(xv.x), bflo(xv.y), bfhi(xv.y)}, zs4[4] = {bflo(zv.x), bfhi(zv.x), bflo(zv.y), bfhi(zv.y)};
#pragma unroll
                    for (int e = 0; e < 4; ++e) { const float y = (acc[pt][lt][4 * i4 + e] + xs4[e] * dsk) * siluf_(zs4[e]); acc[pt][lt][4 * i4 + e] = y; ss += y * y; } }
            ss += xhalf(ss); if (hh == 0) ssq[wave * 128 + lt * 32 + q] = ss; }
        __syncthreads();
        const float* nw = P.in[20];
#pragma unroll
        for (int lt = 0; lt < 4; ++lt) { float tot = 0.f;
#pragma unroll
            for (int w = 0; w < 8; ++w) tot += ssq[w * 128 + lt * 32 + q];
            const float rs = rsqrtf(tot * (1.f / 512.f) + 1e-5f); const size_t rr = (size_t)(row0 + lt * 32 + q);
#pragma unroll
            for (int pt = 0; pt < 2; ++pt)
#pragma unroll
                for (int i4 = 0; i4 < 4; ++i4) { const int p0 = h * 64 + pt * 32 + 8 * i4 + 4 * hh; const f32x4 nv = *(const f32x4*)(nw + p0);
                    u32x2 w; w.x = pk2(acc[pt][lt][4 * i4] * rs * nv[0], acc[pt][lt][4 * i4 + 1] * rs * nv[1]); w.y = pk2(acc[pt][lt][4 * i4 + 2] * rs * nv[2], acc[pt][lt][4 * i4 + 3] * rs * nv[3]);
                    *(u32x2*)(OCAT + rr * 1536 + 512 + p0) = w; } }
    }
    __syncthreads();
}

struct AttnState { float m, l; f32x16 o[2]; };
DI void qk_tile(f32x16& s, const bf16_t* K, int key0, const bf16x8* qf, int q, int hh) {
    const bf16_t* kp = K + (size_t)(key0 + q) * 64 + 8 * hh; s = f32x16{};
#pragma unroll
    for (int ks = 0; ks < 4; ++ks) { const bf16x8 af = *(const bf16x8*)(kp + 16 * ks); s = MFMA32(af, qf[ks], s); }
}
DI void pv_tile(f32x16* o, const float* p, const bf16_t* VT, int ldv, int key0, int q, int hh) {
#pragma unroll
    for (int s = 0; s < 2; ++s) { u32x4 pw; pw.x = pk2(p[8 * s], p[8 * s + 1]); pw.y = pk2(p[8 * s + 2], p[8 * s + 3]); pw.z = pk2(p[8 * s + 4], p[8 * s + 5]); pw.w = pk2(p[8 * s + 6], p[8 * s + 7]);
        const bf16x8 pf = __builtin_bit_cast(bf16x8, pw);
#pragma unroll
        for (int dt = 0; dt < 2; ++dt) { const bf16_t* vp = VT + (size_t)(dt * 32 + q) * ldv + key0 + 16 * s + 4 * hh; const u32x2 lo = *(const u32x2*)vp, hi = *(const u32x2*)(vp + 8);
            const u32x4 av = (u32x4){lo.x, lo.y, hi.x, hi.y}; o[dt] = MFMA32(__builtin_bit_cast(bf16x8, av), pf, o[dt]); } }
}
DI void attn_step(AttnState& st, const f32x16& s, unsigned vmask, const bf16_t* VT, int ldv, int key0, int q, int hh) {
    float mx = -1e30f;
#pragma unroll
    for (int i = 0; i < 16; ++i) if ((vmask >> i) & 1u) mx = fmaxf(mx, s[i]);
    mx = fmaxf(mx, xhalf(mx));
    const float mn = fmaxf(st.m, mx), al = __expf(st.m - mn); st.m = mn; st.l *= al;
#pragma unroll
    for (int i = 0; i < 16; ++i) { st.o[0][i] *= al; st.o[1][i] *= al; }
    float p[16]; float sum = 0.f;
#pragma unroll
    for (int i = 0; i < 16; ++i) { p[i] = ((vmask >> i) & 1u) ? __expf(s[i] - mn) : 0.f; sum += p[i]; }
    st.l += sum;
    pv_tile(st.o, p, VT, ldv, key0, q, hh);
}
constexpr int KT_LD = 72, VT_LD = 136, STG_KEYS = 128, STG_K_BYTES = STG_KEYS * KT_LD * 2, STAGE_BYTES_A = STG_K_BYTES + 64 * VT_LD * 2;
template <bool MASKED>
DI void attn_step_l(AttnState& st, const LAS bf16_t* Kt, const LAS bf16_t* Vt, const bf16x8* qf, unsigned vmask, bool mine, int q, int hh) {
    f32x16 s = f32x16{};
#pragma unroll
    for (int ks = 0; ks < 4; ++ks) { const bf16x8 af = *(const LAS bf16x8*)(Kt + q * KT_LD + 16 * ks + 8 * hh); s = MFMA32(af, qf[ks], s); }
    if (MASKED) {
#pragma unroll
        for (int i = 0; i < 16; ++i) s[i] = ((vmask >> i) & 1u) ? s[i] : -1e30f; }
    float mx = fmaxf(fmaxf(s[0], s[1]), fmaxf(s[2], s[3]));
#pragma unroll
    for (int i = 4; i < 16; i += 4) mx = fmaxf(mx, fmaxf(fmaxf(s[i], s[i + 1]), fmaxf(s[i + 2], s[i + 3])));
    if (!MASKED) mx = mine ? mx : -1e30f;
    mx = xmax32(mx);
    if (__builtin_amdgcn_ballot_w64(mx > st.m) != 0ull) { const float mn = fmaxf(st.m, mx), al = EXP2(st.m - mn); st.m = mn; st.l *= al;
#pragma unroll
        for (int i = 0; i < 16; ++i) { st.o[0][i] *= al; st.o[1][i] *= al; } }
    const float c = (MASKED || mine) ? fmaxf(st.m, -1e29f) : 1e30f;
    float p[16]; float sum = 0.f;
#pragma unroll
    for (int i = 0; i < 16; ++i) { p[i] = EXP2(s[i] - c); sum += p[i]; }
    st.l += sum;
#pragma unroll
    for (int s2 = 0; s2 < 2; ++s2) { u32x4 pw; pw.x = pk2(p[8 * s2], p[8 * s2 + 1]); pw.y = pk2(p[8 * s2 + 2], p[8 * s2 + 3]); pw.z = pk2(p[8 * s2 + 4], p[8 * s2 + 5]); pw.w = pk2(p[8 * s2 + 6], p[8 * s2 + 7]);
        const bf16x8 pf = __builtin_bit_cast(bf16x8, pw);
#pragma unroll
        for (int dt = 0; dt < 2; ++dt) { const LAS bf16_t* vp = Vt + (dt * 32 + q) * VT_LD + 16 * s2 + 4 * hh; const u32x2 lo = *(const LAS u32x2*)vp, hi = *(const LAS u32x2*)(vp + 8);
            const u32x4 av = (u32x4){lo.x, lo.y, hi.x, hi.y}; st.o[dt] = MFMA32(__builtin_bit_cast(bf16x8, av), pf, st.o[dt]); } }
}
DI void nsa_phase(int wv, const Params& P, LAS unsigned char* lds) {
    const int tid_ = tid_fresh(wv);
    unsigned char* const ws_ = ws_fresh(P.ws);
    const int lane = tid_ & 63, wave = tid_ >> 6, q = lane & 31, hh = lane >> 5, tok = q >> 2, g = q & 3;
    const bf16_t* Q = (const bf16_t*)(ws_ + WS_Q); const bf16_t* KCC = (const bf16_t*)(ws_ + WS_KCC); const bf16_t* VCCT = (const bf16_t*)(ws_ + WS_VCCT);
    const bf16_t* KS = (const bf16_t*)(ws_ + WS_KS); const bf16_t* VST = (const bf16_t*)(ws_ + WS_VST); const bf16_t* KW = (const bf16_t*)(ws_ + WS_KW); const bf16_t* VWT = (const bf16_t*)(ws_ + WS_VWT);
    const float* GATES = (const float*)(ws_ + WS_GATES); bf16_t* OCAT = (bf16_t*)(ws_ + WS_OCAT);
    LAS float* imp = (LAS float*)(lds + wave * 4096);
    LAS unsigned long long* selm = (LAS unsigned long long*)(lds + 32768 + wave * 128);
    LAS unsigned char* tiles = lds + 36864;
    const int ldr = tid_ & 255, isV = tid_ >> 8;
    const int nunits = 512, NG = gridDim.x;
    for (int uu = blockIdx.x; uu < nunits; uu += NG) {
        const int pass = uu / NG, idx = uu - pass * NG; int gi = uu; if ((nunits % (2 * NG)) == 0 && (pass & 1)) gi = pass * NG + (NG - 1 - idx);
        int bh = gi >> 7, tg = gi & 127;
        if (NG == 256) { const int xq = blockIdx.x & 7, jq = (xq & 1) * 32 + (blockIdx.x >> 3); bh = xq >> 1; tg = pass ? 127 - jq : jq; }
        const int b = bh >> 1, hkv = bh & 1, t0b = tg * 64, t0 = t0b + 8 * wave, t = t0 + tok, head = hkv * 4 + g;
        const size_t row = (size_t)b * SEQ + t;
        bf16x8 qf[4];
#pragma unroll
        for (int ks = 0; ks < 4; ++ks) qf[ks] = *(const bf16x8*)(Q + row * 512 + head * 64 + 16 * ks + 8 * hh);
        const float g0 = GATES[row * 24 + head * 3 + 0], g1 = GATES[row * 24 + head * 3 + 1], g2 = GATES[row * 24 + head * 3 + 2];
        f32x16 out[2]; out[0] = f32x16{}; out[1] = f32x16{};
        for (int i = lane; i < 1024; i += 64) imp[i] = 0.f;
        const int nvmax = (t0 + 7 >= 31) ? ((t0 + 7 - 31) >> 4) + 1 : 0, nvt = (t >= 31) ? ((t - 31) >> 4) + 1 : 0, ntile = (nvmax + 31) >> 5;
        const bf16_t* Kc = KCC + (size_t)bh * 512 * 64; const bf16_t* VcT = VCCT + (size_t)bh * 64 * 512;
        float m = -1e30f, l = 0.f;
        bf16x8 kf[4], kn[4];
#define CMP_KLOAD(dst_, kt_) _Pragma("unroll") for (int ks = 0; ks < 4; ++ks) dst_[ks] = *(const bf16x8*)(Kc + (size_t)((kt_) * 32 + q) * 64 + 8 * hh + 16 * ks)
#define CMP_QK(s_) do { s_ = f32x16{}; _Pragma("unroll") for (int ks = 0; ks < 4; ++ks) s_ = MFMA32(kf[ks], qf[ks], s_); } while (0)
        if (ntile > 0) { CMP_KLOAD(kf, 0); }
        for (int kt = 0; kt < ntile; ++kt) { if (kt + 1 < ntile) { CMP_KLOAD(kn, kt + 1); }
            f32x16 s; CMP_QK(s); float mx = -1e30f;
#pragma unroll
            for (int i = 0; i < 16; ++i) if (kt * 32 + crow(i, hh) < nvt) mx = fmaxf(mx, s[i]);
            mx = xmax32(mx); const float mn = fmaxf(m, mx); l *= EXP2(m - mn); m = mn;
#pragma unroll
            for (int i = 0; i < 16; ++i) if (kt * 32 + crow(i, hh) < nvt) l += EXP2(s[i] - mn);
#pragma unroll
            for (int ks = 0; ks < 4; ++ks) kf[ks] = kn[ks]; }
        l = xsum32(l);
        const float invl = l > 0.f ? 1.f / l : 0.f;
        { f32x16 o[2]; o[0] = f32x16{}; o[1] = f32x16{}; float carry = 0.f;
          if (ntile > 0) { CMP_KLOAD(kf, 0); }
          for (int kt = 0; kt < ntile; ++kt) { if (kt + 1 < ntile) { CMP_KLOAD(kn, kt + 1); }
            f32x16 s; CMP_QK(s); float p[16];
#pragma unroll
            for (int i = 0; i < 16; ++i) p[i] = (kt * 32 + crow(i, hh) < nvt) ? EXP2(s[i] - m) * invl : 0.f;
            pv_tile(o, p, VcT, 512, kt * 32, q, hh);
            float G4[4], oL[4];
#pragma unroll
            for (int rr = 0; rr < 4; ++rr) { G4[rr] = (p[4 * rr] + p[4 * rr + 1]) + (p[4 * rr + 2] + p[4 * rr + 3]); oL[rr] = xother32(p[4 * rr + 3], hh); }
#pragma unroll
            for (int rr = 0; rr < 4; ++rr) { const float prev = hh ? oL[rr] : (rr ? oL[rr > 0 ? rr - 1 : 0] : carry); const float v = quad_sum(G4[rr] + prev);
                if (g == 0) imp[tok * 128 + kt * 8 + 2 * rr + hh] = v; }
            carry = oL[3];
#pragma unroll
            for (int ks = 0; ks < 4; ++ks) kf[ks] = kn[ks]; }
#undef CMP_KLOAD
#undef CMP_QK
#pragma unroll
          for (int i = 0; i < 16; ++i) { out[0][i] += g0 * o[0][i]; out[1][i] += g0 * o[1][i]; } }
        asm volatile("s_waitcnt lgkmcnt(0)" ::: "memory");
        for (int tk = 0; tk < 8; ++tk) { const int tt = t0 + tk, cur = tt >> 6; unsigned long long mlo, mhi;
            if (cur + 1 <= 16) { mlo = (1ull << (cur + 1)) - 1ull; mhi = 0ull; }
            else { const int j0 = lane, j1 = lane + 64;
                const float s0 = imp[tk * 128 + j0], s1 = imp[tk * 128 + j1];
                const unsigned k0 = (j0 > cur) ? 0u : ((j0 == 0 || j0 == cur || j0 == cur - 1) ? 0x7f000000u : __float_as_uint(s0) + 1u);
                const unsigned k1 = (j1 > cur) ? 0u : ((j1 == cur || j1 == cur - 1) ? 0x7f000000u : __float_as_uint(s1) + 1u);
                unsigned T = 0u;
#pragma unroll 1
                for (int bit = 30; bit >= 0; --bit) { const unsigned cand = T | (1u << bit);
                    const int cnt = __builtin_popcountll(__builtin_amdgcn_ballot_w64(k0 >= cand)) + __builtin_popcountll(__builtin_amdgcn_ballot_w64(k1 >= cand)); if (cnt >= 16) T = cand; }
                mlo = __builtin_amdgcn_ballot_w64(k0 > T); mhi = __builtin_amdgcn_ballot_w64(k1 > T);
                int need = 16 - __builtin_popcountll(mlo) - __builtin_popcountll(mhi);
                unsigned long long elo = __builtin_amdgcn_ballot_w64(k0 == T), ehi = __builtin_amdgcn_ballot_w64(k1 == T);
                while (need > 0 && elo) { const unsigned long long bb = elo & (0ull - elo); mlo |= bb; elo ^= bb; --need; }
                while (need > 0 && ehi) { const unsigned long long bb = ehi & (0ull - ehi); mhi |= bb; ehi ^= bb; --need; } }
            if (lane == 0) { selm[tk * 2] = mlo; selm[tk * 2 + 1] = mhi; } }
        asm volatile("s_waitcnt lgkmcnt(0)" ::: "memory");
        const unsigned long long mylo = selm[tok * 2], myhi = selm[tok * 2 + 1];
#pragma unroll 1
        for (int br = 0; br < 2; ++br) {
            const bf16_t* Kb = (br ? KW : KS) + (size_t)bh * SEQ * 64; const bf16_t* Vb = (br ? VWT : VST) + (size_t)bh * 64 * SEQ;
            const int ktb = br ? (((t0b - 511 > 0) ? (t0b - 511) : 0) >> 5) : 0, kte = ((t0b + 63) >> 5) + 1, nt = kte - ktb;
            const int nst = (nt + 3) >> 2;
            const bf16_t* gsrc = (isV ? (Vb + (size_t)(ldr >> 4) * SEQ + (ldr & 15) * 8) : (Kb + (size_t)(ldr >> 3) * 64 + (ldr & 7) * 8)) + (size_t)ktb * (isV ? 32 : 32 * 64);
            const size_t gj = isV ? (size_t)16 * SEQ : (size_t)32 * 64, gstage = isV ? 128 : 128 * 64;
            const int loff = isV ? (STG_K_BYTES + (ldr >> 4) * VT_LD * 2 + (ldr & 15) * 16) : ((ldr >> 3) * KT_LD * 2 + (ldr & 7) * 16), lj = isV ? 16 * VT_LD * 2 : 32 * KT_LD * 2;
            AttnState st; st.m = -1e30f; st.l = 0.f; st.o[0] = f32x16{}; st.o[1] = f32x16{};
            u32x4 pre[4];
#define NSA_LOAD(si_) _Pragma("unroll") for (int j_ = 0; j_ < 4; ++j_) pre[j_] = *(const u32x4*)(gsrc + (size_t)(si_) * gstage + j_ * gj)
#define NSA_STORE(buf_) _Pragma("unroll") for (int j_ = 0; j_ < 4; ++j_) *(LAS u32x4*)(tiles + (buf_) * STAGE_BYTES_A + loff + j_ * lj) = pre[j_]
            NSA_LOAD(0); NSA_STORE(0);
            if (nst > 1) { NSA_LOAD(1); }
            __syncthreads();
#pragma unroll 1
            for (int si = 0; si < nst; ++si) { const int cur = si & 1;
                if (si + 1 < nst) { NSA_STORE(cur ^ 1); if (si + 2 < nst) { NSA_LOAD(si + 2); } }
#pragma unroll 1
                for (int sub = 0; sub < 4; ++sub) { const int ti = si * 4 + sub; if (ti >= nt) break; const int key0 = (ktb + ti) * 32;
                    const bool rel = br ? (key0 <= t0 + 7 && key0 + 31 + 512 > t0) : (key0 <= t0 + 7);
                    if (rel) {
                        const LAS bf16_t* Kt = (const LAS bf16_t*)(tiles + cur * STAGE_BYTES_A) + sub * 32 * KT_LD; const LAS bf16_t* Vt = (const LAS bf16_t*)(tiles + cur * STAGE_BYTES_A + STG_K_BYTES) + sub * 32;
                        const int jb = key0 >> 6; const bool mine = br ? true : ((jb < 64) ? ((mylo >> jb) & 1ull) : ((myhi >> (jb - 64)) & 1ull));
                        const bool full = br ? (key0 + 31 <= t0 && key0 + 512 > t0 + 7) : (key0 + 31 <= t0);
                        if (__builtin_amdgcn_ballot_w64(mine) == 0ull) {   }
                        else if (full) attn_step_l<false>(st, Kt, Vt, qf, 0u, mine, q, hh);
                        else { unsigned vm = 0u;
                            if (br == 0) {
#pragma unroll
                                for (int e = 0; e < 16; ++e) vm |= (mine && (key0 + crow(e, hh) <= t)) ? (1u << e) : 0u; }
                            else {
#pragma unroll
                                for (int e = 0; e < 16; ++e) { const int key = key0 + crow(e, hh); vm |= (key <= t && key + 512 > t) ? (1u << e) : 0u; } }
                            attn_step_l<true>(st, Kt, Vt, qf, vm, true, q, hh); } } }
                __syncthreads(); }
#undef NSA_LOAD
#undef NSA_STORE
            const float lt = xsum32(st.l), gg = br ? g2 : g1, sc = lt > 0.f ? gg / lt : 0.f;
#pragma unroll
            for (int i = 0; i < 16; ++i) { out[0][i] += sc * st.o[0][i]; out[1][i] += sc * st.o[1][i]; }
        }
#pragma unroll
        for (int dt = 0; dt < 2; ++dt)
#pragma unroll
            for (int i4 = 0; i4 < 4; ++i4) { u32x2 w; w.x = pk2(out[dt][4 * i4], out[dt][4 * i4 + 1]); w.y = pk2(out[dt][4 * i4 + 2], out[dt][4 * i4 + 3]);
                *(u32x2*)(OCAT + row * 1536 + head * 64 + dt * 32 + 8 * i4 + 4 * hh) = w; }
    }
}

constexpr int RW_T = 32;
DI float multi4_sum(float q0, float q1, float q2, float q3, int lane) {
    const bool b0 = lane & 1, b1 = lane & 2;
    const float r01 = (b0 ? q1 : q0) + dpp_f<0xB1>(b0 ? q0 : q1);
    const float r23 = (b0 ? q3 : q2) + dpp_f<0xB1>(b0 ? q2 : q3);
    float r = (b1 ? r23 : r01) + dpp_f<0x4E>(b1 ? r01 : r23);
    r += dpp_f<0x124>(r); r += dpp_f<0x128>(r);
    { auto x = __builtin_amdgcn_permlane16_swap(__float_as_uint(r), __float_as_uint(r), false, false); r = __uint_as_float(x[0]) + __uint_as_float(x[1]); }
    { auto x = __builtin_amdgcn_permlane32_swap(__float_as_uint(r), __float_as_uint(r), false, false); r = __uint_as_float(x[0]) + __uint_as_float(x[1]); }
    return r;
}
DI float rdlane(float v, int l) { return __builtin_bit_cast(float, __builtin_amdgcn_readlane(__builtin_bit_cast(int, v), l)); }
DI float row16_sum(float v) { v += dpp_f<0xB1>(v); v += dpp_f<0x4E>(v); v += dpp_f<0x141>(v); v += dpp_f<0x140>(v); return v; }
DI void rwkv_scan_phase(int wv, const Params& P, LAS unsigned char* lds) {
    const int tid_ = tid_fresh(wv);
    unsigned char* const ws_ = ws_fresh(P.ws);
    const int lane = tid_ & 63, wave = tid_ >> 6;
    const bf16_t* R = (const bf16_t*)(ws_ + WS_R); const bf16_t* K = (const bf16_t*)(ws_ + WS_K); const bf16_t* V = (const bf16_t*)(ws_ + WS_V); const bf16_t* AA = (const bf16_t*)(ws_ + WS_AA);
    const _Float16* LD = (const _Float16*)(ws_ + WS_LD); bf16_t* YS = (bf16_t*)(ws_ + WS_YS); float* RK = (float*)(ws_ + WS_RK);
    LAS float* stg = (LAS float*)lds;
    LAS float* vst = (LAS float*)(lds + 2 * RW_T * 5 * 64 * 4);
    LAS float* ybuf = vst + 2 * RW_T * 8;
    const int nck = SEQ / RW_T;
    const int pw = wave - 2;
    for (int u = blockIdx.x; u < 256; u += gridDim.x) {
        const int ux = (gridDim.x == 256) ? (((u & 7) * 4 + (u >> 6)) * 8 + ((u >> 3) & 7)) : u;
        const int bh = ux >> 3, rg = ux & 7, b = bh >> 4, h = bh & 15;
        __syncthreads();
        if (wave >= 2) {
            const int ch = h * 64 + lane;
            const float kkw = P.in[35][ch], kaw = P.in[36][ch], rkw = P.in[37][ch];
            const int hf = lane >> 5, c2 = lane & 31, chp = h * 64 + 2 * c2;
            const f32x2 kkw2 = *(const f32x2*)(P.in[35] + chp), kaw2 = *(const f32x2*)(P.in[36] + chp), rkw2 = *(const f32x2*)(P.in[37] + chp);
            unsigned gk[3], ga[3], gr[3], gl[3]; float gv[3];
#define RW_LOADG(cn_) _Pragma("unroll") for (int i = 0; i < 3; ++i) { const int pp = pw + 6 * i; const size_t row = (size_t)b * SEQ + (cn_) * RW_T + 2 * (pp < 16 ? pp : 0) + hf; \
                gk[i] = *(const unsigned*)(K + row * 1024 + chp); ga[i] = *(const unsigned*)(AA + row * 1024 + chp); gr[i] = *(const unsigned*)(R + row * 1024 + chp); gl[i] = *(const unsigned*)(LD + row * 1024 + chp); \
                gv[i] = bf2f(V[row * 1024 + h * 64 + rg * 8 + (c2 & 7)]); }
            RW_LOADG(0)
#pragma unroll 1
            for (int ck = -1; ck <= nck; ++ck) {
                {
                    if (ck >= 1) { const LAS float* yb = ybuf + ((ck - 1) & 1) * RW_T * 128;
#pragma unroll 2
                        for (int it = pw; it < 64; it += 6) { const float y = row16_sum(yb[it * 64 + lane]);
                            const float y0 = __builtin_bit_cast(float, __builtin_amdgcn_readlane(__builtin_bit_cast(int, y), 0)), y1 = __builtin_bit_cast(float, __builtin_amdgcn_readlane(__builtin_bit_cast(int, y), 16)),
                                        y2 = __builtin_bit_cast(float, __builtin_amdgcn_readlane(__builtin_bit_cast(int, y), 32)), y3 = __builtin_bit_cast(float, __builtin_amdgcn_readlane(__builtin_bit_cast(int, y), 48));
                            if (lane == 0) { u32x2 w; w.x = pk2(y0, y1); w.y = pk2(y2, y3); *(u32x2*)(YS + ((size_t)b * SEQ + (ck - 1) * RW_T + (it >> 1)) * 1024 + h * 64 + rg * 8 + (it & 1) * 4) = w; } } }
                    if (ck + 1 < nck) { const int cn = ck + 1, buf = cn & 1;
#pragma unroll
                        for (int i = 0; i < 3; ++i) { const int pp = pw + 6 * i; if (pp < 16) { const int tt = 2 * pp + hf; const size_t row = (size_t)b * SEQ + cn * RW_T + tt;
                            const f32x2 k = {bflo(gk[i]), bfhi(gk[i])}, a = {bflo(ga[i]), bfhi(ga[i])}, r = {bflo(gr[i]), bfhi(gr[i])};
                            const h16x2 lh = __builtin_bit_cast(h16x2, gl[i]);
                            const f32x2 kr = k * kkw2, kp = k * ((a - 1.f) * kaw2 + 1.f);
                            const float sp = kr[0] * kr[0] + kr[1] * kr[1], rp = r[0] * kp[0] * rkw2[0] + r[1] * kp[1] * rkw2[1];
                            const bool odd = lane & 1;
                            float red = (odd ? rp : sp) + dpp_f<0xB1>(odd ? sp : rp);
                            red += dpp_f<0x4E>(red); red += dpp_f<0x124>(red); red += dpp_f<0x128>(red);
                            { auto x = __builtin_amdgcn_permlane16_swap(__float_as_uint(red), __float_as_uint(red), false, false); red = __uint_as_float(x[0]) + __uint_as_float(x[1]); }
                            const float oth = dpp_f<0xB1>(red); const float ss = odd ? oth : red, rks = odd ? red : oth;
                            const f32x2 kk = kr * __builtin_amdgcn_rsqf(fmaxf(ss, 1e-24f));
                            LAS float* d = stg + ((buf * RW_T + tt) * 5) * 64 + 2 * c2;
                            *(LAS f32x2*)(d) = -kk; *(LAS f32x2*)(d + 64) = (f32x2){__expf((float)lh[0]), __expf((float)lh[1])}; *(LAS f32x2*)(d + 128) = kk * a; *(LAS f32x2*)(d + 192) = kp; *(LAS f32x2*)(d + 256) = r;
                            if (rg == 0 && c2 == 0) RK[row * 16 + h] = rks;
                            if (c2 < 8) vst[(buf * RW_T + tt) * 8 + c2] = gv[i]; } }
                        if (ck + 2 < nck) { RW_LOADG(ck + 2) } }
                }
                if (ck < nck) __syncthreads();
            }
        } else {
            const int cg = lane & 15, rloc = wave * 4 + (lane >> 4);
            f32x4 S = (f32x4){0.f, 0.f, 0.f, 0.f};
            __syncthreads();
            __builtin_amdgcn_s_setprio(3);
#pragma unroll 1
            for (int ck = 0; ck < nck; ++ck) { const int buf = ck & 1;
                const LAS float* sb = stg + buf * RW_T * 5 * 64 + 4 * cg; const LAS float* vb = vst + buf * RW_T * 8 + rloc; LAS float* yb = ybuf + buf * RW_T * 128 + wave * 64 + lane;
                const unsigned sba = (unsigned)(size_t)sb, vba = (unsigned)(size_t)vb;
                f32x4 nkA, ddA, bbA, kpA, rrA, nkB, ddB, bbB, kpB, rrB; float vvA, vvB;
#define RW_LDS_LOAD(X, j_) asm volatile("ds_read_b128 %0, %6 offset:%c8\n\tds_read_b128 %1, %6 offset:%c9\n\tds_read_b128 %2, %6 offset:%c10\n\tds_read_b128 %3, %6 offset:%c11\n\tds_read_b128 %4, %6 offset:%c12\n\tds_read_b32 %5, %7 offset:%c13" \
                    : "=&v"(nk##X), "=&v"(dd##X), "=&v"(bb##X), "=&v"(kp##X), "=&v"(rr##X), "=&v"(vv##X) : "v"(sbt), "v"(vbt), "i"((j_) * 1280), "i"((j_) * 1280 + 256), "i"((j_) * 1280 + 512), "i"((j_) * 1280 + 768), "i"((j_) * 1280 + 1024), "i"((j_) * 32) : "memory")
#define RW_LDS_WAIT(X) asm volatile("s_waitcnt lgkmcnt(0)" : "+v"(nk##X), "+v"(dd##X), "+v"(bb##X), "+v"(kp##X), "+v"(rr##X), "+v"(vv##X) :: "memory")
#define SB_() __builtin_amdgcn_sched_barrier(0)
#define LO2(v_) __builtin_shufflevector(v_, v_, 0, 1)
#define HI2(v_) __builtin_shufflevector(v_, v_, 2, 3)
#define RW_STEP(X, tt_) do { \
                    f32x2 pa_ = LO2(S) * LO2(nk##X); pa_ = HI2(S) * HI2(nk##X) + pa_; float q_ = pa_[0] + pa_[1]; SB_(); \
                    q_ += dpp_f<0xB1>(q_); const f32x2 kvl_ = LO2(kp##X) * vv##X; SB_(); \
                    q_ += dpp_f<0x4E>(q_); const f32x2 kvh_ = HI2(kp##X) * vv##X; SB_(); \
                    q_ += dpp_f<0x141>(q_); const float yp_ = yacc[0] + yacc[1]; SB_(); \
                    q_ += dpp_f<0x140>(q_); if ((tt_) > 0 || tt > 0) ybt[((tt_) - 1) * 128] = yp_; SB_(); \
                    const f32x2 sl_ = LO2(S) * LO2(dd##X) + (LO2(bb##X) * q_ + kvl_), sh_ = HI2(S) * HI2(dd##X) + (HI2(bb##X) * q_ + kvh_); SB_(); \
                    yacc = sl_ * LO2(rr##X); yacc = sh_ * HI2(rr##X) + yacc; S = __builtin_shufflevector(sl_, sh_, 0, 1, 2, 3); SB_(); } while (0)
                f32x2 yacc = (f32x2){0.f, 0.f};
                unsigned sbt = sba, vbt = vba; LAS float* ybt = yb;
                RW_LDS_LOAD(A, 0); RW_LDS_WAIT(A);
#pragma unroll 1
                for (int tt = 0; tt < RW_T; tt += 8) { sbt = sba + (unsigned)tt * 1280u; vbt = vba + (unsigned)tt * 32u; ybt = yb + tt * 128;
                    RW_LDS_LOAD(B, 1); RW_STEP(A, 0); RW_LDS_WAIT(B);
                    RW_LDS_LOAD(A, 2); RW_STEP(B, 1); RW_LDS_WAIT(A);
                    RW_LDS_LOAD(B, 3); RW_STEP(A, 2); RW_LDS_WAIT(B);
                    RW_LDS_LOAD(A, 4); RW_STEP(B, 3); RW_LDS_WAIT(A);
                    RW_LDS_LOAD(B, 5); RW_STEP(A, 4); RW_LDS_WAIT(B);
                    RW_LDS_LOAD(A, 6); RW_STEP(B, 5); RW_LDS_WAIT(A);
                    RW_LDS_LOAD(B, 7); RW_STEP(A, 6); RW_LDS_WAIT(B);
                    RW_LDS_LOAD(A, 8); RW_STEP(B, 7); RW_LDS_WAIT(A);
                }
                yb[(RW_T - 1) * 128] = yacc[0] + yacc[1];
#undef SB_
#undef LO2
#undef HI2
#undef RW_LDS_LOAD
#undef RW_LDS_WAIT
#undef RW_STEP
                __syncthreads();
            }
            __builtin_amdgcn_s_setprio(0);
        }
    }
}
DI void rwkv_post_phase(int wv, const Params& P) {
    const int tid_ = tid_fresh(wv);
    unsigned char* const ws_ = ws_fresh(P.ws);
    const int lane = tid_ & 63, gw = blockIdx.x * NWAVES + (tid_ >> 6), NGW = gridDim.x * NWAVES;
    const bf16_t* YS = (const bf16_t*)(ws_ + WS_YS); const bf16_t* V = (const bf16_t*)(ws_ + WS_V); const bf16_t* G = (const bf16_t*)(ws_ + WS_G); const float* RK = (const float*)(ws_ + WS_RK);
    bf16_t* A2 = (bf16_t*)(ws_ + WS_A2); const float* lng = P.in[38]; const float* lnb = P.in[39];
    for (int r = gw; r < MTOK; r += NGW) {
#pragma unroll
        for (int it = 0; it < 2; ++it) { const int head = it * 8 + (lane >> 3), ch = head * 64 + (lane & 7) * 8; const size_t off = (size_t)r * 1024 + ch;
            const u32x4 yv = *(const u32x4*)(YS + off), vv = *(const u32x4*)(V + off), gv = *(const u32x4*)(G + off);
            float y[8], v8[8], g8[8];
#pragma unroll
            for (int e = 0; e < 4; ++e) { y[2 * e] = bflo(yv[e]); y[2 * e + 1] = bfhi(yv[e]); v8[2 * e] = bflo(vv[e]); v8[2 * e + 1] = bfhi(vv[e]); g8[2 * e] = bflo(gv[e]); g8[2 * e + 1] = bfhi(gv[e]); }
            float s = 0.f;
#pragma unroll
            for (int e = 0; e < 8; ++e) s += y[e];
            s += dpp_f<0xB1>(s); s += dpp_f<0x4E>(s); s += dpp_f<0x141>(s);
            const float mean = s * (1.f / 64.f); float q = 0.f;
#pragma unroll
            for (int e = 0; e < 8; ++e) { y[e] -= mean; q += y[e] * y[e]; }
            q += dpp_f<0xB1>(q); q += dpp_f<0x4E>(q); q += dpp_f<0x141>(q);
            const float rstd = rsqrtf(q * (1.f / 64.f) + 64e-5f), rk = RK[(size_t)r * 16 + head];
            const f32x4 l0 = *(const f32x4*)(lng + ch), l1 = *(const f32x4*)(lng + ch + 4), b0 = *(const f32x4*)(lnb + ch), b1 = *(const f32x4*)(lnb + ch + 4);
            float o[8];
#pragma unroll
            for (int e = 0; e < 8; ++e) { const float lg = e < 4 ? l0[e & 3] : l1[e & 3], lb = e < 4 ? b0[e & 3] : b1[e & 3]; o[e] = (y[e] * rstd * lg + lb + rk * v8[e]) * g8[e]; }
            u32x4 w; w.x = pk2(o[0], o[1]); w.y = pk2(o[2], o[3]); w.z = pk2(o[4], o[5]); w.w = pk2(o[6], o[7]);
            *(u32x4*)(A2 + off) = w; }
    }
}


#define XB_TMO      128
#define XB_XCNT(j)  (256  + 64 * (j))
#define XB_XSUB(j)  (1280 + 64 * (j))
#define XB_XGEN(j)  (2304 + 64 * (j))
#define XB_TOP      3328
#define XB_TOPGEN   3392
#define XCD_BAR_WORDS 3456
#define XB_SPIN_CAP (1u << 22)
DI unsigned xb_ld(unsigned* p)              { return __hip_atomic_load(p, __ATOMIC_RELAXED, __HIP_MEMORY_SCOPE_AGENT); }
DI unsigned xb_add(unsigned* p, unsigned v) { return __hip_atomic_fetch_add(p, v, __ATOMIC_RELAXED, __HIP_MEMORY_SCOPE_AGENT); }
DI unsigned xb_xcc_id() { return (unsigned)__builtin_amdgcn_s_getreg((3 << 11) | 20) & 0xFu; }
#define XB_SPIN(cond, bar) do { unsigned _sp = 0; while (cond) { __builtin_amdgcn_s_sleep(1); \
    if ((++_sp & 255u) == 0u) { if (xb_ld(&(bar)[XB_TMO])) break; if (_sp > XB_SPIN_CAP) { atomicAdd(&(bar)[XB_TMO], 1u); break; } } } } while (0)
DI void xcd_barrier_complete(unsigned* bar, unsigned x, unsigned& nloc, unsigned& nx) {
    const unsigned G = gridDim.x * gridDim.y * gridDim.z;
    unsigned sum, cnt, mine, sp = 0u;
    for (;;) {
        sum = 0u; cnt = 0u; mine = 0u;
#pragma unroll
        for (unsigned j = 0; j < 16; ++j) { const unsigned c = xb_ld(&bar[XB_XCNT(j)]); sum += c; cnt += (c > 0u) ? 1u : 0u; mine = (j == x) ? c : mine; }
        if (sum == G) break;
        __builtin_amdgcn_s_sleep(1);
        if ((++sp & 255u) == 0u) { if (xb_ld(&bar[XB_TMO])) break; if (sp > XB_SPIN_CAP) { atomicAdd(&bar[XB_TMO], 1u); break; } }
    }
    nloc = mine > 0u ? mine : 1u; nx = cnt > 0u ? cnt : 1u;
}
DI void xcd_barrier(unsigned* bar, volatile LAS unsigned* st, bool leader) {
    asm volatile("s_waitcnt vmcnt(0)" ::: "memory");
    __syncthreads();
    if (leader) {
        const unsigned x = xb_xcc_id();
        __builtin_amdgcn_s_waitcnt(0);
        unsigned nloc = st[0], nx = st[1];
        if (nloc == 0u) { xcd_barrier_complete(bar, x, nloc, nx); st[0] = nloc; st[1] = nx; }
        const unsigned old = xb_add(&bar[XB_XSUB(x)], 1u);
        const unsigned gen = old / nloc;
        if (old + 1u == (gen + 1u) * nloc) {
            __builtin_amdgcn_fence(__ATOMIC_RELEASE, "agent");
            asm volatile("s_waitcnt vmcnt(0)" ::: "memory");
            const unsigned og = xb_add(&bar[XB_TOP], 1u);
            const unsigned tg = og / nx;
            if (og + 1u == (tg + 1u) * nx) xb_add(&bar[XB_TOPGEN], 1u);
            else XB_SPIN(xb_ld(&bar[XB_TOPGEN]) == tg, bar);
            __builtin_amdgcn_fence(__ATOMIC_ACQUIRE, "agent");
            xb_add(&bar[XB_XGEN(x)], 1u);
            asm volatile("s_waitcnt vmcnt(0)" ::: "memory");
        } else {
            XB_SPIN(xb_ld(&bar[XB_XGEN(x)]) == gen, bar);
            __builtin_amdgcn_fence(__ATOMIC_ACQUIRE, "agent");
            asm volatile("s_waitcnt vmcnt(0)" ::: "memory");
        }
    }
    __syncthreads();
}

#ifndef REP_GEMM
#define REP_GEMM 1
#endif
#ifndef REP_NSA
#define REP_NSA 1
#endif
#ifndef REP_SCAN
#define REP_SCAN 1
#endif
#ifndef REP_SSD
#define REP_SSD 1
#endif
#define GEMM_RUN(EpiT, epi, Aptr, Bptr, M_, N_, K_, lda_, padA_, cshift) for (int rep_ = 0; rep_ < REP_GEMM; ++rep_) do { pg8::Gemm g_{(const bf16_t*)(Aptr), (const bf16_t*)(Bptr), (M_), (N_), (K_), (lda_), (padA_)}; pg8::StaticOrder S_; \
    S_.init((M_), (N_), (int)gridDim.x, (int)((blockIdx.x + gridDim.x - (cshift)) % gridDim.x)); pg8::gemm_phase<EpiT>(wv, lds, g_, S_, (epi)); } while (0)

DI unsigned* bar_ptr(const Params& P) { return (unsigned*)(P.ws + WS_BAR); }
#define ws ws_fresh(P.ws)
#define A ((bf16_t*)(ws + WS_A))
#define H ((bf16_t*)(ws + WS_H))
#define Y ((bf16_t*)(ws + WS_Y))
#define GSYNC() do { unsigned* const barp_ = bar_ptr(P); const bool lead_ = (tid_fresh(wv) == 0); xcd_barrier(barp_, (volatile LAS unsigned*)(lds + LDS_BYTES - 64), lead_); } while (0)
template <int layer> DI void layer_body(const Params& P, cg::grid_group& grid, const int wv, LAS unsigned char* lds) {
    float* X = P.out; const float* ng = P.in[1];
        const float* gl = ng + layer * 6 * DM;
        { EpiSwiglu e{H}; GEMM_RUN(EpiSwiglu, e, A, ws + WS_WGU, MTOK, 2 * DFF, DM, DM, 0, 0); }
        GSYNC();
        { EpiBf16 e{Y, DM}; GEMM_RUN(EpiBf16, e, H, ws + WS_WD, MTOK, DM, DFF, DFF, 0, 0); }
        GSYNC();
        row_phase(wv, 1, layer == 0 ? P.in[0] : X, Y, gl + 1 * DM, 0.5f, gl + 2 * DM, X, A, layer);
        run_jobs(wv, P.ffn2[layer], 3, nullptr, 0, lds);
        GSYNC();
        if (layer == 0) {
            { EpiWin e{ws, P.in[17]};
              GEMM_RUN(EpiWin, e, A, ws + WS_WIN, MTOK, 4096, DM, DM, 0, 0); }
            GSYNC();
            { EpiF32 e{(float*)(ws + WS_PK), 256}; GEMM_RUN(EpiF32, e, ws + WS_KCN, ws + WS_W1K, 2048, 256, 1024, 1024, 0, 0); }
            { EpiF32 e{(float*)(ws + WS_PV), 256}; GEMM_RUN(EpiF32, e, ws + WS_VCN, ws + WS_W1V, 2048, 256, 1024, 1024, 0, 8); }
            for (int r_ = 0; r_ < REP_SSD; ++r_) conv_phase(wv, P);
            GSYNC();
            cmp_finish_phase(wv, P); for (int r_ = 0; r_ < REP_SSD; ++r_) ssd_states_phase(wv, P, lds);
            GSYNC();
            ssd_scan_phase(wv, P); for (int r_ = 0; r_ < REP_NSA; ++r_) nsa_phase(wv, P, lds);
            GSYNC();
            for (int r_ = 0; r_ < REP_SSD; ++r_) ssd_out_phase(wv, P, lds);
            GSYNC();
            { EpiBf16 e{(bf16_t*)(ws + WS_YMIX0), DM}; GEMM_RUN(EpiBf16, e, ws + WS_OCAT, ws + WS_WOUT, MTOK, DM, 1536, 1536, 0, 0); }
            GSYNC();
            row_phase(wv, 1, X, (const bf16_t*)(ws + WS_YMIX0), gl + 3 * DM, 1.f, gl + 4 * DM, X, A, 0);
            GSYNC();
        } else {
            { EpiRwkv1 e{ws}; GEMM_RUN(EpiRwkv1, e, A, ws + WS_WG1, MTOK, 3584, 2048, DM, DM * 2, 0); }
            GSYNC();
            { EpiRwkv2 e{(_Float16*)(ws + WS_LD), (bf16_t*)(ws + WS_AA), P.in[27], P.in[30]}; GEMM_RUN(EpiRwkv2, e, ws + WS_LH, ws + WS_W2A, MTOK, 2048, 128, 512, 0, 0); }
            GSYNC();
            for (int r_ = 0; r_ < REP_SCAN; ++r_) rwkv_scan_phase(wv, P, lds);
            GSYNC();
            { EpiBf16 e{(bf16_t*)(ws + WS_G), DM}; GEMM_RUN(EpiBf16, e, (bf16_t*)(ws + WS_LH) + 128, ws + WS_W2B, MTOK, DM, 256, 512, 0, 0); }
            GSYNC();
            rwkv_post_phase(wv, P);
            GSYNC();
            { EpiBf16 e{(bf16_t*)(ws + WS_YMIX1), DM}; GEMM_RUN(EpiBf16, e, ws + WS_A2, ws + WS_WO, MTOK, DM, DM, DM, 0, 0); }
            GSYNC();
            row_phase(wv, 1, X, (const bf16_t*)(ws + WS_YMIX1), gl + 3 * DM, 1.f, gl + 4 * DM, X, A, 0);
            GSYNC();
        }
        { EpiSwiglu e{H}; GEMM_RUN(EpiSwiglu, e, A, ws + WS_WGU, MTOK, 2 * DFF, DM, DM, 0, 0); }
        GSYNC();
        { EpiBf16 e{Y, DM}; GEMM_RUN(EpiBf16, e, H, ws + WS_WD, MTOK, DM, DFF, DFF, 0, 0); }
        GSYNC();
        if (layer == 0) { row_phase(wv, 1, X, Y, gl + 5 * DM, 0.5f, ng + 6 * DM, X, A, 0); run_jobs(wv, P.js[1].cj, P.js[1].ncj, P.js[1].zj, P.js[1].nzj, lds); GSYNC(); }
        else row_phase(wv, 1, X, Y, gl + 5 * DM, 0.5f, nullptr, X, nullptr, 0);
}

__global__ void __launch_bounds__(NTHREADS, 2) mega_fwd(Params P) {
    extern __shared__ __attribute__((aligned(16))) unsigned char lds_raw[];
    LAS unsigned char* lds = (LAS unsigned char*)lds_raw;
    cg::grid_group grid = cg::this_grid();
    const int wv = __builtin_amdgcn_readfirstlane(threadIdx.x >> 6);
    { unsigned* const barp = bar_ptr(P); const unsigned xid = xb_xcc_id();
      if (threadIdx.x == 0) { ((volatile LAS unsigned*)(lds + LDS_BYTES - 64))[0] = 0u; ((volatile LAS unsigned*)(lds + LDS_BYTES - 64))[1] = 0u; (void)xb_add(barp + XB_XCNT(xid), 1u); } }
    __syncthreads();
    float* X = P.out;
    const float* ng = P.in[1];
    grid.sync();
    run_jobs(wv, P.js[0].cj, P.js[0].ncj, P.js[0].zj, P.js[0].nzj, lds); p0_misc(wv, P, lds);
    row_phase(wv, 0, P.in[0], nullptr, nullptr, 0.f, ng + 0 * DM, nullptr, A, 0);
    GSYNC();
    layer_body<0>(P, grid, wv, lds);
    layer_body<1>(P, grid, wv, lds);
}
#undef ws
#undef A
#undef H
#undef Y
static void add_cvt(JobSet& js, const float* src, int ldw, int K, int N, bf16_t* dst, int ldk, int koff, int mode, int rowoff, const float* scale = nullptr, int smode = 0) {
    CvtJob& j = js.cj[js.ncj++]; j.src = src; j.scale = scale; j.dst = dst; j.ldw = ldw; j.K = K; j.N = N; j.ldk = ldk; j.koff = koff; j.mode = mode; j.rowoff = rowoff; j.smode = smode;
}
static void add_zero(JobSet& js, bf16_t* dst, int rows, int ldk, int c0, int nc) { ZeroJob& z = js.zj[js.nzj++]; z.dst = dst; z.rows = rows; z.ldk = ldk; z.c0 = c0; z.nc = nc; z.pad = 0; }
static void set_cvt(CvtJob& j, const float* src, int ldw, int K, int N, bf16_t* dst, int ldk, int koff, int mode, int rowoff) {
    j.src = src; j.scale = nullptr; j.dst = dst; j.ldw = ldw; j.K = K; j.N = N; j.ldk = ldk; j.koff = koff; j.mode = mode; j.rowoff = rowoff; j.smode = 0;
}
static void set_ffn(CvtJob* j, unsigned char* ws, const float* wg, const float* wu, const float* wd) {
    set_cvt(j[0], wg, DFF, DM, DFF, (bf16_t*)(ws + WS_WGU), DM, 0, 1, 0); set_cvt(j[1], wu, DFF, DM, DFF, (bf16_t*)(ws + WS_WGU), DM, 0, 1, 128); set_cvt(j[2], wd, DM, DFF, DM, (bf16_t*)(ws + WS_WD), DFF, 0, 0, 0);
}
static void add_ffn(JobSet& js, unsigned char* ws, const float* wg, const float* wu, const float* wd) {
    add_cvt(js, wg, DFF, DM, DFF, (bf16_t*)(ws + WS_WGU), DM, 0, 1, 0);
    add_cvt(js, wu, DFF, DM, DFF, (bf16_t*)(ws + WS_WGU), DM, 0, 1, 128);
    add_cvt(js, wd, DM, DFF, DM, (bf16_t*)(ws + WS_WD), DFF, 0, 0, 0);
}

extern "C" void kernel_launch(void* const* d_in, const int* in_sizes, int n_in, void* d_out, int out_size, void* d_ws, size_t ws_size, hipStream_t stream) {
    static int grid = 0;
    if (grid == 0) {
        int dev = 0, cus = 0, per_cu = 0;
        hipGetDevice(&dev); hipDeviceGetAttribute(&cus, hipDeviceAttributeMultiprocessorCount, dev);
        hipFuncSetAttribute((const void*)mega_fwd, hipFuncAttributeMaxDynamicSharedMemorySize, LDS_BYTES);
        hipOccupancyMaxActiveBlocksPerMultiprocessor(&per_cu, (const void*)mega_fwd, NTHREADS, LDS_BYTES);
        if (per_cu < 1) { fprintf(stderr, "occupancy query returned %d\n", per_cu); per_cu = 1; }
        grid = cus * 1;
        if (n_in != 40 || ws_size < 256 * MiB) fprintf(stderr, "unexpected n_in %d / ws %zu\n", n_in, ws_size);
    }
    static Params P;
    memset(&P, 0, sizeof(P));
    for (int i = 0; i < 40; ++i) P.in[i] = (const float*)d_in[i];
    P.out = (float*)d_out; P.ws = (unsigned char*)d_ws;
    unsigned char* ws = P.ws;
    const float* const* in = P.in;
    const size_t FW = (size_t)DM * DFF;
    { JobSet& js = P.js[0]; add_ffn(js, ws, in[2], in[3], in[4]);
      add_cvt(js, in[8], 3880, DM, 3880, (bf16_t*)(ws + WS_WIN), DM, 0, 2, 0);
      add_cvt(js, in[21], DM, 1536, DM, (bf16_t*)(ws + WS_WOUT), 1536, 0, 0, 0);
      add_cvt(js, in[10], 64, 1024, 64, (bf16_t*)(ws + WS_W1K), 1024, 0, 0, 0); add_cvt(js, in[10] + 1024 * 64, 64, 1024, 64, (bf16_t*)(ws + WS_W1K), 1024, 0, 0, 64);
      add_cvt(js, in[13], 64, 1024, 64, (bf16_t*)(ws + WS_W1V), 1024, 0, 0, 0); add_cvt(js, in[13] + 1024 * 64, 64, 1024, 64, (bf16_t*)(ws + WS_W1V), 1024, 0, 0, 64);
      add_zero(js, (bf16_t*)(ws + WS_W1K) + 128 * 1024, 128, 1024, 0, 1024); add_zero(js, (bf16_t*)(ws + WS_W1V) + 128 * 1024, 128, 1024, 0, 1024);
      add_zero(js, (bf16_t*)(ws + WS_WIN) + (size_t)(768 + 64) * DM, 64, DM, 0, DM); add_zero(js, (bf16_t*)(ws + WS_WIN) + (size_t)(768 + 128 + 64) * DM, 64, DM, 0, DM);
      add_zero(js, (bf16_t*)(ws + WS_WIN) + (size_t)(1280 + 128 + 40) * DM, 88, DM, 0, DM); }
    set_ffn(P.ffn2[0], ws, in[5], in[6], in[7]);
    { JobSet& js = P.js[1]; add_ffn(js, ws, in[2] + FW, in[3] + FW, in[4] + FW);
      bf16_t* wg1 = (bf16_t*)(ws + WS_WG1); const float* mu = in[22];
      const float* srcs[6] = {in[23], in[24], in[25], in[28], in[31], in[33]}; const int ncol[6] = {1024, 1024, 1024, 64, 64, 160}; const int roff[6] = {0, 1024, 2048, 3072, 3072 + 64, 3072 + 128}; const int mui[6] = {0, 2, 3, 1, 4, 5};
      for (int i = 0; i < 6; ++i) { add_cvt(js, srcs[i], ncol[i], DM, ncol[i], wg1, 2048, 0, 0, roff[i], mu + mui[i] * DM, 1); add_cvt(js, srcs[i], ncol[i], DM, ncol[i], wg1, 2048, 1024, 0, roff[i], mu + mui[i] * DM, 2); }
      add_zero(js, wg1 + (size_t)(3072 + 288) * 2048, 224, 2048, 0, 2048);
      add_cvt(js, in[26], DM, DM, DM, (bf16_t*)(ws + WS_WO), DM, 0, 0, 0);
      bf16_t* w2a = (bf16_t*)(ws + WS_W2A); add_cvt(js, in[29], DM, 64, DM, w2a, 128, 0, 0, 0); add_cvt(js, in[32], DM, 64, DM, w2a, 128, 64, 0, 1024);
      add_zero(js, w2a, 1024, 128, 64, 64); add_zero(js, w2a + 1024 * 128, 1024, 128, 0, 64);
      bf16_t* w2b = (bf16_t*)(ws + WS_W2B); add_cvt(js, in[34], DM, 160, DM, w2b, 256, 0, 0, 0); add_zero(js, w2b, 1024, 256, 192, 64); }
    set_ffn(P.ffn2[1], ws, in[5] + FW, in[6] + FW, in[7] + FW);
    hipMemsetAsync((char*)d_ws + WS_BAR, 0, 16384, stream);
    void* args[] = {&P};
    hipError_t e = hipLaunchCooperativeKernel((const void*)mega_fwd, dim3(grid), dim3(NTHREADS), args, LDS_BYTES, stream);
    if (e != hipSuccess) fprintf(stderr, "cooperative launch failed: %s (grid %d)\n", hipGetErrorString(e), grid);
}

#ifdef PHASE_TEST
#define TK(name, ...) __global__ void __launch_bounds__(NTHREADS, 2) name(Params P) { extern __shared__ __attribute__((aligned(16))) unsigned char lds_raw[]; LAS unsigned char* lds = (LAS unsigned char*)lds_raw; unsigned char* ws = P.ws; const int wv = __builtin_amdgcn_readfirstlane(threadIdx.x >> 6); __VA_ARGS__ }
TK(t_jobs, run_jobs(wv, P.js[0].cj, P.js[0].ncj, P.js[0].zj, P.js[0].nzj, lds); p0_misc(wv, P, lds);)
TK(t_row, row_phase(wv, 1, P.out, (const bf16_t*)(ws + WS_Y), P.in[1], 0.5f, P.in[1] + DM, P.out, (bf16_t*)(ws + WS_A), 1);)
TK(t_swiglu, { EpiSwiglu e{(bf16_t*)(ws + WS_H)}; GEMM_RUN(EpiSwiglu, e, ws + WS_A, ws + WS_WGU, MTOK, 2 * DFF, DM, DM, 0, 0); })
TK(t_f32, { EpiF32 e{(float*)(ws + WS_Y), DM}; GEMM_RUN(EpiF32, e, ws + WS_H, ws + WS_WD, MTOK, DM, DFF, DFF, 0, 0); })
TK(t_win, { EpiWin e{ws, P.in[17]};
              GEMM_RUN(EpiWin, e, ws + WS_A, ws + WS_WIN, MTOK, 4096, DM, DM, 0, 0); })
TK(t_conv, conv_phase(wv, P);)
TK(t_cmpfin, cmp_finish_phase(wv, P);)
TK(t_sstates, ssd_states_phase(wv, P, lds);)
TK(t_sscan, ssd_scan_phase(wv, P);)
TK(t_sout, ssd_out_phase(wv, P, lds);)
TK(t_nsa, nsa_phase(wv, P, lds);)
TK(t_rw1, { EpiRwkv1 e{ws}; GEMM_RUN(EpiRwkv1, e, ws + WS_A, ws + WS_WG1, MTOK, 3584, 2048, DM, DM * 2, 0); })
TK(t_rw2, { EpiRwkv2 e{(_Float16*)(ws + WS_LD), (bf16_t*)(ws + WS_AA), P.in[27], P.in[30]}; GEMM_RUN(EpiRwkv2, e, ws + WS_LH, ws + WS_W2A, MTOK, 2048, 128, 512, 0, 0); })
TK(t_bf16, { EpiBf16 e{(bf16_t*)(ws + WS_G), DM}; GEMM_RUN(EpiBf16, e, (bf16_t*)(ws + WS_LH) + 128, ws + WS_W2B, MTOK, DM, 256, 512, 0, 0); })
TK(t_scan, rwkv_scan_phase(wv, P, lds);)
TK(t_rpost, rwkv_post_phase(wv, P);)
#endif
```
